# Optimizing an MI355X kernel written in HIP

```python
import jax, jax.numpy as jnp
from jax import lax
import numpy as np

D_MODEL = 1024
BATCH = 16
SEQ = 2048
DEPTH = 1

CTX_LEN = 256
GRID_W = 64
D_CONV = 1024
CONV_W = 3
N_HEADS = 8
DK = 64
DV = 128
D_MLSTM = N_HEADS * DV
D_FF = 4 * D_MODEL
CHUNK = 128
N_DIR = 2
N_BRANCH = 2
EPS = 1e-6

STATE_SPLITS = (N_HEADS * DK, D_MLSTM, N_DIR * N_HEADS, N_DIR * N_HEADS)
REST_SPLITS = (N_HEADS * DK, D_MLSTM, D_CONV, D_CONV, D_CONV, N_BRANCH * D_MODEL)
COL_SPLITS = STATE_SPLITS + REST_SPLITS
D_IN = sum(COL_SPLITS)
N_STATE_COLS = sum(STATE_SPLITS)
COL_OFFSETS = tuple(np.cumsum(COL_SPLITS)[:-1].tolist())
STATE_OFFSETS = tuple(np.cumsum(STATE_SPLITS)[:-1].tolist())
F_GATE_OFFSET = N_HEADS * DK + D_MLSTM + N_DIR * N_HEADS

kernel_name = "hybrid_conv_mlstm_prefix_dit"


def rmsnorm(x, w):
    xf = x.astype(jnp.float32)
    y = xf * lax.rsqrt(jnp.mean(xf * xf, axis=-1, keepdims=True) + EPS)
    return y.astype(x.dtype) * w


def modulate(x, w, shift, scale):
    return rmsnorm(x, w) * (1 + scale) + shift


def adaln(cvec, w_mod, b_mod):
    return jnp.split(jax.nn.silu(cvec) @ w_mod + b_mod, 6, axis=-1)


def ffn(h, w1, w2):
    return jnp.square(jax.nn.relu(h @ w1)) @ w2


def conv3(u, w, axis):
    n = u.shape[axis]
    pad = [(0, 0)] * u.ndim
    pad[axis] = (1, 1)
    p = jnp.pad(u, pad)
    return (w[0] * lax.slice_in_dim(p, 0, n, axis=axis)
            + w[1] * lax.slice_in_dim(p, 1, n + 1, axis=axis)
            + w[2] * lax.slice_in_dim(p, 2, n + 2, axis=axis))


def heads(a, d):
    b, t, _ = a.shape
    return a.reshape(b, t, -1, d).transpose(0, 2, 1, 3)


def dir_shared(a):
    return jnp.stack([a, a[..., ::-1, :]])


def dir_gates(g):
    b, t, _ = g.shape
    g = g.reshape(b, t, N_DIR, N_HEADS).transpose(2, 0, 3, 1)
    return jnp.stack([g[0], g[1][..., ::-1]])


def mlstm_dir_inputs(k, v, ig, fg):
    kd = dir_shared(heads(k, DK)).astype(jnp.float32) * (DK ** -0.5)
    vd = dir_shared(heads(v, DV)).astype(jnp.float32)
    igd = dir_gates(ig).astype(jnp.float32)
    lfd = jax.nn.log_sigmoid(dir_gates(fg).astype(jnp.float32))
    return kd, vd, igd, lfd


def mlstm_chunked(q, k, v, ig, lf, C0, n0, m0):
    lead = q.shape[:-2]
    t = q.shape[-2]
    nc = t // CHUNK

    def feat_chunks(a):
        return jnp.moveaxis(a.reshape(*lead, nc, CHUNK, a.shape[-1]), -3, 0)

    def gate_chunks(a):
        return jnp.moveaxis(a.reshape(*lead, nc, CHUNK), -2, 0)

    causal_in_chunk = jnp.tril(jnp.ones((CHUNK, CHUNK), dtype=bool))

    def step(carry, inp):
        C, n, m = carry
        qc, kc, vc, ic, fc = inp
        b = jnp.cumsum(fc, axis=-1)
        log_d = jnp.where(causal_in_chunk,
                          b[..., :, None] - b[..., None, :] + ic[..., None, :], -jnp.inf)
        inter = b + m[..., None]
        m_t = jnp.maximum(jnp.max(log_d, axis=-1), inter)
        s = jnp.einsum('...tk,...sk->...ts', qc, kc) * jnp.exp(log_d - m_t[..., None])
        w_inter = jnp.exp(inter - m_t)
        num = (jnp.einsum('...ts,...sv->...tv', s, vc)
               + w_inter[..., None] * jnp.einsum('...vk,...tk->...tv', C, qc))
        den = jnp.sum(s, axis=-1) + w_inter * jnp.einsum('...k,...tk->...t', n, qc)
        h = num / jnp.maximum(jnp.abs(den), jnp.exp(-m_t))[..., None]
        b_last = b[..., -1]
        g = b_last[..., None] - b + ic
        m_new = jnp.maximum(b_last + m, jnp.max(g, axis=-1))
        wk = jnp.exp(g - m_new[..., None])
        decay = jnp.exp(b_last + m - m_new)
        C_new = decay[..., None, None] * C + jnp.einsum('...s,...sv,...sk->...vk', wk, vc, kc)
        n_new = decay[..., None] * n + jnp.einsum('...s,...sk->...k', wk, kc)
        return (C_new, n_new, m_new), h

    state, hs = lax.scan(step, (C0, n0, m0),
                         (feat_chunks(q), feat_chunks(k), feat_chunks(v), gate_chunks(ig), gate_chunks(lf)))
    hs = jnp.moveaxis(hs, 0, -3).reshape(*lead, t, v.shape[-1])
    return hs, state


def mlstm_state(k, v, ig, lf):
    b = jnp.cumsum(lf, axis=-1)
    b_last = b[..., -1]
    g = b_last[..., None] - b + ig
    m = jnp.maximum(b_last, jnp.max(g, axis=-1))
    w = jnp.exp(g - m[..., None])
    C = jnp.einsum('...s,...sv,...sk->...vk', w, v, k)
    n = jnp.einsum('...s,...sk->...k', w, k)
    return C, n, m


def context_state(hc, w_in, b_in):
    z = hc @ w_in[:, :N_STATE_COLS] + b_in[:N_STATE_COLS]
    k, v, ig, fg = jnp.split(z, STATE_OFFSETS, axis=-1)
    return mlstm_state(*mlstm_dir_inputs(k, v, ig, fg))


def token_mixers(h, w_in, b_in, conv_w, mlstm_norm_w, w_conv_out, w_mlstm_out, w_out, state0, grid):
    bsz, t, _ = h.shape
    k, v, ig, fg, q, o, xin, gate_c, gate_b, merge = jnp.split(h @ w_in + b_in, COL_OFFSETS, axis=-1)
    u = gate_c * xin
    if grid:
        rows = t // GRID_W
        a = conv3(u.reshape(bsz, rows, GRID_W, D_CONV), conv_w, axis=2).reshape(bsz, t, D_CONV)
    else:
        a = conv3(u, conv_w, axis=1)
    y_a = (gate_b * a) @ w_conv_out
    kd, vd, igd, lfd = mlstm_dir_inputs(k, v, ig, fg)
    qd = dir_shared(heads(q, DK)).astype(jnp.float32)
    hd, state = mlstm_chunked(qd, kd, vd, igd, lfd, *state0)
    hs = (hd[0] + hd[1][..., ::-1, :]).transpose(0, 2, 1, 3)
    hs = hs * lax.rsqrt(jnp.mean(hs * hs, axis=-1, keepdims=True) + EPS)
    hs = hs.reshape(bsz, t, D_MLSTM).astype(h.dtype) * mlstm_norm_w
    y_b = (hs * jax.nn.sigmoid(o)) @ w_mlstm_out
    g_a, g_b = jnp.split(jax.nn.sigmoid(merge), N_BRANCH, axis=-1)
    return (g_a * y_a + g_b * y_b) @ w_out, state


def setup_inputs(seed: int = 0) -> dict:
    key = jax.random.key(seed)
    ks = jax.random.split(key, 20)

    def nrm(k, shape, s):
        return jax.random.normal(k, shape, jnp.float32) * s

    b_in = nrm(ks[7], (DEPTH, D_IN), 0.02)
    b_in = b_in.at[:, F_GATE_OFFSET:F_GATE_OFFSET + N_DIR * N_HEADS].add(
        jnp.tile(jnp.linspace(3.0, 6.0, N_HEADS), N_DIR))
    return {
        "x": nrm(ks[0], (BATCH, SEQ, D_MODEL), 1.0),
        "c": nrm(ks[1], (BATCH, D_MODEL), 1.0),
        "ctx": nrm(ks[2], (BATCH, CTX_LEN, D_MODEL), 1.0),
        "c_ctx": nrm(ks[3], (D_MODEL,), 1.0),
        "w_mod": nrm(ks[4], (DEPTH, D_MODEL, 6 * D_MODEL), 0.5 * D_MODEL ** -0.5),
        "b_mod": nrm(ks[5], (DEPTH, 6 * D_MODEL), 0.02),
        "norm1_w": 1.0 + nrm(ks[6], (DEPTH, D_MODEL), 0.02),
        "w_in": nrm(ks[8], (DEPTH, D_MODEL, D_IN), D_MODEL ** -0.5),
        "b_in": b_in,
        "conv_w": nrm(ks[9], (DEPTH, CONV_W, D_CONV), 0.5),
        "mlstm_norm_w": 1.0 + nrm(ks[10], (DEPTH, D_MLSTM), 0.02),
        "w_conv_out": nrm(ks[11], (DEPTH, D_CONV, D_MODEL), D_CONV ** -0.5),
        "w_mlstm_out": nrm(ks[12], (DEPTH, D_MLSTM, D_MODEL), D_MLSTM ** -0.5),
        "w_out": nrm(ks[13], (DEPTH, D_MODEL, D_MODEL), D_MODEL ** -0.5),
        "norm2_w": 1.0 + nrm(ks[14], (DEPTH, D_MODEL), 0.02),
        "w_ff1": nrm(ks[15], (DEPTH, D_MODEL, D_FF), D_MODEL ** -0.5),
        "w_ff2": nrm(ks[16], (DEPTH, D_FF, D_MODEL), D_FF ** -0.5),
        "final_norm_w": 1.0 + nrm(ks[17], (D_MODEL,), 0.02),
    }


def reference(x, c, ctx, c_ctx, w_mod, b_mod, norm1_w, w_in, b_in, conv_w, mlstm_norm_w,
              w_conv_out, w_mlstm_out, w_out, norm2_w, w_ff1, w_ff2, final_norm_w):
    for l in range(DEPTH):
        sh1, sc1, g1, sh2, sc2, g2 = [m[:, None, :] for m in adaln(c, w_mod[l], b_mod[l])]
        csh1, csc1, cg1, csh2, csc2, cg2 = adaln(c_ctx, w_mod[l], b_mod[l])
        hc = modulate(ctx, norm1_w[l], csh1, csc1)
        if l + 1 < DEPTH:
            bsz = ctx.shape[0]
            zero_state = (jnp.zeros((N_DIR, bsz, N_HEADS, DV, DK), jnp.float32),
                          jnp.zeros((N_DIR, bsz, N_HEADS, DK), jnp.float32),
                          jnp.zeros((N_DIR, bsz, N_HEADS), jnp.float32))
            out_c, state = token_mixers(hc, w_in[l], b_in[l], conv_w[l], mlstm_norm_w[l], w_conv_out[l],
                                        w_mlstm_out[l], w_out[l], zero_state, grid=False)
            ctx_next = ctx + cg1 * out_c
            ctx_next = ctx_next + cg2 * ffn(modulate(ctx_next, norm2_w[l], csh2, csc2), w_ff1[l], w_ff2[l])
        else:
            state = context_state(hc, w_in[l], b_in[l])
            ctx_next = ctx
        h = modulate(x, norm1_w[l], sh1, sc1)
        out, _ = token_mixers(h, w_in[l], b_in[l], conv_w[l], mlstm_norm_w[l], w_conv_out[l],
                              w_mlstm_out[l], w_out[l], state, grid=True)
        x = x + g1 * out
        x = x + g2 * ffn(modulate(x, norm2_w[l], sh2, sc2), w_ff1[l], w_ff2[l])
        ctx = ctx_next
    return rmsnorm(x, final_norm_w)
```

```cpp
#include <hip/hip_runtime.h>
#include <hip/hip_cooperative_groups.h>
#include <cstdio>
#include <cstdint>
namespace cg = cooperative_groups;

#define LAS __attribute__((address_space(3)))
typedef unsigned short bf16_t;
typedef short bf16x8 __attribute__((ext_vector_type(8)));
typedef float f32x4 __attribute__((ext_vector_type(4)));
typedef unsigned u32x4 __attribute__((ext_vector_type(4)));
typedef unsigned u32x2 __attribute__((ext_vector_type(2)));

constexpr int DM = 1024, NB = 16, SEQ = 2048, CTXL = 256, NH = 8, DK = 64, DV = 128, DFF = 4096;
constexpr int MTOK = NB * SEQ;
constexpr int MCTX = NB * CTXL;
constexpr int MALL = MTOK + MCTX;
constexpr int DIN = 8224, NIN = 8448;
constexpr float EPS = 1e-6f;
constexpr int OFF_K = 0, OFF_V = 512, OFF_IG = 1536, OFF_Q = 1568, OFF_O = 2080, OFF_XIN = 3104, OFF_GC = 4128, OFF_GB = 5152, OFF_MRG = 6176;

constexpr size_t MiB = 1u << 20;
constexpr size_t WS_MOD = 0;
constexpr size_t WS_BIASP = 512 * 1024;
constexpr size_t WS_BAR = 768 * 1024;
constexpr size_t WS_CNT = 800 * 1024;
constexpr size_t WS_XBUF = 450 * MiB;
constexpr size_t WS_WIN = 1 * MiB;
constexpr size_t WS_BT2 = 18 * MiB;
constexpr size_t WS_WO = 22 * MiB;
constexpr size_t WS_W1 = 24 * MiB;
constexpr size_t WS_W2 = 32 * MiB;
constexpr size_t WS_H = 40 * MiB;
constexpr size_t WS_K = 112 * MiB;
constexpr size_t WS_VT = 148 * MiB;
constexpr size_t WS_Q = 220 * MiB;
constexpr size_t WS_G = 252 * MiB;
constexpr size_t WS_AB = 258 * MiB;
constexpr size_t WS_HD1 = 386 * MiB;
constexpr size_t WS_F1 = 112 * MiB;
constexpr size_t WS_END = 452 * MiB;

constexpr int LDS_BYTES = 155648;

typedef float f32x2_t __attribute__((ext_vector_type(2))); typedef __bf16 bf16x2_t __attribute__((ext_vector_type(2)));
__device__ __forceinline__ unsigned cvt_pk_bf16(float lo, float hi) { const f32x2_t v = {lo, hi}; const bf16x2_t b = __builtin_convertvector(v, bf16x2_t); return __builtin_bit_cast(unsigned, b); }
__device__ __forceinline__ float bf_lo(unsigned w) { return __uint_as_float(w << 16); }
__device__ __forceinline__ float bf_hi(unsigned w) { return __uint_as_float(w & 0xffff0000u); }
__device__ __forceinline__ float sigm(float x) { return __builtin_amdgcn_rcpf(1.f + __expf(-x)); }
__device__ __forceinline__ float wave_sum(float v) {
#pragma unroll
    for (int o = 1; o < 64; o <<= 1) v += __shfl_xor(v, o);
    return v;
}
__device__ __forceinline__ float wave_max(float v) {
#pragma unroll
    for (int o = 1; o < 64; o <<= 1) v = fmaxf(v, __shfl_xor(v, o));
    return v;
}
template <int CTRL, int RM = 0xf> __device__ __forceinline__ float dppf(float old, float src) {
    return __int_as_float(__builtin_amdgcn_update_dpp(__float_as_int(old), __float_as_int(src), CTRL, RM, 0xf, false));
}
__device__ __forceinline__ float wave_scan_add(float x) {
    x += dppf<0x111>(0.f, x); x += dppf<0x112>(0.f, x); x += dppf<0x114>(0.f, x); x += dppf<0x118>(0.f, x);
    x += dppf<0x142, 0xA>(0.f, x); x += dppf<0x143, 0xC>(0.f, x); return x;
}
__device__ __forceinline__ float wave_scan_max(float x) {
    const float ninf = -INFINITY;
    x = fmaxf(x, dppf<0x111>(ninf, x)); x = fmaxf(x, dppf<0x112>(ninf, x)); x = fmaxf(x, dppf<0x114>(ninf, x)); x = fmaxf(x, dppf<0x118>(ninf, x));
    x = fmaxf(x, dppf<0x142, 0xA>(ninf, x)); x = fmaxf(x, dppf<0x143, 0xC>(ninf, x)); return x;
}
__device__ __forceinline__ float lane63(float x) { return __int_as_float(__builtin_amdgcn_readlane(__float_as_int(x), 63)); }
__device__ __forceinline__ float logsig(float x) { return fminf(x, 0.f) - __logf(1.f + __expf(-fabsf(x))); }

namespace pg8 {
constexpr int BM = 256, BK = 64, HALF = 128, HTB = HALF * BK * 2, STAGE_BYTES = 8 * HTB, NXCD = 8, WGM = 8;
__host__ __device__ __forceinline__ int lds_byte(int r, int c) { const int st = (r >> 4) * 2 + (c >> 5), rr = r & 15, cc = c & 31, ob = rr * 64 + cc * 2; return st * 1024 + (ob ^ (((ob >> 9) & 1) << 5)); }
__host__ __device__ __forceinline__ void stage_rc(int b, int& R, int& C) { const int st = b / 1024, sb = b % 1024, swz = sb ^ (((sb >> 9) & 1) << 5); R = (st >> 1) * 16 + swz / 64; C = (st & 1) * 32 + (swz % 64) / 2; }
__host__ __device__ __forceinline__ int perm32(int rho) { const int n = rho >> 4, i = rho & 15; return 8 * (i >> 2) + 4 * n + (i & 3); }

struct Unit { int pm, pn, sw, h; };
struct Gemm { const bf16_t* A; const bf16_t* Bt; int K, lda, ldb; };

__device__ __forceinline__ void rect_map(int l, int nM, int nN, int& pm, int& pn) {
    const int nig = WGM * nN, gid = l / nig, fm = gid * WGM, gsz = (nM - fm) < WGM ? (nM - fm) : WGM, rem = l % nig;
    pm = fm + rem % gsz; pn = rem / gsz;
}
struct StaticOrder {
    int nM, nN, nwg, G, c;
    __device__ void init(int M, int N, int G_, int c_) { nM = M / BM; nN = N / BM; nwg = nM * nN; G = G_; c = c_; }
    __device__ bool next(int i, Unit& u) const {
        const long L = (long)i * G + c; if (L >= nwg) return false;
        int wgid = (int)L; { const int q = nwg / NXCD, r = nwg % NXCD, xcd = wgid % NXCD, off = wgid / NXCD; wgid = (xcd < r ? xcd * (q + 1) : r * (q + 1) + (xcd - r) * q) + off; }
        rect_map(wgid, nM, nN, u.pm, u.pn); u.sw = 0; u.h = 0; return true;
    }
};
struct InProjOrder {
    int G, c;
    static constexpr int N_RC = 128 * 26, N_RB = 144 * 4, N_RA = 144 * 3, NWG = N_RC + N_RB + N_RA;
    __device__ bool next(int i, Unit& u) const {
        const long L = (long)i * G + c; if (L >= NWG) return false;
        int w = (int)L; w = (w % NXCD) * (NWG / NXCD) + w / NXCD;
        int a, b; u.h = 0;
        if (w < N_RC) { rect_map(w, 128, 26, a, b); u.pm = a; u.pn = 7 + b; u.sw = 0; }
        else if (w < N_RC + N_RB) { rect_map(w - N_RC, 144, 4, a, b); u.pm = 3 + b; u.pn = a; u.sw = 1; }
        else { rect_map(w - N_RC - N_RB, 144, 3, a, b); u.pm = a; u.pn = b; u.sw = 0; }
        return true;
    }
};
static_assert(InProjOrder::NWG % NXCD == 0, "in-proj unit count");
struct SplitKOrder {
    StaticOrder base;
    __device__ bool next(int i, Unit& u) const { if (!base.next(i >> 1, u)) return false; u.h = i & 1; return true; }
};

template <class Epi, class Sched>
__device__ __forceinline__ void gemm_phase(LAS unsigned char* lds, const Gemm g, const Sched& S, const Epi& E) {
    const int tid = threadIdx.x, wid = __builtin_amdgcn_readfirstlane(tid >> 6), lane = tid & 63, wr = wid >> 2, wc = wid & 3, fr = lane & 15, fq = lane >> 4;
    const int K = g.K, nt = K / BK;
    unsigned voffA[2], voffB[2];
#pragma unroll
    for (int i = 0; i < 2; ++i) { int R, C; stage_rc(tid * 16 + i * 8192, R, C); const int Rb = (R & ~31) + perm32(R & 31);
        voffA[i] = (unsigned)(R * g.lda + C) * 2u; voffB[i] = (unsigned)(Rb * g.ldb + C) * 2u; }
    const size_t kstep = (size_t)(BK * 2);
    const size_t hstepA = (size_t)HALF * g.lda * 2, hstepB = (size_t)HALF * g.ldb * 2;
    const unsigned ldsw = (unsigned)wid * 1024u;
    const int aoff = lds_byte(wr * 64 + fr, fq * 8), boff = lds_byte(wc * 32 + fr, fq * 8);
#define PG8_SA(b, h) (((b) * 2 + (h)) * HTB)
#define PG8_SB(b, h) ((4 + (b) * 2 + (h)) * HTB)
#define PG8_STAGE(bufoff, gbase, voff) do { _Pragma("unroll") for (int _i = 0; _i < 2; ++_i) \
        __builtin_amdgcn_global_load_lds((const unsigned*)((const char*)(gbase) + (voff)[_i]), (LAS unsigned*)(lds + (bufoff) + ldsw + _i * 8192), 16, 0, 0); } while (0)
#define PG8_LDA(dst, b, h) do { _Pragma("unroll") for (int m = 0; m < 4; ++m) _Pragma("unroll") for (int k = 0; k < 2; ++k) dst[m][k] = *(const LAS bf16x8*)(lds + PG8_SA(b, h) + aoff + m * 2048 + k * 1024); } while (0)
#define PG8_LDB(dst, b, h) do { _Pragma("unroll") for (int n = 0; n < 2; ++n) _Pragma("unroll") for (int k = 0; k < 2; ++k) dst[n][k] = *(const LAS bf16x8*)(lds + PG8_SB(b, h) + boff + n * 2048 + k * 1024); } while (0)
#define PG8_MMA(ai, bj, At, Bt) do { __builtin_amdgcn_s_setprio(1); _Pragma("unroll") for (int m = 0; m < 4; ++m) _Pragma("unroll") for (int n = 0; n < 2; ++n) _Pragma("unroll") for (int k = 0; k < 2; ++k) \
        acc[ai][bj][m][n] = __builtin_amdgcn_mfma_f32_16x16x32_bf16(Bt[n][k], At[m][k], acc[ai][bj][m][n], 0, 0, 0); __builtin_amdgcn_s_setprio(0); } while (0)
#define PG8_WAIT_V(n) asm volatile("s_waitcnt vmcnt(" #n ")" ::: "memory")
#define PG8_WAIT_L(n) asm volatile("s_waitcnt lgkmcnt(" #n ")" ::: "memory")
#define PG8_BAR __builtin_amdgcn_s_barrier()
#define PG8_SCHED __builtin_amdgcn_sched_barrier(0)
#define PG8_PA(u) ((const char*)((u).sw ? g.Bt : g.A) + (size_t)(u).pm * 2 * hstepA + (size_t)(u).h * K * 2)
#define PG8_PB(u) ((const char*)((u).sw ? g.A : g.Bt) + (size_t)(u).pn * 2 * hstepB + (size_t)(u).h * K * 2)
    Unit cur, nxt; int ui = 0;
    if (!S.next(0, cur)) return;
    f32x4 acc[2][2][4][2];
#pragma unroll
    for (int a = 0; a < 2; ++a)
#pragma unroll
        for (int b = 0; b < 2; ++b)
#pragma unroll
            for (int m = 0; m < 4; ++m)
#pragma unroll
                for (int n = 0; n < 2; ++n) acc[a][b][m][n] = (f32x4){0.f, 0.f, 0.f, 0.f};
    bf16x8 At[4][2], B0[2][2], B1[2][2];
    const char* cA = PG8_PA(cur); const char* cB = PG8_PB(cur);
    PG8_STAGE(PG8_SB(0, 0), cB, voffB); PG8_STAGE(PG8_SB(0, 1), cB + hstepB, voffB); PG8_STAGE(PG8_SA(0, 0), cA, voffA); PG8_STAGE(PG8_SA(0, 1), cA + hstepA, voffA);
    if (wr == 1) PG8_BAR;
    PG8_WAIT_V(2); PG8_BAR;
    PG8_STAGE(PG8_SB(1, 0), cB + kstep, voffB); PG8_STAGE(PG8_SA(1, 0), cA + kstep, voffA); PG8_STAGE(PG8_SB(1, 1), cB + hstepB + kstep, voffB);
    PG8_WAIT_V(6); PG8_BAR;
    for (;;) {
        const bool has_next = S.next(ui + 1, nxt);
        const char* nA = has_next ? PG8_PA(nxt) : cA; const char* nB = has_next ? PG8_PB(nxt) : cB;
        for (int t = 0; t < nt; t += 2) {
            const bool last = (t == nt - 2);
            const char* a1 = cA + (size_t)(t + 1) * kstep;
            const char* a2 = last ? nA : cA + (size_t)(t + 2) * kstep; const char* b2 = last ? nB : cB + (size_t)(t + 2) * kstep;
            const char* a3 = a2 + kstep; const char* b3 = b2 + kstep;
            PG8_LDB(B0, 0, 0); PG8_LDB(B1, 0, 1); PG8_SCHED; PG8_LDA(At, 0, 0); PG8_STAGE(PG8_SA(1, 1), a1 + hstepA, voffA);
            PG8_WAIT_V(8); PG8_WAIT_L(0); PG8_BAR; PG8_MMA(0, 0, At, B0); PG8_MMA(0, 1, At, B1); PG8_BAR; PG8_SCHED;
            PG8_LDA(At, 0, 1); PG8_STAGE(PG8_SB(0, 0), b2, voffB); PG8_STAGE(PG8_SB(0, 1), b2 + hstepB, voffB); PG8_STAGE(PG8_SA(0, 0), a2, voffA);
            PG8_WAIT_V(8); PG8_WAIT_L(0); PG8_BAR; PG8_MMA(1, 0, At, B0); PG8_MMA(1, 1, At, B1); PG8_BAR; PG8_SCHED;
            PG8_LDB(B0, 1, 0); PG8_LDB(B1, 1, 1); PG8_SCHED; PG8_LDA(At, 1, 0); PG8_STAGE(PG8_SA(0, 1), a2 + hstepA, voffA);
            PG8_WAIT_V(8); PG8_WAIT_L(0); PG8_BAR; PG8_MMA(0, 0, At, B0); PG8_MMA(0, 1, At, B1); PG8_BAR; PG8_SCHED;
            PG8_LDA(At, 1, 1); PG8_STAGE(PG8_SB(1, 0), b3, voffB); PG8_STAGE(PG8_SB(1, 1), b3 + hstepB, voffB); PG8_STAGE(PG8_SA(1, 0), a3, voffA);
            PG8_WAIT_V(8); PG8_WAIT_L(0); PG8_BAR; PG8_MMA(1, 0, At, B0); PG8_MMA(1, 1, At, B1); PG8_BAR; PG8_SCHED;
        }
        if (wr == 0) PG8_BAR;
        bool keep = false;
        if constexpr (Epi::HAS_MID) keep = (cur.h == 0);
        if constexpr (Epi::HAS_MID) { if (keep) E.mid(acc, cur, wr, wc, fr, fq); else E(acc, cur, wr, wc, fr, fq); }
        else E(acc, cur, wr, wc, fr, fq);
        if (!has_next) break;
        if (!keep)
#pragma unroll
        for (int a = 0; a < 2; ++a)
#pragma unroll
            for (int b = 0; b < 2; ++b)
#pragma unroll
                for (int m = 0; m < 4; ++m)
#pragma unroll
                    for (int n = 0; n < 2; ++n) acc[a][b][m][n] = (f32x4){0.f, 0.f, 0.f, 0.f};
        cur = nxt; cA = nA; cB = nB; ++ui;
        if (wr == 1) PG8_BAR;
    }
    PG8_WAIT_V(0);
    PG8_BAR;
#undef PG8_SA
#undef PG8_SB
#undef PG8_STAGE
#undef PG8_LDA
#undef PG8_LDB
#undef PG8_MMA
#undef PG8_WAIT_V
#undef PG8_WAIT_L
#undef PG8_BAR
#undef PG8_SCHED
#undef PG8_PA
#undef PG8_PB
}
}
using pg8::Unit;

typedef f32x4 Acc[2][2][4][2];

__device__ __forceinline__ u32x4 pack8(const f32x4 v0, const f32x4 v1) {
    u32x4 w; w.x = cvt_pk_bf16(v0[0], v0[1]); w.y = cvt_pk_bf16(v0[2], v0[3]); w.z = cvt_pk_bf16(v1[0], v1[1]); w.w = cvt_pk_bf16(v1[2], v1[3]); return w;
}

struct EpiInProj {
    static constexpr bool HAS_MID = false;
    bf16_t* Kb; bf16_t* VTb; bf16_t* Qb; float* Gb; bf16_t* AB; bf16_t* MG; const float* biasp; const float* convw;
    __device__ __forceinline__ void operator()(Acc& acc, const Unit& u, int wr, int wc, int fr, int fq) const {
        if (u.sw) {
            const int r0 = u.pm * 256 + wr * 64 + fr, t0 = u.pn * 256 + wc * 32 + 8 * fq;
#pragma unroll
            for (int ai = 0; ai < 2; ++ai)
#pragma unroll
                for (int m = 0; m < 4; ++m) { const int wrow = r0 + ai * 128 + m * 16; const float bs = biasp[wrow]; bf16_t* rowp = VTb + (size_t)(wrow - 768) * MALL + t0;
#pragma unroll
                    for (int bj = 0; bj < 2; ++bj) *(u32x4*)(rowp + bj * 128) = pack8(acc[ai][bj][m][0] + bs, acc[ai][bj][m][1] + bs); }
            return;
        }
        const int row0 = u.pm * 256 + wr * 64 + fr, pn = u.pn;
        const int cb = pn * 256 + wc * 32 + 8 * fq;
        if (pn == 2) {
            if (wc == 0) {
                const f32x4 b0 = *(const f32x4*)(biasp + cb), b1 = *(const f32x4*)(biasp + cb + 4);
#pragma unroll
                for (int ai = 0; ai < 2; ++ai)
#pragma unroll
                    for (int m = 0; m < 4; ++m) { float* gp = Gb + (size_t)(row0 + ai * 128 + m * 16) * 32 + 8 * fq;
                        f32x4 g0 = acc[ai][0][m][0] + b0, g1 = acc[ai][0][m][1] + b1;
                        if (fq >= 2) {
#pragma unroll
                            for (int j = 0; j < 4; ++j) { g0[j] = logsig(g0[j]); g1[j] = logsig(g1[j]); } }
                        *(f32x4*)gp = g0; *(f32x4*)(gp + 4) = g1; }
            }
            return;
        }
        if (pn >= 9 && pn < 25) {
            const int ch = 64 * (pn - 9) + 16 * wc + 4 * fq;
            const f32x4 bX = *(const f32x4*)(biasp + cb), bC = *(const f32x4*)(biasp + cb + 4), bB = *(const f32x4*)(biasp + cb + 128), bO = *(const f32x4*)(biasp + cb + 132);
            const f32x4 w0 = *(const f32x4*)(convw + ch), w1 = *(const f32x4*)(convw + 1024 + ch), w2 = *(const f32x4*)(convw + 2048 + ch);
#pragma unroll
            for (int ai = 0; ai < 2; ++ai) {
                f32x4 uu[4];
#pragma unroll
                for (int m = 0; m < 4; ++m) uu[m] = (acc[ai][0][m][0] + bX) * (acc[ai][0][m][1] + bC);
#pragma unroll
                for (int m = 0; m < 4; ++m) {
                    f32x4 pv, nx;
#pragma unroll
                    for (int j = 0; j < 4; ++j) {
                        const float pold = (m > 0) ? dppf<0x121>(0.f, uu[m > 0 ? m - 1 : 0][j]) : 0.f;
                        pv[j] = dppf<0x111>(pold, uu[m][j]);
                        const float nold = (m < 3) ? dppf<0x12F>(0.f, uu[m < 3 ? m + 1 : 3][j]) : 0.f;
                        nx[j] = dppf<0x101>(nold, uu[m][j]);
                    }
                    const f32x4 cv = w0 * pv + w1 * uu[m] + w2 * nx;
                    const f32x4 aa = (acc[ai][1][m][0] + bB) * cv;
                    f32x4 os = acc[ai][1][m][1] + bO;
#pragma unroll
                    for (int j = 0; j < 4; ++j) os[j] = sigm(os[j]);
                    bf16_t* rp = AB + (size_t)(row0 + ai * 128 + m * 16) * 2048 + ch;
                    u32x2 wa, wo; wa.x = cvt_pk_bf16(aa[0], aa[1]); wa.y = cvt_pk_bf16(aa[2], aa[3]); wo.x = cvt_pk_bf16(os[0], os[1]); wo.y = cvt_pk_bf16(os[2], os[3]);
                    *(u32x2*)rp = wa; *(u32x2*)(rp + 1024) = wo;
                }
            }
            return;
        }
        if (pn >= 25) {
            const int ch = 128 * (pn - 25) + 32 * wc + 8 * fq;
            f32x4 ba[2], bb[2];
#pragma unroll
            for (int n = 0; n < 2; ++n) { ba[n] = *(const f32x4*)(biasp + cb + 4 * n); bb[n] = *(const f32x4*)(biasp + cb + 128 + 4 * n); }
#pragma unroll
            for (int ai = 0; ai < 2; ++ai)
#pragma unroll
                for (int m = 0; m < 4; ++m) { bf16_t* rp = MG + (size_t)(row0 + ai * 128 + m * 16) * 2048 + ch;
                    f32x4 rr[2], gg[2];
#pragma unroll
                    for (int n = 0; n < 2; ++n) { const f32x4 xa = acc[ai][0][m][n] + ba[n], xb = acc[ai][1][m][n] + bb[n];
#pragma unroll
                        for (int j = 0; j < 4; ++j) { const float ea = 1.f + __expf(-xa[j]), eb = 1.f + __expf(-xb[j]); rr[n][j] = eb * __builtin_amdgcn_rcpf(ea); gg[n][j] = __builtin_amdgcn_rcpf(eb); } }
                    *(u32x4*)rp = pack8(rr[0], rr[1]); *(u32x4*)(rp + 1024) = pack8(gg[0], gg[1]); }
            return;
        }
        bf16_t* base; int ldc, col0, mode;
        if (pn < 2) { base = Kb; ldc = 512; col0 = pn * 256; mode = 0; }
        else { base = Qb; ldc = 512; col0 = (pn - 7) * 256; mode = 1; }
        col0 += wc * 32 + 8 * fq;
        f32x4 bv[2][2];
#pragma unroll
        for (int bj = 0; bj < 2; ++bj)
#pragma unroll
            for (int n = 0; n < 2; ++n) bv[bj][n] = *(const f32x4*)(biasp + cb + bj * 128 + 4 * n);
#pragma unroll
        for (int ai = 0; ai < 2; ++ai)
#pragma unroll
            for (int m = 0; m < 4; ++m) { bf16_t* rowp = base + (size_t)(row0 + ai * 128 + m * 16) * ldc + col0;
#pragma unroll
                for (int bj = 0; bj < 2; ++bj) { f32x4 v0 = acc[ai][bj][m][0] + bv[bj][0], v1 = acc[ai][bj][m][1] + bv[bj][1];
                    if (mode == 0) { v0 = v0 * 0.125f; v1 = v1 * 0.125f; }
                    *(u32x4*)(rowp + bj * 128) = pack8(v0, v1); } }
    }
};

struct EpiG2 {
    static constexpr bool HAS_MID = true;
    const bf16_t* MG; bf16_t* MRG;
    __device__ __forceinline__ void mid(Acc& acc, const Unit& u, int wr, int wc, int fr, int fq) const {
        const int row0 = u.pm * 256 + wr * 64 + fr, col0 = u.pn * 256 + wc * 32 + 8 * fq;
#pragma unroll
        for (int ai = 0; ai < 2; ++ai)
#pragma unroll
            for (int m = 0; m < 4; ++m) { const bf16_t* gp = MG + (size_t)(row0 + ai * 128 + m * 16) * 2048 + col0;
#pragma unroll
                for (int bj = 0; bj < 2; ++bj) { const u32x4 rr = *(const u32x4*)(gp + bj * 128);
                    const f32x4 r0 = {bf_lo(rr.x), bf_hi(rr.x), bf_lo(rr.y), bf_hi(rr.y)}, r1 = {bf_lo(rr.z), bf_hi(rr.z), bf_lo(rr.w), bf_hi(rr.w)};
                    acc[ai][bj][m][0] = acc[ai][bj][m][0] * r0; acc[ai][bj][m][1] = acc[ai][bj][m][1] * r1; }
                asm volatile("" ::: "memory"); }
    }
    __device__ __forceinline__ void operator()(Acc& acc, const Unit& u, int wr, int wc, int fr, int fq) const {
        const int row0 = u.pm * 256 + wr * 64 + fr, col0 = u.pn * 256 + wc * 32 + 8 * fq;
#pragma unroll
        for (int ai = 0; ai < 2; ++ai)
#pragma unroll
            for (int m = 0; m < 4; ++m) { const size_t ro = (size_t)(row0 + ai * 128 + m * 16);
#pragma unroll
                for (int bj = 0; bj < 2; ++bj) { const u32x4 gb = *(const u32x4*)(MG + ro * 2048 + col0 + bj * 128 + 1024);
                    const f32x4 g0 = {bf_lo(gb.x), bf_hi(gb.x), bf_lo(gb.y), bf_hi(gb.y)}, g1 = {bf_lo(gb.z), bf_hi(gb.z), bf_lo(gb.w), bf_hi(gb.w)};
                    *(u32x4*)(MRG + ro * 1024 + col0 + bj * 128) = pack8(acc[ai][bj][m][0] * g0, acc[ai][bj][m][1] * g1); } }
    }
};
struct EpiRes {
    static constexpr bool HAS_MID = false;
    const float* base; float* out; const float* gate;
    __device__ __forceinline__ void operator()(Acc& acc, const Unit& u, int wr, int wc, int fr, int fq) const {
        const int row0 = u.pm * 256 + wr * 64 + fr, col0 = u.pn * 256 + wc * 32 + 8 * fq;
        const float* gp = gate + (size_t)((u.pm * 256) >> 11) * 6144 + col0;
        f32x4 gv[2][2];
#pragma unroll
        for (int bj = 0; bj < 2; ++bj)
#pragma unroll
            for (int n = 0; n < 2; ++n) gv[bj][n] = *(const f32x4*)(gp + bj * 128 + 4 * n);
#pragma unroll
        for (int ai = 0; ai < 2; ++ai)
#pragma unroll
            for (int m = 0; m < 4; ++m) { const size_t off = (size_t)(row0 + ai * 128 + m * 16) * 1024 + col0;
#pragma unroll
                for (int bj = 0; bj < 2; ++bj)
#pragma unroll
                    for (int n = 0; n < 2; ++n) { const f32x4 bs = *(const f32x4*)(base + off + bj * 128 + 4 * n);
                        *(f32x4*)(out + off + bj * 128 + 4 * n) = bs + gv[bj][n] * acc[ai][bj][m][n]; } }
    }
};
template <int mode> struct EpiResNorm {
    static constexpr bool HAS_MID = false;
    const float* base; float* out; const float* gate; int mode_unused;
    bf16_t* h2; const float* nw; const float* mod;
    float* xbuf; unsigned* cnt; LAS unsigned char* xl;
    __device__ __forceinline__ void operator()(Acc& acc, const Unit& u, int wr, int wc, int fr, int fq) const {
        const int wid = wr * 4 + wc, lane = fq * 16 + fr;
        const int row0 = u.pm * 256 + wr * 64 + fr, col0 = u.pn * 256 + wc * 32 + 8 * fq, bb = (u.pm * 256) >> 11;
        {
            const float* gp = gate + (size_t)bb * 6144 + col0;
            f32x4 gv[2][2];
#pragma unroll
            for (int bj = 0; bj < 2; ++bj)
#pragma unroll
                for (int n = 0; n < 2; ++n) gv[bj][n] = *(const f32x4*)(gp + bj * 128 + 4 * n);
#pragma unroll
            for (int ai = 0; ai < 2; ++ai)
#pragma unroll
                for (int m = 0; m < 4; ++m) { const size_t off = (size_t)(row0 + ai * 128 + m * 16) * 1024 + col0;
#pragma unroll
                    for (int bj = 0; bj < 2; ++bj)
#pragma unroll
                        for (int n = 0; n < 2; ++n) { const f32x4 bs = *(const f32x4*)(base + off + bj * 128 + 4 * n); acc[ai][bj][m][n] = bs + gv[bj][n] * acc[ai][bj][m][n]; }
                    asm volatile("" : "+v"(acc[ai][0][m][0]), "+v"(acc[ai][0][m][1]), "+v"(acc[ai][1][m][0]), "+v"(acc[ai][1][m][1]));
                    if (m & 1) asm volatile("" ::: "memory"); }
        }
        LAS float* P = (LAS float*)xl; LAS float* S = (LAS float*)(xl + 4096);
#pragma unroll
        for (int ai = 0; ai < 2; ++ai)
#pragma unroll
            for (int m = 0; m < 4; ++m) { float q = 0.f;
#pragma unroll
                for (int bj = 0; bj < 2; ++bj)
#pragma unroll
                    for (int n = 0; n < 2; ++n) { const f32x4 x = acc[ai][bj][m][n]; q += (x[0] * x[0] + x[1] * x[1]) + (x[2] * x[2] + x[3] * x[3]); }
                q += __shfl_xor(q, 16); q += __shfl_xor(q, 32);
                if (fq == 0) P[(ai * 128 + wr * 64 + m * 16 + fr) * 4 + wc] = q; }
        asm volatile("s_waitcnt lgkmcnt(0)\n\ts_barrier" ::: "memory");
        const int row = wid * 32 + (lane & 31);
        if (lane < 32) { const float tot = (P[row * 4 + 0] + P[row * 4 + 1]) + (P[row * 4 + 2] + P[row * 4 + 3]);
            __hip_atomic_store(xbuf + (size_t)(u.pm * 256 + row) * 4 + u.pn, tot, __ATOMIC_RELAXED, __HIP_MEMORY_SCOPE_AGENT); }
        asm volatile("s_waitcnt vmcnt(0)" ::: "memory");
        if (lane == 0) __hip_atomic_fetch_add(cnt + 64 * u.pm, 1u, __ATOMIC_RELAXED, __HIP_MEMORY_SCOPE_AGENT);
        if (wid == 0) {
            unsigned sp = 0;
            while ((unsigned)__builtin_amdgcn_readfirstlane(__hip_atomic_load(cnt + 64 * u.pm, __ATOMIC_RELAXED, __HIP_MEMORY_SCOPE_AGENT)) < 32u) { __builtin_amdgcn_s_sleep(2); if (++sp > (1u << 20)) break; }
            __builtin_amdgcn_fence(__ATOMIC_ACQUIRE, "agent");
        }
        asm volatile("s_waitcnt vmcnt(0) lgkmcnt(0)\n\ts_barrier" ::: "memory");
        if (lane < 32) { const float* sl = xbuf + (size_t)(u.pm * 256 + row) * 4; float t = 0.f;
#pragma unroll
            for (int k = 0; k < 4; ++k) t += __hip_atomic_load(sl + k, __ATOMIC_RELAXED, __HIP_MEMORY_SCOPE_AGENT);
            S[row] = rsqrtf(t * (1.f / 1024.f) + EPS); }
        asm volatile("s_waitcnt vmcnt(0) lgkmcnt(0)\n\ts_barrier" ::: "memory");
#pragma unroll
        for (int bj = 0; bj < 2; ++bj) {
            const int c = col0 + bj * 128;
            f32x4 w0 = *(const f32x4*)(nw + c), w1 = *(const f32x4*)(nw + c + 4), h0 = (f32x4){0.f, 0.f, 0.f, 0.f}, h1 = h0;
            if (mode == 0) { const float* mb = mod + (size_t)bb * 6144 + c; w0 = w0 * (*(const f32x4*)(mb + 4096) + 1.f); w1 = w1 * (*(const f32x4*)(mb + 4100) + 1.f); h0 = *(const f32x4*)(mb + 3072); h1 = *(const f32x4*)(mb + 3076); }
#pragma unroll
            for (int ai = 0; ai < 2; ++ai)
#pragma unroll
                for (int m = 0; m < 4; ++m) { asm volatile("" ::: "memory"); const int rl = ai * 128 + wr * 64 + m * 16 + fr; const float r = S[rl]; const size_t off = (size_t)(u.pm * 256 + rl) * 1024 + c;
                    const f32x4 v0 = acc[ai][bj][m][0], v1 = acc[ai][bj][m][1];
                    if (mode == 0) { *(f32x4*)(out + off) = v0; *(f32x4*)(out + off + 4) = v1; *(u32x4*)(h2 + off) = pack8((v0 * r) * w0 + h0, (v1 * r) * w1 + h1); }
                    else { *(f32x4*)(out + off) = (v0 * r) * w0; *(f32x4*)(out + off + 4) = (v1 * r) * w1; } }
        }
    }
};
struct EpiRelu2 {
    static constexpr bool HAS_MID = false;
    bf16_t* O; int ldc;
    __device__ __forceinline__ void operator()(Acc& acc, const Unit& u, int wr, int wc, int fr, int fq) const {
        const int row0 = u.pm * 256 + wr * 64 + fr, col0 = u.pn * 256 + wc * 32 + 8 * fq;
#pragma unroll
        for (int ai = 0; ai < 2; ++ai)
#pragma unroll
            for (int m = 0; m < 4; ++m) { bf16_t* rowp = O + (size_t)(row0 + ai * 128 + m * 16) * ldc + col0;
#pragma unroll
                for (int bj = 0; bj < 2; ++bj) { f32x4 v0 = acc[ai][bj][m][0], v1 = acc[ai][bj][m][1];
#pragma unroll
                    for (int j = 0; j < 4; ++j) { const float a = fmaxf(v0[j], 0.f), b = fmaxf(v1[j], 0.f); v0[j] = a * a; v1[j] = b * b; }
                    *(u32x4*)(rowp + bj * 128) = pack8(v0, v1); } }
    }
};

__device__ __forceinline__ int inproj_colmap(int n) {
    if (n < 512) return OFF_K + n;
    if (n < 768) { const int j = n - 512; return j < 32 ? OFF_IG + j : -1; }
    if (n < 1792) return OFF_V + (n - 768);
    if (n < 2304) return OFF_Q + (n - 1792);
    if (n < 6400) { const int lc = (n - 2304) & 255, jt = (n - 2304) >> 8, bj = lc >> 7, wc = (lc >> 5) & 3, fq = (lc >> 3) & 3, nn = (lc >> 2) & 1, jj = lc & 3;
        const int seg = 2 * bj + nn, ch = 64 * jt + 16 * wc + 4 * fq + jj;
        return (seg == 0 ? OFF_XIN : seg == 1 ? OFF_GC : seg == 2 ? OFF_GB : OFF_O) + ch; }
    { const int lc = (n - 6400) & 255, jt = (n - 6400) >> 8; return OFF_MRG + (lc >> 7) * 1024 + 128 * jt + (lc & 127); }
}
template <bool MAP>
__device__ __forceinline__ void transpose_item(const float* W, int ldw, int nblk, bf16_t* out, int ldo, int kofs, LAS float* scr, int item, int lane) {
    const int kb = item / nblk, nb = item % nblk, k0 = 64 * kb, n0 = 32 * nb;
    const int n4 = lane & 7, kr = lane >> 3;
    const int nn = n0 + 4 * n4; const int src = MAP ? inproj_colmap(nn) : nn;
    f32x4 v[8];
#pragma unroll
    for (int it = 0; it < 8; ++it) v[it] = (src >= 0) ? *(const f32x4*)(W + (size_t)(k0 + 8 * it + kr) * ldw + src) : (f32x4){0.f, 0.f, 0.f, 0.f};
#pragma unroll
    for (int it = 0; it < 8; ++it) { LAS float* d = scr + (8 * it + kr) * 33 + 4 * n4; d[0] = v[it][0]; d[1] = v[it][1]; d[2] = v[it][2]; d[3] = v[it][3]; }
    asm volatile("s_waitcnt lgkmcnt(0)" ::: "memory");
    const int c = lane & 7;
#pragma unroll
    for (int j = 0; j < 4; ++j) { const int n = (lane >> 3) + 8 * j; const LAS float* s = scr + (8 * c) * 33 + n;
        u32x4 o; o.x = cvt_pk_bf16(s[0 * 33], s[1 * 33]); o.y = cvt_pk_bf16(s[2 * 33], s[3 * 33]); o.z = cvt_pk_bf16(s[4 * 33], s[5 * 33]); o.w = cvt_pk_bf16(s[6 * 33], s[7 * 33]);
        *(u32x4*)(out + (size_t)(n0 + n) * ldo + kofs + k0 + 8 * c) = o; }
    asm volatile("s_waitcnt lgkmcnt(0)" ::: "memory");
}

struct Args { const float* in[18]; float* out; unsigned char* ws; int ph_lo, ph_hi; };
enum { I_X = 0, I_C, I_CTX, I_CCTX, I_WMOD, I_BMOD, I_N1W, I_WIN, I_BIN, I_CONVW, I_MNW, I_WCO, I_WMO, I_WOUT, I_N2W, I_WFF1, I_WFF2, I_FNW };

__device__ __forceinline__ void p0_prologue(const Args& A, LAS unsigned char* lds, int tid, int lane, int wave) {
    unsigned char* ws = A.ws;
    LAS float* scr = (LAS float*)(lds + wave * 16384);
    const int gw = blockIdx.x * 8 + wave, NGW = gridDim.x * 8;
    constexpr int IT_WIN = 16 * (NIN / 32), IT_SQ = 16 * 32, IT_W1 = 16 * 128, IT_W2 = 64 * 32;
    constexpr int NITEMS = IT_WIN + 3 * IT_SQ + IT_W1 + IT_W2;
    for (int it = gw; it < NITEMS; it += NGW) {
        int r = it;
        if (r < IT_WIN) { transpose_item<true>(A.in[I_WIN], DIN, NIN / 32, (bf16_t*)(ws + WS_WIN), 1024, 0, scr, r, lane); continue; } r -= IT_WIN;
        if (r < IT_SQ) { transpose_item<false>(A.in[I_WCO], 1024, 32, (bf16_t*)(ws + WS_BT2), 2048, 0, scr, r, lane); continue; } r -= IT_SQ;
        if (r < IT_SQ) { transpose_item<false>(A.in[I_WMO], 1024, 32, (bf16_t*)(ws + WS_BT2), 2048, 1024, scr, r, lane); continue; } r -= IT_SQ;
        if (r < IT_SQ) { transpose_item<false>(A.in[I_WOUT], 1024, 32, (bf16_t*)(ws + WS_WO), 1024, 0, scr, r, lane); continue; } r -= IT_SQ;
        if (r < IT_W1) { transpose_item<false>(A.in[I_WFF1], 4096, 128, (bf16_t*)(ws + WS_W1), 1024, 0, scr, r, lane); continue; } r -= IT_W1;
        transpose_item<false>(A.in[I_WFF2], 1024, 32, (bf16_t*)(ws + WS_W2), 4096, 0, scr, r, lane);
    }
    for (int i = blockIdx.x * 512 + tid; i < NIN; i += gridDim.x * 512) { const int s = inproj_colmap(i); ((float*)(ws + WS_BIASP))[i] = s >= 0 ? A.in[I_BIN][s] : 0.f; }
    __syncthreads();
    LAS float* sl = (LAS float*)lds;
    LAS float* red = (LAS float*)(lds + 17 * 4096);
    bool filled = false;
    for (int item = blockIdx.x; item < 6144 / 32; item += gridDim.x) {
        if (!filled) {
            for (int i = tid; i < 17 * 1024; i += 512) { const float v = i < 16 * 1024 ? A.in[I_C][i] : A.in[I_CCTX][i - 16 * 1024]; sl[i] = v * sigm(v); }
            __syncthreads(); filled = true;
        }
        const int col = lane & 31, kh = lane >> 5, n0 = item * 32, kbase = 128 * wave + 64 * kh;
        float a[17];
#pragma unroll
        for (int r = 0; r < 17; ++r) a[r] = 0.f;
        const float* wp = A.in[I_WMOD] + (size_t)kbase * 6144 + n0 + col;
        for (int i = 0; i < 64; i += 4) {
            const float w0 = wp[(size_t)(i + 0) * 6144], w1 = wp[(size_t)(i + 1) * 6144], w2 = wp[(size_t)(i + 2) * 6144], w3 = wp[(size_t)(i + 3) * 6144];
#pragma unroll
            for (int r = 0; r < 17; ++r) { const f32x4 s4 = *(const LAS f32x4*)(sl + r * 1024 + kbase + i); a[r] += s4[0] * w0 + s4[1] * w1 + s4[2] * w2 + s4[3] * w3; }
        }
#pragma unroll
        for (int r = 0; r < 17; ++r) red[((wave * 2 + kh) * 17 + r) * 32 + col] = a[r];
        __syncthreads();
        for (int o = tid; o < 17 * 32; o += 512) { const int r = o >> 5, cc = o & 31; float s = A.in[I_BMOD][n0 + cc];
#pragma unroll
            for (int p = 0; p < 16; ++p) s += red[(p * 17 + r) * 32 + cc];
            ((float*)(ws + WS_MOD))[r * 6144 + n0 + cc] = s; }
        __syncthreads();
    }
}

__device__ __forceinline__ float wave_allsum(float x) { return lane63(wave_scan_add(x)); }
__device__ __forceinline__ void modulate_rows4(const float* xrow, const float* w, const float* sh, const float* sc, bf16_t* orow, int lane) {
    f32x4 v[4][4]; float r[4];
#pragma unroll
    for (int q = 0; q < 4; ++q)
#pragma unroll
        for (int j = 0; j < 4; ++j) v[q][j] = ((const f32x4*)(xrow + (size_t)q * DM))[lane + 64 * j];
#pragma unroll
    for (int q = 0; q < 4; ++q) { float s = 0.f;
#pragma unroll
        for (int j = 0; j < 4; ++j) s += (v[q][j].x * v[q][j].x + v[q][j].y * v[q][j].y) + (v[q][j].z * v[q][j].z + v[q][j].w * v[q][j].w);
        r[q] = rsqrtf(wave_allsum(s) * (1.f / DM) + EPS); }
#pragma unroll
    for (int j = 0; j < 4; ++j) { const f32x4 ww = ((const f32x4*)w)[lane + 64 * j], hh = ((const f32x4*)sh)[lane + 64 * j], cc = ((const f32x4*)sc)[lane + 64 * j];
        const f32x4 wc = ww * (cc + 1.f);
#pragma unroll
        for (int q = 0; q < 4; ++q) { const f32x4 y = (v[q][j] * r[q]) * wc + hh;
            u32x2 p; p.x = cvt_pk_bf16(y[0], y[1]); p.y = cvt_pk_bf16(y[2], y[3]); ((u32x2*)(orow + (size_t)q * DM))[lane + 64 * j] = p; } }
}

constexpr int L_QS = 0, L_KS = 18432, L_KTS = 36864, L_VTS = 54272, L_SS = 93440, L_CS = 128256, L_GW = 148992;
static_assert(L_GW + 8 * 512 <= LDS_BYTES, "mlstm LDS map");
#define BAR_LDS() asm volatile("s_waitcnt lgkmcnt(0)\n\ts_barrier" ::: "memory")

__device__ __forceinline__ void mlstm_seq(LAS unsigned char* lds, const bf16_t* Kb, const bf16_t* VTb, const bf16_t* Qb, const float* Gb, bf16_t* HD0, bf16_t* HD1, int seq, int tid, int lane, int w) {
    const int dir = seq >> 7, b = (seq >> 3) & 15, head = seq & 7;
    const int g = lane >> 4, l15 = lane & 15;
    bf16_t* HD = dir ? HD1 : HD0;
    for (int i = tid; i < 16 * 136; i += 512) { const int r = i / 136, cidx = i % 136; *(LAS bf16_t*)(lds + L_VTS + (128 + r) * 272 + cidx * 2) = (r == 0) ? (bf16_t)0x3F80 : (bf16_t)0; }
    f32x4 st[4], nst;
#pragma unroll
    for (int i = 0; i < 4; ++i) st[i] = (f32x4){0.f, 0.f, 0.f, 0.f};
    nst = (f32x4){0.f, 0.f, 0.f, 0.f};
    float mstate = 0.f;
    u32x4 pq[2], pk[2], pv[4]; float gi0, gi1, gf0, gf1;
    const int krow = tid & 127, kpc = tid >> 7;
    unsigned offq[2], offk[2], offv[4], offg0, offg1;
#pragma unroll
    for (int i = 0; i < 2; ++i) { const int p = tid + 512 * i, row = p >> 3, pc = p & 7; offq[i] = (unsigned)((dir ? 127 - row : row) * 512 + head * 64 + pc * 8);
        offk[i] = (unsigned)((dir ? 127 - krow : krow) * 512 + head * 64 + (kpc + 4 * i) * 8); }
#pragma unroll
    for (int i = 0; i < 4; ++i) { const int p = tid + 512 * i, v = p >> 4, pc = p & 15; offv[i] = (unsigned)((head * 128 + v) * MALL + pc * 8); }
    offg0 = (unsigned)((dir ? 127 - lane : lane) * 32 + dir * 8 + head); offg1 = (unsigned)((dir ? 63 - lane : lane + 64) * 32 + dir * 8 + head);
#define PREFETCH(cc) do { const int cc_ = (cc); const bool isctx_ = cc_ < 2; const int T_ = isctx_ ? CTXL : SEQ, c_ = isctx_ ? cc_ : cc_ - 2; \
        const int base_ = isctx_ ? MTOK + b * CTXL : b * SEQ; const int tok0_ = base_ + (dir ? T_ - 128 * (c_ + 1) : 128 * c_); \
        const bf16_t* qb_ = Qb + (size_t)tok0_ * 512; const bf16_t* kb_ = Kb + (size_t)tok0_ * 512; const bf16_t* vb_ = VTb + tok0_; const float* gb_ = Gb + (size_t)tok0_ * 32; \
        if (!isctx_) { _Pragma("unroll") for (int i = 0; i < 2; ++i) pq[i] = *(const u32x4*)(qb_ + offq[i]); } \
        _Pragma("unroll") for (int i = 0; i < 2; ++i) pk[i] = *(const u32x4*)(kb_ + offk[i]); \
        _Pragma("unroll") for (int i = 0; i < 4; ++i) pv[i] = *(const u32x4*)(vb_ + offv[i]); \
        gi0 = gb_[offg0]; gf0 = gb_[offg0 + 16]; gi1 = gb_[offg1]; gf1 = gb_[offg1 + 16]; \
    } while (0)
    PREFETCH(0);
    for (int cc = 0; cc < 18; ++cc) {
        const bool isctx = cc < 2; const int T_ = isctx ? CTXL : SEQ, c_ = isctx ? cc : cc - 2;
        const int tok0 = (isctx ? MTOK + b * CTXL : b * SEQ) + (dir ? T_ - 128 * (c_ + 1) : 128 * c_);
        const float b0 = wave_scan_add(gf0), b1 = wave_scan_add(gf1) + lane63(b0);
        const float a0 = gi0 - b0, a1 = gi1 - b1;
        const float Mc = fmaxf(mstate, lane63(wave_scan_max(fmaxf(a0, a1))));
        const float e0 = __expf(a0 - Mc), e1 = __expf(a1 - Mc), th0 = __expf(-b0 - Mc), th1 = __expf(-b1 - Mc);
        const float decay = __expf(mstate - Mc);
        mstate = lane63(b1) + Mc;
#pragma unroll
        for (int db = 0; db < 4; ++db) { st[db] = st[db] * decay; u32x2 p; p.x = cvt_pk_bf16(st[db][0], st[db][1]); p.y = cvt_pk_bf16(st[db][2], st[db][3]);
            *(LAS u32x2*)(lds + L_CS + (16 * w + l15) * 144 + (16 * db + 4 * g) * 2) = p; }
        if (w < 4) { nst = nst * decay; u32x2 p; p.x = cvt_pk_bf16(nst[0], nst[1]); p.y = cvt_pk_bf16(nst[2], nst[3]);
            *(LAS u32x2*)(lds + L_CS + (128 + l15) * 144 + (16 * w + 4 * g) * 2) = p; }
        if (!isctx) {
#pragma unroll
            for (int i = 0; i < 2; ++i) { const int p = tid + 512 * i, row = p >> 3, pc = p & 7; *(LAS u32x4*)(lds + L_QS + row * 144 + pc * 16) = pq[i]; }
        }
        {
            const float es = (w & 1) ? e1 : e0; const int kidx = dir ? 127 - krow : krow;
#pragma unroll
            for (int i = 0; i < 2; ++i) { const int pc = kpc + 4 * i;
                const unsigned ww[4] = {pk[i].x, pk[i].y, pk[i].z, pk[i].w}; unsigned sc4[4];
#pragma unroll
                for (int q2 = 0; q2 < 4; ++q2) { const unsigned pkd = cvt_pk_bf16(bf_lo(ww[q2]) * es, bf_hi(ww[q2]) * es); sc4[q2] = pkd;
                    *(LAS bf16_t*)(lds + L_KTS + (pc * 8 + 2 * q2) * 272 + kidx * 2) = (bf16_t)(pkd & 0xffffu);
                    *(LAS bf16_t*)(lds + L_KTS + (pc * 8 + 2 * q2 + 1) * 272 + kidx * 2) = (bf16_t)(pkd >> 16); }
                *(LAS u32x4*)(lds + L_KS + krow * 144 + pc * 16) = (u32x4){sc4[0], sc4[1], sc4[2], sc4[3]}; }
#pragma unroll
            for (int i = 0; i < 4; ++i) { const int p = tid + 512 * i, v = p >> 4, pc = p & 15; *(LAS u32x4*)(lds + L_VTS + v * 272 + pc * 16) = pv[i]; }
        }
        BAR_LDS();
        if (cc + 1 < 18) PREFETCH(cc + 1);
        if (!isctx) {
            const int tb = (w < 4) ? 2 * w : 15 - 2 * w;
            const int trow = 16 * tb + l15;
            const int klo = dir ? ((7 - tb) >> 1) : 0, khi = dir ? 3 : (tb >> 1);
            bf16x8 qf[2];
#pragma unroll
            for (int kk = 0; kk < 2; ++kk) qf[kk] = *(const LAS bf16x8*)(lds + L_QS + trow * 144 + (kk * 32 + g * 8) * 2);
#pragma unroll
            for (int sb = 0; sb < 8; ++sb) {
                f32x4 sa = (f32x4){0.f, 0.f, 0.f, 0.f};
                if (sb <= tb) {
#pragma unroll
                    for (int kk = 0; kk < 2; ++kk) { const bf16x8 kf = *(const LAS bf16x8*)(lds + L_KS + (16 * sb + l15) * 144 + (kk * 32 + g * 8) * 2);
                        sa = __builtin_amdgcn_mfma_f32_16x16x32_bf16(kf, qf[kk], sa, 0, 0, 0); }
                    if (sb == tb) { const int s0 = 16 * sb + 4 * g;
#pragma unroll
                        for (int r = 0; r < 4; ++r) sa[r] = (s0 + r <= trow) ? sa[r] : 0.f; }
                }
                const int s0 = 16 * sb + 4 * g;
                u32x2 p;
                if (dir) { p.x = cvt_pk_bf16(sa[3], sa[2]); p.y = cvt_pk_bf16(sa[1], sa[0]); *(LAS u32x2*)(lds + L_SS + trow * 272 + (124 - s0) * 2) = p; }
                else { p.x = cvt_pk_bf16(sa[0], sa[1]); p.y = cvt_pk_bf16(sa[2], sa[3]); *(LAS u32x2*)(lds + L_SS + trow * 272 + s0 * 2) = p; }
            }
            f32x4 num[9];
#pragma unroll
            for (int vb = 0; vb < 9; ++vb) { num[vb] = (f32x4){0.f, 0.f, 0.f, 0.f};
#pragma unroll
                for (int kk = 0; kk < 2; ++kk) { const bf16x8 cf = *(const LAS bf16x8*)(lds + L_CS + (16 * vb + l15) * 144 + (kk * 32 + g * 8) * 2);
                    num[vb] = __builtin_amdgcn_mfma_f32_16x16x32_bf16(cf, qf[kk], num[vb], 0, 0, 0); } }
#pragma unroll
            for (int kk = 0; kk < 4; ++kk) {
                if (kk >= klo && kk <= khi) {
                    const bf16x8 sf = *(const LAS bf16x8*)(lds + L_SS + trow * 272 + (kk * 32 + g * 8) * 2);
#pragma unroll
                    for (int vb = 0; vb < 9; ++vb) { const bf16x8 vf = *(const LAS bf16x8*)(lds + L_VTS + (16 * vb + l15) * 272 + (kk * 32 + g * 8) * 2);
                        num[vb] = __builtin_amdgcn_mfma_f32_16x16x32_bf16(vf, sf, num[vb], 0, 0, 0); }
                }
            }
            const float den = __shfl(num[8][0], l15);
            const float thr = __shfl((tb < 4) ? th0 : th1, (16 * tb + l15) & 63);
            const float inv = 1.f / fmaxf(fabsf(den), thr);
            const int tok = tok0 + (dir ? 127 - trow : trow);
            bf16_t* hp = HD + (size_t)tok * 1024 + head * 128 + 4 * g;
#pragma unroll
            for (int vb = 0; vb < 8; ++vb) { u32x2 p; p.x = cvt_pk_bf16(num[vb][0] * inv, num[vb][1] * inv); p.y = cvt_pk_bf16(num[vb][2] * inv, num[vb][3] * inv); *(u32x2*)(hp + 16 * vb) = p; }
        }
        {
            bf16x8 vf[4];
#pragma unroll
            for (int kk = 0; kk < 4; ++kk) vf[kk] = *(const LAS bf16x8*)(lds + L_VTS + (16 * w + l15) * 272 + (kk * 32 + g * 8) * 2);
#pragma unroll
            for (int db = 0; db < 4; ++db)
#pragma unroll
                for (int kk = 0; kk < 4; ++kk) { const bf16x8 kf = *(const LAS bf16x8*)(lds + L_KTS + (16 * db + l15) * 272 + (kk * 32 + g * 8) * 2);
                    st[db] = __builtin_amdgcn_mfma_f32_16x16x32_bf16(kf, vf[kk], st[db], 0, 0, 0); }
            if (w < 4) {
#pragma unroll
                for (int kk = 0; kk < 4; ++kk) { const bf16x8 kf = *(const LAS bf16x8*)(lds + L_KTS + (16 * w + l15) * 272 + (kk * 32 + g * 8) * 2);
                    const bf16x8 of = *(const LAS bf16x8*)(lds + L_VTS + (128 + l15) * 272 + (kk * 32 + g * 8) * 2);
                    nst = __builtin_amdgcn_mfma_f32_16x16x32_bf16(kf, of, nst, 0, 0, 0); }
            }
        }
        BAR_LDS();
    }
#undef PREFETCH
}

__device__ __forceinline__ void combine_rows4(const bf16_t* h0, const bf16_t* h1, bf16_t* ab, const float* nw, int lane) {
    u32x4 a[4][2], b[4][2], o[4][2];
#pragma unroll
    for (int q = 0; q < 4; ++q)
#pragma unroll
        for (int i = 0; i < 2; ++i) { const int p = lane + 64 * i;
            a[q][i] = *(const u32x4*)(h0 + (size_t)q * 1024 + 8 * p); b[q][i] = *(const u32x4*)(h1 + (size_t)q * 1024 + 8 * p); o[q][i] = *(const u32x4*)(ab + (size_t)q * 2048 + 8 * p); }
#pragma unroll
    for (int i = 0; i < 2; ++i) { const int p = lane + 64 * i;
        const f32x4 n0 = *(const f32x4*)(nw + 8 * p), n1 = *(const f32x4*)(nw + 8 * p + 4);
#pragma unroll
        for (int q = 0; q < 4; ++q) { const u32x4 aa = a[q][i], bb = b[q][i], oo = o[q][i];
            float s[8] = {bf_lo(aa.x) + bf_lo(bb.x), bf_hi(aa.x) + bf_hi(bb.x), bf_lo(aa.y) + bf_lo(bb.y), bf_hi(aa.y) + bf_hi(bb.y), bf_lo(aa.z) + bf_lo(bb.z), bf_hi(aa.z) + bf_hi(bb.z), bf_lo(aa.w) + bf_lo(bb.w), bf_hi(aa.w) + bf_hi(bb.w)};
            float ss = 0.f;
#pragma unroll
            for (int j = 0; j < 8; ++j) ss += s[j] * s[j];
            ss += dppf<0x121>(0.f, ss); ss += dppf<0x122>(0.f, ss); ss += dppf<0x124>(0.f, ss); ss += dppf<0x128>(0.f, ss);
            const float r = rsqrtf(ss * (1.f / 128.f) + EPS);
            const float og[8] = {bf_lo(oo.x), bf_hi(oo.x), bf_lo(oo.y), bf_hi(oo.y), bf_lo(oo.z), bf_hi(oo.z), bf_lo(oo.w), bf_hi(oo.w)};
            u32x4 qv;
            qv.x = cvt_pk_bf16(s[0] * r * n0[0] * og[0], s[1] * r * n0[1] * og[1]); qv.y = cvt_pk_bf16(s[2] * r * n0[2] * og[2], s[3] * r * n0[3] * og[3]);
            qv.z = cvt_pk_bf16(s[4] * r * n1[0] * og[4], s[5] * r * n1[1] * og[5]); qv.w = cvt_pk_bf16(s[6] * r * n1[2] * og[6], s[7] * r * n1[3] * og[7]);
            *(u32x4*)(ab + (size_t)q * 2048 + 8 * p) = qv; } }
}

#define XB_TMO      128
#define XB_XCNT(j)  (256  + 64 * (j))
#define XB_XSUB(j)  (1280 + 64 * (j))
#define XB_XGEN(j)  (2304 + 64 * (j))
#define XB_TOP      3328
#define XB_TOPGEN   3392
#define XCD_BAR_WORDS 3456
#define XB_SPIN_CAP (1u << 18)
__device__ __forceinline__ unsigned xb_ld(unsigned* p)              { return __hip_atomic_load(p, __ATOMIC_RELAXED, __HIP_MEMORY_SCOPE_AGENT); }
__device__ __forceinline__ unsigned xb_add(unsigned* p, unsigned v) { return __hip_atomic_fetch_add(p, v, __ATOMIC_RELAXED, __HIP_MEMORY_SCOPE_AGENT); }
__device__ __forceinline__ unsigned xb_xcc_id() { return (unsigned)__builtin_amdgcn_s_getreg((3 << 11) | 20) & 0xFu; }
#define XB_SPIN(cond, bar) do { unsigned _sp = 0; while (cond) { __builtin_amdgcn_s_sleep(1); \
    if ((++_sp & 255u) == 0u) { if (xb_ld(&(bar)[XB_TMO])) break; if (_sp > XB_SPIN_CAP) { atomicAdd(&(bar)[XB_TMO], 1u); break; } } } } while (0)
struct XcdBarrier { unsigned* bar; unsigned x; volatile LAS unsigned* st; };
__device__ __forceinline__ XcdBarrier xcd_barrier_post(unsigned* bar, volatile LAS unsigned* st) {
    XcdBarrier b; b.bar = bar; b.x = xb_xcc_id(); b.st = st;
    if (threadIdx.x == 0) (void)xb_add(&bar[XB_XCNT(b.x)], 1u);
    return b;
}
__device__ __forceinline__ void xcd_barrier_complete(unsigned* bar, unsigned x, unsigned& nloc, unsigned& nx) {
    const unsigned G = gridDim.x * gridDim.y * gridDim.z;
    unsigned sum, cnt, mine, sp = 0u;
    for (;;) {
        sum = 0u; cnt = 0u; mine = 0u;
#pragma unroll
        for (unsigned j = 0; j < 16; ++j) { const unsigned c = xb_ld(&bar[XB_XCNT(j)]); sum += c; cnt += (c > 0u) ? 1u : 0u; mine = (j == x) ? c : mine; }
        if (sum == G) break;
        __builtin_amdgcn_s_sleep(1);
        if ((++sp & 255u) == 0u) { if (xb_ld(&bar[XB_TMO])) break; if (sp > XB_SPIN_CAP) { atomicAdd(&bar[XB_TMO], 1u); break; } }
    }
    nloc = mine > 0u ? mine : 1u; nx = cnt > 0u ? cnt : 1u;
}
__device__ __forceinline__ void xcd_barrier(const XcdBarrier& b) {
    asm volatile("s_waitcnt vmcnt(0)" ::: "memory");
    __syncthreads();
    if (threadIdx.x == 0) {
        unsigned* bar = b.bar;
        __builtin_amdgcn_s_waitcnt(0);
        unsigned nloc = b.st[0], nx = b.st[1];
        if (nloc == 0u) { xcd_barrier_complete(bar, b.x, nloc, nx); b.st[0] = nloc; b.st[1] = nx; }
        const unsigned old = xb_add(&bar[XB_XSUB(b.x)], 1u);
        const unsigned gen = old / nloc;
        if (old + 1u == (gen + 1u) * nloc) {
            __builtin_amdgcn_fence(__ATOMIC_RELEASE, "agent");
            asm volatile("s_waitcnt vmcnt(0)" ::: "memory");
            const unsigned og = xb_add(&bar[XB_TOP], 1u);
            const unsigned tg = og / nx;
            if (og + 1u == (tg + 1u) * nx) xb_add(&bar[XB_TOPGEN], 1u);
            else XB_SPIN(xb_ld(&bar[XB_TOPGEN]) == tg, bar);
            __builtin_amdgcn_fence(__ATOMIC_ACQUIRE, "agent");
            xb_add(&bar[XB_XGEN(b.x)], 1u);
            asm volatile("s_waitcnt vmcnt(0)" ::: "memory");
        } else {
            XB_SPIN(xb_ld(&bar[XB_XGEN(b.x)]) == gen, bar);
            __builtin_amdgcn_fence(__ATOMIC_ACQUIRE, "agent");
            asm volatile("s_waitcnt vmcnt(0)" ::: "memory");
        }
    }
    __syncthreads();
}

constexpr int N_PHASES = 11;
__global__ void __launch_bounds__(512, 2) mk_fwd(Args A) {
    extern __shared__ __attribute__((aligned(16))) unsigned char lds_raw[];
    LAS unsigned char* lds = (LAS unsigned char*)lds_raw;
    cg::grid_group grid = cg::this_grid();
    const int tid = threadIdx.x, lane = tid & 63, wave = __builtin_amdgcn_readfirstlane(tid >> 6);
    const int G = gridDim.x, gw = blockIdx.x * 8 + wave, NGW = G * 8;
    unsigned char* ws = A.ws;
    const float* mod = (const float*)(ws + WS_MOD);
    bf16_t* H = (bf16_t*)(ws + WS_H);
    const int lo = A.ph_lo, hi = A.ph_hi;
#ifndef PHMASK
#define PHMASK 0x7ff
#endif
#ifndef REPMASK
#define REPMASK 0
#endif
#ifndef XSYNC
#define XSYNC 0
#endif
#define REP(k) for (int rep_ = 0; rep_ < 1 + ((REPMASK >> (k)) & 1); ++rep_)
#define IN(k) (((PHMASK >> (k)) & 1) && lo <= (k) && (k) < hi)
    unsigned* barw = (unsigned*)(ws + WS_BAR);
    volatile LAS unsigned* bst = (volatile LAS unsigned*)(lds + LDS_BYTES - 16);
    if (tid < 4) bst[tid] = 0u;
    if (lo == 0 && blockIdx.x == 0) { for (int i = tid; i < XCD_BAR_WORDS; i += 512) barw[i] = 0u; for (int i = tid; i < 2 * 128 * 64; i += 512) ((unsigned*)(ws + WS_CNT))[i] = 0u; }
    __syncthreads();
    XcdBarrier xbar; xbar.bar = barw; xbar.x = 0; xbar.st = bst;
#define SEAM(k) do { if (IN(k) && IN((k) + 1)) xcd_barrier(xbar); } while (0)

    if (IN(0)) REP(0) { p0_prologue(A, lds, tid, lane, wave); __syncthreads(); }
    if (IN(0) && IN(1)) { grid.sync(); xbar = xcd_barrier_post(barw, bst); }
    for (int xs_ = 0; xs_ < XSYNC; ++xs_) xcd_barrier(xbar);
    if (IN(1)) REP(1) {
        for (int row = 4 * gw; row < MALL; row += 4 * NGW) {
            const bool isx = row < MTOK; const int bb = isx ? (row >> 11) : 16;
            const float* xr = isx ? A.in[I_X] + (size_t)row * DM : A.in[I_CTX] + (size_t)(row - MTOK) * DM;
            modulate_rows4(xr, A.in[I_N1W], mod + bb * 6144, mod + bb * 6144 + 1024, H + (size_t)row * DM, lane);
        }
    }
    SEAM(1);
    if (IN(2)) REP(2) {
        pg8::Gemm g{H, (const bf16_t*)(ws + WS_WIN), 1024, 1024, 1024}; pg8::InProjOrder S{G, (int)blockIdx.x};
        EpiInProj E{(bf16_t*)(ws + WS_K), (bf16_t*)(ws + WS_VT), (bf16_t*)(ws + WS_Q), (float*)(ws + WS_G), (bf16_t*)(ws + WS_AB), (bf16_t*)A.out, (const float*)(ws + WS_BIASP), A.in[I_CONVW]};
        pg8::gemm_phase<EpiInProj, pg8::InProjOrder>(lds, g, S, E);
    }
    SEAM(2);
    if (IN(3)) REP(3) {
        for (int seq = blockIdx.x; seq < 256; seq += G)
            mlstm_seq(lds, (const bf16_t*)(ws + WS_K), (const bf16_t*)(ws + WS_VT), (const bf16_t*)(ws + WS_Q), (const float*)(ws + WS_G), (bf16_t*)(ws + WS_H), (bf16_t*)(ws + WS_HD1), seq, tid, lane, wave);
    }
    SEAM(3);
    if (IN(4)) {
        for (int row = 4 * gw; row < MTOK; row += 4 * NGW)
            combine_rows4((const bf16_t*)(ws + WS_H) + (size_t)row * 1024, (const bf16_t*)(ws + WS_HD1) + (size_t)row * 1024, (bf16_t*)(ws + WS_AB) + (size_t)row * 2048 + 1024, A.in[I_MNW], lane);
    }
    SEAM(4);
    if (IN(5)) REP(5) {
        pg8::Gemm g{(const bf16_t*)(ws + WS_AB), (const bf16_t*)(ws + WS_BT2), 1024, 2048, 2048}; pg8::SplitKOrder S; S.base.init(MTOK, 1024, G, (int)blockIdx.x);
        EpiG2 E{(const bf16_t*)A.out, (bf16_t*)(ws + WS_H)};
        pg8::gemm_phase<EpiG2, pg8::SplitKOrder>(lds, g, S, E);
    }
    SEAM(5);
    if (IN(6)) REP(6) {
        pg8::Gemm g{(const bf16_t*)(ws + WS_H), (const bf16_t*)(ws + WS_WO), 1024, 1024, 1024}; pg8::StaticOrder S; S.init(MTOK, 1024, G, (int)blockIdx.x);
        EpiResNorm<0> E{A.in[I_X], A.out, mod + 2048, 0, H, A.in[I_N2W], mod, (float*)(ws + WS_XBUF), (unsigned*)(ws + WS_CNT), lds + 131072};
        pg8::gemm_phase<EpiResNorm<0>, pg8::StaticOrder>(lds, g, S, E);
    }
    SEAM(6);
    if (IN(8)) REP(8) {
        pg8::Gemm g{H, (const bf16_t*)(ws + WS_W1), 1024, 1024, 1024}; pg8::StaticOrder S; S.init(MTOK, DFF, G, (int)blockIdx.x);
        EpiRelu2 E{(bf16_t*)(ws + WS_F1), DFF};
        pg8::gemm_phase<EpiRelu2, pg8::StaticOrder>(lds, g, S, E);
    }
    SEAM(8);
    if (IN(9)) {
        pg8::Gemm g{(const bf16_t*)(ws + WS_F1), (const bf16_t*)(ws + WS_W2), DFF, DFF, DFF}; pg8::StaticOrder S; S.init(MTOK, 1024, G, (int)blockIdx.x);
        EpiResNorm<1> E{A.out, A.out, mod + 5120, 1, nullptr, A.in[I_FNW], mod, (float*)(ws + WS_XBUF) + (size_t)MTOK * 4, (unsigned*)(ws + WS_CNT) + 128 * 64, lds + 131072};
        pg8::gemm_phase<EpiResNorm<1>, pg8::StaticOrder>(lds, g, S, E);
    }
#undef IN
#undef SEAM
}

#ifndef MK_N_LAUNCHES
#define MK_N_LAUNCHES 1
#endif
extern "C" void kernel_launch(void* const* d_in, const int* in_sizes, int n_in, void* d_out, int out_size, void* d_ws, size_t ws_size, hipStream_t stream) {
    static int grid = 0;
    if (grid == 0) {
        if (n_in != 18 || out_size != MTOK * DM || ws_size < WS_END) { fprintf(stderr, "kernel_launch: unexpected shapes (n_in %d out %d ws %zu)\n", n_in, out_size, ws_size); grid = -1; return; }
        int dev = 0, cus = 0, per_cu = 0;
        hipGetDevice(&dev); hipDeviceGetAttribute(&cus, hipDeviceAttributeMultiprocessorCount, dev);
        hipFuncSetAttribute((const void*)mk_fwd, hipFuncAttributeMaxDynamicSharedMemorySize, LDS_BYTES);
        if (hipOccupancyMaxActiveBlocksPerMultiprocessor(&per_cu, (const void*)mk_fwd, 512, LDS_BYTES) != hipSuccess || per_cu < 1) { fprintf(stderr, "kernel_launch: occupancy query says %d\n", per_cu); per_cu = 1; }
        (void)hipGetLastError();
        grid = cus * per_cu;
        if (grid > 256) grid = 256;
    }
    if (grid < 0) return;
    Args a{};
    for (int i = 0; i < 18; ++i) a.in[i] = (const float*)d_in[i];
    a.out = (float*)d_out; a.ws = (unsigned char*)d_ws;
#if MK_N_LAUNCHES == 1
    a.ph_lo = 0; a.ph_hi = N_PHASES;
    void* args[] = {&a};
    hipError_t e = hipLaunchCooperativeKernel((const void*)mk_fwd, dim3(grid), dim3(512), args, LDS_BYTES, stream);
    if (e != hipSuccess) fprintf(stderr, "cooperative launch failed: %s (grid %d)\n", hipGetErrorString(e), grid);
#else
    for (int p = 0; p < N_PHASES; ++p) { a.ph_lo = p; a.ph_hi = p + 1; hipLaunchKernelGGL(mk_fwd, dim3(grid), dim3(512), LDS_BYTES, stream, a); }
#endif
}
```

```cpp
#include <hip/hip_runtime.h>
#include <hip/hip_cooperative_groups.h>
#include <cstdio>
#include <cstdint>
namespace cg = cooperative_groups;

#define LAS __attribute__((address_space(3)))
typedef unsigned short bf16_t;
typedef short bf16x8 __attribute__((ext_vector_type(8)));
typedef float f32x4 __attribute__((ext_vector_type(4)));
typedef unsigned u32x4 __attribute__((ext_vector_type(4)));
typedef unsigned u32x2 __attribute__((ext_vector_type(2)));

constexpr int DM = 1024, NB = 16, SEQ = 2048, CTXL = 256, NH = 8, DK = 64, DV = 128, DFF = 4096;
constexpr int MTOK = NB * SEQ;
constexpr int MCTX = NB * CTXL;
constexpr int MALL = MTOK + MCTX;
constexpr int DIN = 8224, NIN = 8448;
constexpr float EPS = 1e-6f;
constexpr int OFF_K = 0, OFF_V = 512, OFF_IG = 1536, OFF_Q = 1568, OFF_O = 2080, OFF_XIN = 3104, OFF_GC = 4128, OFF_GB = 5152, OFF_MRG = 6176;

constexpr size_t MiB = 1u << 20;
constexpr size_t WS_MOD = 0;
constexpr size_t WS_BIASP = 512 * 1024;
constexpr size_t WS_BAR = 768 * 1024;
constexpr size_t WS_MODCNT = 900 * 1024;
constexpr size_t WS_CNT = 800 * 1024;
constexpr size_t WS_XBUF = 450 * MiB;
constexpr size_t WS_WIN = 1 * MiB;
constexpr size_t WS_BT2 = 18 * MiB;
constexpr size_t WS_WO = 22 * MiB;
constexpr size_t WS_W1 = 24 * MiB;
constexpr int F1P = DFF + 64;
constexpr size_t WS_W2 = 452 * MiB;
constexpr size_t WS_H = 40 * MiB;
constexpr size_t WS_K = 112 * MiB;
constexpr size_t WS_VT = 148 * MiB;
constexpr size_t WS_Q = 220 * MiB;
constexpr size_t WS_G = 252 * MiB;
constexpr size_t WS_AB = 258 * MiB;
constexpr size_t WS_HD1 = 386 * MiB;
constexpr size_t WS_F1 = 112 * MiB;
constexpr size_t WS_END = 462 * MiB;

constexpr int LDS_BYTES = 155648;

typedef float f32x2_t __attribute__((ext_vector_type(2))); typedef __bf16 bf16x2_t __attribute__((ext_vector_type(2)));
__device__ __forceinline__ unsigned cvt_pk_bf16(float lo, float hi) { const f32x2_t v = {lo, hi}; const bf16x2_t b = __builtin_convertvector(v, bf16x2_t); return __builtin_bit_cast(unsigned, b); }
__device__ __forceinline__ float bf_lo(unsigned w) { return __uint_as_float(w << 16); }
__device__ __forceinline__ float bf_hi(unsigned w) { return __uint_as_float(w & 0xffff0000u); }
__device__ __forceinline__ float sigm(float x) { return __builtin_amdgcn_rcpf(1.f + __expf(-x)); }
__device__ __forceinline__ float wave_sum(float v) {
#pragma unroll
    for (int o = 1; o < 64; o <<= 1) v += __shfl_xor(v, o);
    return v;
}
__device__ __forceinline__ float wave_max(float v) {
#pragma unroll
    for (int o = 1; o < 64; o <<= 1) v = fmaxf(v, __shfl_xor(v, o));
    return v;
}
template <int CTRL, int RM = 0xf> __device__ __forceinline__ float dppf(float old, float src) {
    return __int_as_float(__builtin_amdgcn_update_dpp(__float_as_int(old), __float_as_int(src), CTRL, RM, 0xf, false));
}
__device__ __forceinline__ float wave_scan_add(float x) {
    x += dppf<0x111>(0.f, x); x += dppf<0x112>(0.f, x); x += dppf<0x114>(0.f, x); x += dppf<0x118>(0.f, x);
    x += dppf<0x142, 0xA>(0.f, x); x += dppf<0x143, 0xC>(0.f, x); return x;
}
__device__ __forceinline__ float wave_scan_max(float x) {
    const float ninf = -INFINITY;
    x = fmaxf(x, dppf<0x111>(ninf, x)); x = fmaxf(x, dppf<0x112>(ninf, x)); x = fmaxf(x, dppf<0x114>(ninf, x)); x = fmaxf(x, dppf<0x118>(ninf, x));
    x = fmaxf(x, dppf<0x142, 0xA>(ninf, x)); x = fmaxf(x, dppf<0x143, 0xC>(ninf, x)); return x;
}
__device__ __forceinline__ float lane63(float x) { return __int_as_float(__builtin_amdgcn_readlane(__float_as_int(x), 63)); }
__device__ __forceinline__ float logsig(float x) { return fminf(x, 0.f) - __logf(1.f + __expf(-fabsf(x))); }

namespace pg8 {
constexpr int BM = 256, BK = 64, HALF = 128, HTB = HALF * BK * 2, STAGE_BYTES = 8 * HTB, NXCD = 8, WGM = 8;
__host__ __device__ __forceinline__ int lds_byte(int r, int c) { const int st = (r >> 4) * 2 + (c >> 5), rr = r & 15, cc = c & 31, ob = rr * 64 + cc * 2; return st * 1024 + (ob ^ (((ob >> 9) & 1) << 5)); }
__host__ __device__ __forceinline__ void stage_rc(int b, int& R, int& C) { const int st = b / 1024, sb = b % 1024, swz = sb ^ (((sb >> 9) & 1) << 5); R = (st >> 1) * 16 + swz / 64; C = (st & 1) * 32 + (swz % 64) / 2; }
__host__ __device__ __forceinline__ int perm32(int rho) { const int n = rho >> 4, i = rho & 15; return 8 * (i >> 2) + 4 * n + (i & 3); }

struct Unit { int pm, pn, sw, h; };
struct Gemm { const bf16_t* A; const bf16_t* Bt; int K, lda, ldb, atile; };

__device__ __forceinline__ void rect_map(int l, int nM, int nN, int& pm, int& pn) {
    const int nig = WGM * nN, gid = l / nig, fm = gid * WGM, gsz = (nM - fm) < WGM ? (nM - fm) : WGM, rem = l % nig;
    pm = fm + rem % gsz; pn = rem / gsz;
}
struct StaticOrder {
    int nM, nN, nwg, G, c, rev = 0;
    __device__ void init(int M, int N, int G_, int c_) { nM = M / BM; nN = N / BM; nwg = nM * nN; G = G_; c = c_; }
    __device__ bool next(int i, Unit& u) const {
        const long L = (long)i * G + c; if (L >= nwg) return false;
        int wgid = (int)L; { const int q = nwg / NXCD, r = nwg % NXCD, xcd = wgid % NXCD, off = wgid / NXCD; wgid = (xcd < r ? xcd * (q + 1) : r * (q + 1) + (xcd - r) * q) + off; }
        rect_map(wgid, nM, nN, u.pm, u.pn); if (rev) u.pm = nM - 1 - u.pm; u.sw = 0; u.h = 0; return true;
    }
};
struct InProjOrder {
    int G, c;
    static constexpr int N_RC = 128 * 26, N_RB = 144 * 4, N_RA = 144 * 3, NWG = N_RC + N_RB + N_RA;
    __device__ bool next(int i, Unit& u) const {
        const long L = (long)i * G + c; if (L >= NWG) return false;
        int w = (int)L; w = (w % NXCD) * (NWG / NXCD) + w / NXCD;
        int a, b; u.h = 0;
        if (w < N_RC) { rect_map(w, 128, 26, a, b); u.pm = a; u.pn = 7 + b; u.sw = 0; }
        else if (w < N_RC + N_RB) { rect_map(w - N_RC, 144, 4, a, b); u.pm = 3 + b; u.pn = a; u.sw = 1; }
        else { rect_map(w - N_RC - N_RB, 144, 3, a, b); u.pm = a; u.pn = b; u.sw = 0; }
        return true;
    }
};
static_assert(InProjOrder::NWG % NXCD == 0, "in-proj unit count");
struct SplitKOrder {
    StaticOrder base;
    __device__ bool next(int i, Unit& u) const { if (!base.next(i >> 1, u)) return false; u.h = i & 1; return true; }
};

template <class Epi, class Sched>
__device__ __forceinline__ void gemm_phase(LAS unsigned char* lds, const Gemm g, const Sched& S, const Epi& E) {
    const int tid = threadIdx.x, wid = __builtin_amdgcn_readfirstlane(tid >> 6), lane = tid & 63, wr = wid >> 2, wc = wid & 3, fr = lane & 15, fq = lane >> 4;
    const int K = g.K, nt = K / BK;
    unsigned voffA[2], voffB[2];
#pragma unroll
    for (int i = 0; i < 2; ++i) { int R, C; stage_rc(tid * 16 + i * 8192, R, C); const int Rb = (R & ~31) + perm32(R & 31);
        voffA[i] = g.atile ? (unsigned)(R * BK + C) * 2u : (unsigned)(R * g.lda + C) * 2u; voffB[i] = (unsigned)(Rb * g.ldb + C) * 2u; }
    const size_t kstep = (size_t)(BK * 2), kstepA = g.atile ? (size_t)HTB : kstep;
    const size_t hstepA = g.atile ? (size_t)(g.lda / BK) * HTB : (size_t)HALF * g.lda * 2, hstepB = (size_t)HALF * g.ldb * 2;
    const unsigned ldsw = (unsigned)wid * 1024u;
    const int aoff = lds_byte(wr * 64 + fr, fq * 8), boff = lds_byte(wc * 32 + fr, fq * 8);
#define PG8_SA(b, h) (((b) * 2 + (h)) * HTB)
#define PG8_SB(b, h) ((4 + (b) * 2 + (h)) * HTB)
#define PG8_STAGE(bufoff, gbase, voff) do { _Pragma("unroll") for (int _i = 0; _i < 2; ++_i) \
        __builtin_amdgcn_global_load_lds((const unsigned*)((const char*)(gbase) + (voff)[_i]), (LAS unsigned*)(lds + (bufoff) + ldsw + _i * 8192), 16, 0, 0); } while (0)
#define PG8_LDA(dst, b, h) do { _Pragma("unroll") for (int m = 0; m < 4; ++m) _Pragma("unroll") for (int k = 0; k < 2; ++k) dst[m][k] = *(const LAS bf16x8*)(lds + PG8_SA(b, h) + aoff + m * 2048 + k * 1024); } while (0)
#define PG8_LDB(dst, b, h) do { _Pragma("unroll") for (int n = 0; n < 2; ++n) _Pragma("unroll") for (int k = 0; k < 2; ++k) dst[n][k] = *(const LAS bf16x8*)(lds + PG8_SB(b, h) + boff + n * 2048 + k * 1024); } while (0)
#define PG8_MMA(ai, bj, At, Bt) do { __builtin_amdgcn_s_setprio(1); _Pragma("unroll") for (int m = 0; m < 4; ++m) _Pragma("unroll") for (int n = 0; n < 2; ++n) _Pragma("unroll") for (int k = 0; k < 2; ++k) \
        acc[ai][bj][m][n] = __builtin_amdgcn_mfma_f32_16x16x32_bf16(Bt[n][k], At[m][k], acc[ai][bj][m][n], 0, 0, 0); __builtin_amdgcn_s_setprio(0); } while (0)
#define PG8_WAIT_V(n) asm volatile("s_waitcnt vmcnt(" #n ")" ::: "memory")
#define PG8_WAIT_L(n) asm volatile("s_waitcnt lgkmcnt(" #n ")" ::: "memory")
#define PG8_BAR __builtin_amdgcn_s_barrier()
#define PG8_SCHED __builtin_amdgcn_sched_barrier(0)
#define PG8_PA(u) ((const char*)((u).sw ? g.Bt : g.A) + (size_t)(u).pm * 2 * hstepA + (size_t)(u).h * K * 2)
#define PG8_PB(u) ((const char*)((u).sw ? g.A : g.Bt) + (size_t)(u).pn * 2 * hstepB + (size_t)(u).h * K * 2)
    Unit cur, nxt; int ui = 0;
    if (!S.next(0, cur)) return;
    f32x4 acc[2][2][4][2];
#pragma unroll
    for (int a = 0; a < 2; ++a)
#pragma unroll
        for (int b = 0; b < 2; ++b)
#pragma unroll
            for (int m = 0; m < 4; ++m)
#pragma unroll
                for (int n = 0; n < 2; ++n) acc[a][b][m][n] = (f32x4){0.f, 0.f, 0.f, 0.f};
    bf16x8 At[4][2], B0[2][2], B1[2][2];
    const char* cA = PG8_PA(cur); const char* cB = PG8_PB(cur);
    PG8_STAGE(PG8_SB(0, 0), cB, voffB); PG8_STAGE(PG8_SB(0, 1), cB + hstepB, voffB); PG8_STAGE(PG8_SA(0, 0), cA, voffA); PG8_STAGE(PG8_SA(0, 1), cA + hstepA, voffA);
    if (wr == 1) PG8_BAR;
    PG8_WAIT_V(2); PG8_BAR;
    PG8_STAGE(PG8_SB(1, 0), cB + kstep, voffB); PG8_STAGE(PG8_SA(1, 0), cA + kstepA, voffA); PG8_STAGE(PG8_SB(1, 1), cB + hstepB + kstep, voffB);
    PG8_WAIT_V(6); PG8_BAR;
    for (;;) {
        const bool has_next = S.next(ui + 1, nxt);
        const char* nA = has_next ? PG8_PA(nxt) : cA; const char* nB = has_next ? PG8_PB(nxt) : cB;
        for (int t = 0; t < nt; t += 2) {
            const bool last = (t == nt - 2);
            const char* a1 = cA + (size_t)(t + 1) * kstepA;
            const char* a2 = last ? nA : cA + (size_t)(t + 2) * kstepA; const char* b2 = last ? nB : cB + (size_t)(t + 2) * kstep;
            const char* a3 = a2 + kstepA; const char* b3 = b2 + kstep;
            PG8_LDB(B0, 0, 0); PG8_LDB(B1, 0, 1); PG8_SCHED; PG8_LDA(At, 0, 0); PG8_STAGE(PG8_SA(1, 1), a1 + hstepA, voffA);
            PG8_WAIT_V(8); PG8_WAIT_L(0); PG8_BAR; PG8_MMA(0, 0, At, B0); PG8_MMA(0, 1, At, B1); PG8_BAR; PG8_SCHED;
            PG8_LDA(At, 0, 1); PG8_STAGE(PG8_SB(0, 0), b2, voffB); PG8_STAGE(PG8_SB(0, 1), b2 + hstepB, voffB); PG8_STAGE(PG8_SA(0, 0), a2, voffA);
            PG8_WAIT_V(8); PG8_WAIT_L(0); PG8_BAR; PG8_MMA(1, 0, At, B0); PG8_MMA(1, 1, At, B1); PG8_BAR; PG8_SCHED;
            PG8_LDB(B0, 1, 0); PG8_LDB(B1, 1, 1); PG8_SCHED; PG8_LDA(At, 1, 0); PG8_STAGE(PG8_SA(0, 1), a2 + hstepA, voffA);
            PG8_WAIT_V(8); PG8_WAIT_L(0); PG8_BAR; PG8_MMA(0, 0, At, B0); PG8_MMA(0, 1, At, B1); PG8_BAR; PG8_SCHED;
            PG8_LDA(At, 1, 1); PG8_STAGE(PG8_SB(1, 0), b3, voffB); PG8_STAGE(PG8_SB(1, 1), b3 + hstepB, voffB); PG8_STAGE(PG8_SA(1, 0), a3, voffA);
            PG8_WAIT_V(8); PG8_WAIT_L(0); PG8_BAR; PG8_MMA(1, 0, At, B0); PG8_MMA(1, 1, At, B1); PG8_BAR; PG8_SCHED;
        }
        if (wr == 0) PG8_BAR;
        bool keep = false;
        if constexpr (Epi::HAS_MID) keep = (cur.h == 0);
        if constexpr (Epi::HAS_MID) { if (keep) E.mid(acc, cur, wr, wc, fr, fq); else E(acc, cur, wr, wc, fr, fq); }
        else E(acc, cur, wr, wc, fr, fq);
        if (!has_next) break;
        if (!keep)
#pragma unroll
        for (int a = 0; a < 2; ++a)
#pragma unroll
            for (int b = 0; b < 2; ++b)
#pragma unroll
                for (int m = 0; m < 4; ++m)
#pragma unroll
                    for (int n = 0; n < 2; ++n) acc[a][b][m][n] = (f32x4){0.f, 0.f, 0.f, 0.f};
        cur = nxt; cA = nA; cB = nB; ++ui;
        if (wr == 1) PG8_BAR;
    }
    PG8_WAIT_V(0);
    PG8_BAR;
#undef PG8_SA
#undef PG8_SB
#undef PG8_STAGE
#undef PG8_LDA
#undef PG8_LDB
#undef PG8_MMA
#undef PG8_WAIT_V
#undef PG8_WAIT_L
#undef PG8_BAR
#undef PG8_SCHED
#undef PG8_PA
#undef PG8_PB
}
}
using pg8::Unit;

typedef f32x4 Acc[2][2][4][2];

__device__ __forceinline__ u32x4 pack8(const f32x4 v0, const f32x4 v1) {
    u32x4 w; w.x = cvt_pk_bf16(v0[0], v0[1]); w.y = cvt_pk_bf16(v0[2], v0[3]); w.z = cvt_pk_bf16(v1[0], v1[1]); w.w = cvt_pk_bf16(v1[2], v1[3]); return w;
}

struct EpiInProj {
    static constexpr bool HAS_MID = false;
    bf16_t* Kb; bf16_t* VTb; bf16_t* Qb; float* Gb; bf16_t* AB; bf16_t* MG; const float* biasp; const float* convw;
    __device__ __forceinline__ void operator()(Acc& acc, const Unit& u, int wr, int wc, int fr, int fq) const {
        if (u.sw) {
            const int r0 = u.pm * 256 + wr * 64 + fr, t0 = u.pn * 256 + wc * 32 + 8 * fq;
#pragma unroll
            for (int ai = 0; ai < 2; ++ai)
#pragma unroll
                for (int m = 0; m < 4; ++m) { const int wrow = r0 + ai * 128 + m * 16; const float bs = biasp[wrow]; bf16_t* rowp = VTb + (size_t)(wrow - 768) * MALL + t0;
#pragma unroll
                    for (int bj = 0; bj < 2; ++bj) *(u32x4*)(rowp + bj * 128) = pack8(acc[ai][bj][m][0] + bs, acc[ai][bj][m][1] + bs); }
            return;
        }
        const int row0 = u.pm * 256 + wr * 64 + fr, pn = u.pn;
        const int cb = pn * 256 + wc * 32 + 8 * fq;
        if (pn == 2) {
            if (wc == 0) {
                const f32x4 b0 = *(const f32x4*)(biasp + cb), b1 = *(const f32x4*)(biasp + cb + 4);
#pragma unroll
                for (int ai = 0; ai < 2; ++ai)
#pragma unroll
                    for (int m = 0; m < 4; ++m) { float* gp = Gb + (size_t)(row0 + ai * 128 + m * 16) * 32 + 8 * fq;
                        f32x4 g0 = acc[ai][0][m][0] + b0, g1 = acc[ai][0][m][1] + b1;
                        if (fq >= 2) {
#pragma unroll
                            for (int j = 0; j < 4; ++j) { g0[j] = logsig(g0[j]); g1[j] = logsig(g1[j]); } }
                        *(f32x4*)gp = g0; *(f32x4*)(gp + 4) = g1; }
            }
            return;
        }
        if (pn >= 9 && pn < 25) {
            const int ch = 64 * (pn - 9) + 16 * wc + 4 * fq;
            const f32x4 bX = *(const f32x4*)(biasp + cb), bC = *(const f32x4*)(biasp + cb + 4), bB = *(const f32x4*)(biasp + cb + 128), bO = *(const f32x4*)(biasp + cb + 132);
            const f32x4 w0 = *(const f32x4*)(convw + ch), w1 = *(const f32x4*)(convw + 1024 + ch), w2 = *(const f32x4*)(convw + 2048 + ch);
#pragma unroll
            for (int ai = 0; ai < 2; ++ai) {
                f32x4 uu[4];
#pragma unroll
                for (int m = 0; m < 4; ++m) uu[m] = (acc[ai][0][m][0] + bX) * (acc[ai][0][m][1] + bC);
#pragma unroll
                for (int m = 0; m < 4; ++m) {
                    f32x4 pv, nx;
#pragma unroll
                    for (int j = 0; j < 4; ++j) {
                        const float pold = (m > 0) ? dppf<0x121>(0.f, uu[m > 0 ? m - 1 : 0][j]) : 0.f;
                        pv[j] = dppf<0x111>(pold, uu[m][j]);
                        const float nold = (m < 3) ? dppf<0x12F>(0.f, uu[m < 3 ? m + 1 : 3][j]) : 0.f;
                        nx[j] = dppf<0x101>(nold, uu[m][j]);
                    }
                    const f32x4 cv = w0 * pv + w1 * uu[m] + w2 * nx;
                    const f32x4 aa = (acc[ai][1][m][0] + bB) * cv;
                    f32x4 os = acc[ai][1][m][1] + bO;
#pragma unroll
                    for (int j = 0; j < 4; ++j) os[j] = sigm(os[j]);
                    bf16_t* rp = AB + (size_t)(row0 + ai * 128 + m * 16) * 2048 + ch;
                    u32x2 wa, wo; wa.x = cvt_pk_bf16(aa[0], aa[1]); wa.y = cvt_pk_bf16(aa[2], aa[3]); wo.x = cvt_pk_bf16(os[0], os[1]); wo.y = cvt_pk_bf16(os[2], os[3]);
                    *(u32x2*)rp = wa; *(u32x2*)(rp + 1024) = wo;
                }
            }
            return;
        }
        if (pn >= 25) {
            const int ch = 128 * (pn - 25) + 32 * wc + 8 * fq;
            f32x4 ba[2], bb[2];
#pragma unroll
            for (int n = 0; n < 2; ++n) { ba[n] = *(const f32x4*)(biasp + cb + 4 * n); bb[n] = *(const f32x4*)(biasp + cb + 128 + 4 * n); }
#pragma unroll
            for (int ai = 0; ai < 2; ++ai)
#pragma unroll
                for (int m = 0; m < 4; ++m) { bf16_t* rp = MG + (size_t)(row0 + ai * 128 + m * 16) * 2048 + ch;
                    f32x4 rr[2], gg[2];
#pragma unroll
                    for (int n = 0; n < 2; ++n) { const f32x4 xa = acc[ai][0][m][n] + ba[n], xb = acc[ai][1][m][n] + bb[n];
#pragma unroll
                        for (int j = 0; j < 4; ++j) { const float ea = 1.f + __expf(-xa[j]), eb = 1.f + __expf(-xb[j]); rr[n][j] = eb * __builtin_amdgcn_rcpf(ea); gg[n][j] = __builtin_amdgcn_rcpf(eb); } }
                    *(u32x4*)rp = pack8(rr[0], rr[1]); *(u32x4*)(rp + 1024) = pack8(gg[0], gg[1]); }
            return;
        }
        bf16_t* base; int ldc, col0, mode;
        if (pn < 2) { base = Kb; ldc = 512; col0 = pn * 256; mode = 0; }
        else { base = Qb; ldc = 512; col0 = (pn - 7) * 256; mode = 1; }
        col0 += wc * 32 + 8 * fq;
        f32x4 bv[2][2];
#pragma unroll
        for (int bj = 0; bj < 2; ++bj)
#pragma unroll
            for (int n = 0; n < 2; ++n) bv[bj][n] = *(const f32x4*)(biasp + cb + bj * 128 + 4 * n);
#pragma unroll
        for (int ai = 0; ai < 2; ++ai)
#pragma unroll
            for (int m = 0; m < 4; ++m) { bf16_t* rowp = base + (size_t)(row0 + ai * 128 + m * 16) * ldc + col0;
#pragma unroll
                for (int bj = 0; bj < 2; ++bj) { f32x4 v0 = acc[ai][bj][m][0] + bv[bj][0], v1 = acc[ai][bj][m][1] + bv[bj][1];
                    if (mode == 0) { v0 = v0 * 0.125f; v1 = v1 * 0.125f; }
                    *(u32x4*)(rowp + bj * 128) = pack8(v0, v1); } }
    }
};

struct EpiG2 {
    static constexpr bool HAS_MID = true;
    const bf16_t* MG; bf16_t* MRG;
    __device__ __forceinline__ void mid(Acc& acc, const Unit& u, int wr, int wc, int fr, int fq) const {
        const int row0 = u.pm * 256 + wr * 64 + fr, col0 = u.pn * 256 + wc * 32 + 8 * fq;
#pragma unroll
        for (int ai = 0; ai < 2; ++ai) {
            u32x4 rr[4][2];
#pragma unroll
            for (int m = 0; m < 4; ++m)
#pragma unroll
                for (int bj = 0; bj < 2; ++bj) rr[m][bj] = *(const u32x4*)(MG + (size_t)(row0 + ai * 128 + m * 16) * 2048 + col0 + bj * 128);
#pragma unroll
            for (int m = 0; m < 4; ++m)
#pragma unroll
                for (int bj = 0; bj < 2; ++bj) { const u32x4 q = rr[m][bj];
                    const f32x4 r0 = {bf_lo(q.x), bf_hi(q.x), bf_lo(q.y), bf_hi(q.y)}, r1 = {bf_lo(q.z), bf_hi(q.z), bf_lo(q.w), bf_hi(q.w)};
                    acc[ai][bj][m][0] = acc[ai][bj][m][0] * r0; acc[ai][bj][m][1] = acc[ai][bj][m][1] * r1; }
            asm volatile("" ::: "memory");
        }
    }
    __device__ __forceinline__ void operator()(Acc& acc, const Unit& u, int wr, int wc, int fr, int fq) const {
        const int row0 = u.pm * 256 + wr * 64 + fr, col0 = u.pn * 256 + wc * 32 + 8 * fq;
#pragma unroll
        for (int ai = 0; ai < 2; ++ai) {
            u32x4 gg[4][2];
#pragma unroll
            for (int m = 0; m < 4; ++m)
#pragma unroll
                for (int bj = 0; bj < 2; ++bj) gg[m][bj] = *(const u32x4*)(MG + (size_t)(row0 + ai * 128 + m * 16) * 2048 + col0 + bj * 128 + 1024);
#pragma unroll
            for (int m = 0; m < 4; ++m)
#pragma unroll
                for (int bj = 0; bj < 2; ++bj) { const u32x4 gb = gg[m][bj];
                    const f32x4 g0 = {bf_lo(gb.x), bf_hi(gb.x), bf_lo(gb.y), bf_hi(gb.y)}, g1 = {bf_lo(gb.z), bf_hi(gb.z), bf_lo(gb.w), bf_hi(gb.w)};
                    *(u32x4*)(MRG + (size_t)(row0 + ai * 128 + m * 16) * 1024 + col0 + bj * 128) = pack8(acc[ai][bj][m][0] * g0, acc[ai][bj][m][1] * g1); }
            asm volatile("" ::: "memory");
        }
    }
};
struct EpiRes {
    static constexpr bool HAS_MID = false;
    const float* base; float* out; const float* gate;
    __device__ __forceinline__ void operator()(Acc& acc, const Unit& u, int wr, int wc, int fr, int fq) const {
        const int row0 = u.pm * 256 + wr * 64 + fr, col0 = u.pn * 256 + wc * 32 + 8 * fq;
        const float* gp = gate + (size_t)((u.pm * 256) >> 11) * 6144 + col0;
        f32x4 gv[2][2];
#pragma unroll
        for (int bj = 0; bj < 2; ++bj)
#pragma unroll
            for (int n = 0; n < 2; ++n) gv[bj][n] = *(const f32x4*)(gp + bj * 128 + 4 * n);
#pragma unroll
        for (int ai = 0; ai < 2; ++ai)
#pragma unroll
            for (int m = 0; m < 4; ++m) { const size_t off = (size_t)(row0 + ai * 128 + m * 16) * 1024 + col0;
#pragma unroll
                for (int bj = 0; bj < 2; ++bj)
#pragma unroll
                    for (int n = 0; n < 2; ++n) { const f32x4 bs = *(const f32x4*)(base + off + bj * 128 + 4 * n);
                        *(f32x4*)(out + off + bj * 128 + 4 * n) = bs + gv[bj][n] * acc[ai][bj][m][n]; } }
    }
};
template <int mode> struct EpiResNorm {
    static constexpr bool HAS_MID = false;
    const float* base; float* out; const float* gate; int mode_unused;
    bf16_t* h2; const float* nw; const float* mod;
    float* xbuf; unsigned* cnt; LAS unsigned char* xl;
    __device__ __forceinline__ void operator()(Acc& acc, const Unit& u, int wr, int wc, int fr, int fq) const {
        const int wid = wr * 4 + wc, lane = fq * 16 + fr;
        const int row0 = u.pm * 256 + wr * 64 + fr, col0 = u.pn * 256 + wc * 32 + 8 * fq, bb = (u.pm * 256) >> 11;
        {
            const float* gp = gate + (size_t)bb * 6144 + col0;
            f32x4 gv[2][2];
#pragma unroll
            for (int bj = 0; bj < 2; ++bj)
#pragma unroll
                for (int n = 0; n < 2; ++n) gv[bj][n] = *(const f32x4*)(gp + bj * 128 + 4 * n);
#pragma unroll
            for (int ai = 0; ai < 2; ++ai)
#pragma unroll
                for (int m = 0; m < 4; ++m) { const size_t off = (size_t)(row0 + ai * 128 + m * 16) * 1024 + col0;
#pragma unroll
                    for (int bj = 0; bj < 2; ++bj)
#pragma unroll
                        for (int n = 0; n < 2; ++n) { const f32x4 bs = *(const f32x4*)(base + off + bj * 128 + 4 * n); acc[ai][bj][m][n] = bs + gv[bj][n] * acc[ai][bj][m][n]; }
                    asm volatile("" : "+v"(acc[ai][0][m][0]), "+v"(acc[ai][0][m][1]), "+v"(acc[ai][1][m][0]), "+v"(acc[ai][1][m][1]));
                    if (m & 1) asm volatile("" ::: "memory"); }
        }
        LAS float* P = (LAS float*)xl; LAS float* S = (LAS float*)(xl + 4096);
#pragma unroll
        for (int ai = 0; ai < 2; ++ai)
#pragma unroll
            for (int m = 0; m < 4; ++m) { float q = 0.f;
#pragma unroll
                for (int bj = 0; bj < 2; ++bj)
#pragma unroll
                    for (int n = 0; n < 2; ++n) { const f32x4 x = acc[ai][bj][m][n]; q += (x[0] * x[0] + x[1] * x[1]) + (x[2] * x[2] + x[3] * x[3]); }
                q += __shfl_xor(q, 16); q += __shfl_xor(q, 32);
                if (fq == 0) P[(ai * 128 + wr * 64 + m * 16 + fr) * 4 + wc] = q; }
        asm volatile("s_waitcnt lgkmcnt(0)\n\ts_barrier" ::: "memory");
        const int row = wid * 32 + (lane & 31);
        if (lane < 32) { const float tot = (P[row * 4 + 0] + P[row * 4 + 1]) + (P[row * 4 + 2] + P[row * 4 + 3]);
            __hip_atomic_store(xbuf + (size_t)(u.pm * 256 + row) * 4 + u.pn, tot, __ATOMIC_RELAXED, __HIP_MEMORY_SCOPE_AGENT); }
        asm volatile("s_waitcnt vmcnt(0)" ::: "memory");
        if (lane == 0) __hip_atomic_fetch_add(cnt + 64 * u.pm, 1u, __ATOMIC_RELAXED, __HIP_MEMORY_SCOPE_AGENT);
        if (wid == 0) {
            unsigned sp = 0;
            while ((unsigned)__builtin_amdgcn_readfirstlane(__hip_atomic_load(cnt + 64 * u.pm, __ATOMIC_RELAXED, __HIP_MEMORY_SCOPE_AGENT)) < 32u) { __builtin_amdgcn_s_sleep(2); if (++sp > (1u << 20)) break; }
            __builtin_amdgcn_fence(__ATOMIC_ACQUIRE, "agent");
        }
        asm volatile("s_waitcnt vmcnt(0) lgkmcnt(0)\n\ts_barrier" ::: "memory");
        if (lane < 32) { const float* sl = xbuf + (size_t)(u.pm * 256 + row) * 4; float t = 0.f;
#pragma unroll
            for (int k = 0; k < 4; ++k) t += __hip_atomic_load(sl + k, __ATOMIC_RELAXED, __HIP_MEMORY_SCOPE_AGENT);
            S[row] = rsqrtf(t * (1.f / 1024.f) + EPS); }
        asm volatile("s_waitcnt vmcnt(0) lgkmcnt(0)\n\ts_barrier" ::: "memory");
#pragma unroll
        for (int bj = 0; bj < 2; ++bj) {
            const int c = col0 + bj * 128;
            f32x4 w0 = *(const f32x4*)(nw + c), w1 = *(const f32x4*)(nw + c + 4), h0 = (f32x4){0.f, 0.f, 0.f, 0.f}, h1 = h0;
            if (mode == 0) { const float* mb = mod + (size_t)bb * 6144 + c; w0 = w0 * (*(const f32x4*)(mb + 4096) + 1.f); w1 = w1 * (*(const f32x4*)(mb + 4100) + 1.f); h0 = *(const f32x4*)(mb + 3072); h1 = *(const f32x4*)(mb + 3076); }
#pragma unroll
            for (int ai = 0; ai < 2; ++ai)
#pragma unroll
                for (int m = 0; m < 4; ++m) { asm volatile("" ::: "memory"); const int rl = ai * 128 + wr * 64 + m * 16 + fr; const float r = S[rl]; const size_t off = (size_t)(u.pm * 256 + rl) * 1024 + c;
                    const f32x4 v0 = acc[ai][bj][m][0], v1 = acc[ai][bj][m][1];
                    if (mode == 0) { *(f32x4*)(out + off) = v0; *(f32x4*)(out + off + 4) = v1; *(u32x4*)(h2 + off) = pack8((v0 * r) * w0 + h0, (v1 * r) * w1 + h1); }
                    else { *(f32x4*)(out + off) = (v0 * r) * w0; *(f32x4*)(out + off + 4) = (v1 * r) * w1; } }
        }
    }
};
struct EpiRelu2 {
    static constexpr bool HAS_MID = false;
    bf16_t* O; int ldc;
    __device__ __forceinline__ void operator()(Acc& acc, const Unit& u, int wr, int wc, int fr, int fq) const {
        const int row0 = u.pm * 256 + wr * 64 + fr, col0 = u.pn * 256 + wc * 32 + 8 * fq;
#pragma unroll
        for (int ai = 0; ai < 2; ++ai)
#pragma unroll
            for (int m = 0; m < 4; ++m) { const int row = row0 + ai * 128 + m * 16;
#pragma unroll
                for (int bj = 0; bj < 2; ++bj) { f32x4 v0 = acc[ai][bj][m][0], v1 = acc[ai][bj][m][1]; const int col = col0 + bj * 128;
                    bf16_t* rowp = O + ((size_t)(row >> 7) * (ldc >> 6) + (col >> 6)) * 8192 + (row & 127) * 64 + (col & 63) - bj * 128;
#pragma unroll
                    for (int j = 0; j < 4; ++j) { const float a = fmaxf(v0[j], 0.f), b = fmaxf(v1[j], 0.f); v0[j] = a * a; v1[j] = b * b; }
                    *(u32x4*)(rowp + bj * 128) = pack8(v0, v1); } }
    }
};

__device__ __forceinline__ int inproj_colmap(int n) {
    if (n < 512) return OFF_K + n;
    if (n < 768) { const int j = n - 512; return j < 32 ? OFF_IG + j : -1; }
    if (n < 1792) return OFF_V + (n - 768);
    if (n < 2304) return OFF_Q + (n - 1792);
    if (n < 6400) { const int lc = (n - 2304) & 255, jt = (n - 2304) >> 8, bj = lc >> 7, wc = (lc >> 5) & 3, fq = (lc >> 3) & 3, nn = (lc >> 2) & 1, jj = lc & 3;
        const int seg = 2 * bj + nn, ch = 64 * jt + 16 * wc + 4 * fq + jj;
        return (seg == 0 ? OFF_XIN : seg == 1 ? OFF_GC : seg == 2 ? OFF_GB : OFF_O) + ch; }
    { const int lc = (n - 6400) & 255, jt = (n - 6400) >> 8; return OFF_MRG + (lc >> 7) * 1024 + 128 * jt + (lc & 127); }
}
struct TrItem { const float* W; bf16_t* out; int ldw, nblk, ldo, kofs, item, map; };
__device__ __forceinline__ void tr_load(const TrItem& t, int lane, f32x4 (&v)[8]) {
    const int kb = t.item / t.nblk, nb = t.item % t.nblk, k0 = 64 * kb, n0 = 32 * nb;
    const int n4 = lane & 7, kr = lane >> 3;
    const int nn = n0 + 4 * n4; const int src = t.map ? inproj_colmap(nn) : nn;
#pragma unroll
    for (int it = 0; it < 8; ++it) v[it] = (src >= 0) ? *(const f32x4*)(t.W + (size_t)(k0 + 8 * it + kr) * t.ldw + src) : (f32x4){0.f, 0.f, 0.f, 0.f};
}
__device__ __forceinline__ void tr_finish(const TrItem& t, int lane, const f32x4 (&v)[8], LAS float* scr) {
    const int kb = t.item / t.nblk, nb = t.item % t.nblk, k0 = 64 * kb, n0 = 32 * nb;
    const int n4 = lane & 7, kr = lane >> 3;
#pragma unroll
    for (int it = 0; it < 8; ++it) { LAS float* d = scr + (8 * it + kr) * 33 + 4 * n4; d[0] = v[it][0]; d[1] = v[it][1]; d[2] = v[it][2]; d[3] = v[it][3]; }
    asm volatile("s_waitcnt lgkmcnt(0)" ::: "memory");
    const int c = lane & 7;
#pragma unroll
    for (int j = 0; j < 4; ++j) { const int n = (lane >> 3) + 8 * j; const LAS float* s = scr + (8 * c) * 33 + n;
        u32x4 o; o.x = cvt_pk_bf16(s[0 * 33], s[1 * 33]); o.y = cvt_pk_bf16(s[2 * 33], s[3 * 33]); o.z = cvt_pk_bf16(s[4 * 33], s[5 * 33]); o.w = cvt_pk_bf16(s[6 * 33], s[7 * 33]);
        *(u32x4*)(t.out + (size_t)(n0 + n) * t.ldo + t.kofs + k0 + 8 * c) = o; }
    asm volatile("s_waitcnt lgkmcnt(0)" ::: "memory");
}

struct Args { const float* in[18]; float* out; unsigned char* ws; int ph_lo, ph_hi; };
enum { I_X = 0, I_C, I_CTX, I_CCTX, I_WMOD, I_BMOD, I_N1W, I_WIN, I_BIN, I_CONVW, I_MNW, I_WCO, I_WMO, I_WOUT, I_N2W, I_WFF1, I_WFF2, I_FNW };

__device__ __forceinline__ void p0_mod(const Args& A, LAS unsigned char* lds, int tid, int lane, int wave, unsigned* modcnt) {
    unsigned char* ws = A.ws;
    LAS float* sl = (LAS float*)lds;
    LAS float* red = (LAS float*)(lds + 17 * 4096);
    bool filled = false; unsigned done = 0;
    for (int item = blockIdx.x; item < 6144 / 32; item += gridDim.x) {
        if (!filled) {
            float cv[34];
#pragma unroll
            for (int j = 0; j < 34; ++j) { const int i = tid + 512 * j; cv[j] = i < 16 * 1024 ? A.in[I_C][i] : A.in[I_CCTX][i - 16 * 1024]; }
#pragma unroll
            for (int j = 0; j < 34; ++j) sl[tid + 512 * j] = cv[j] * sigm(cv[j]);
            __syncthreads(); filled = true;
        }
        const int col = lane & 31, kh = lane >> 5, n0 = item * 32, kbase = 128 * wave + 64 * kh;
        float a[17];
#pragma unroll
        for (int r = 0; r < 17; ++r) a[r] = 0.f;
        const float* wp = A.in[I_WMOD] + (size_t)kbase * 6144 + n0 + col;
        float wv[64];
#pragma unroll
        for (int j = 0; j < 64; ++j) wv[j] = wp[(size_t)j * 6144];
#pragma unroll
        for (int i = 0; i < 64; i += 8) {
#pragma unroll
            for (int r = 0; r < 17; ++r) { const f32x4 s4 = *(const LAS f32x4*)(sl + r * 1024 + kbase + i), s5 = *(const LAS f32x4*)(sl + r * 1024 + kbase + i + 4);
                a[r] += (s4[0] * wv[i + 0] + s4[1] * wv[i + 1]) + (s4[2] * wv[i + 2] + s4[3] * wv[i + 3]) + (s5[0] * wv[i + 4] + s5[1] * wv[i + 5]) + (s5[2] * wv[i + 6] + s5[3] * wv[i + 7]); }
        }
#pragma unroll
        for (int r = 0; r < 17; ++r) red[((wave * 2 + kh) * 17 + r) * 32 + col] = a[r];
        __syncthreads();
        for (int o = tid; o < 17 * 32; o += 512) { const int r = o >> 5, cc = o & 31; float s = A.in[I_BMOD][n0 + cc];
#pragma unroll
            for (int p = 0; p < 16; ++p) s += red[(p * 17 + r) * 32 + cc];
            ((float*)(ws + WS_MOD))[r * 6144 + n0 + cc] = s; }
        asm volatile("s_waitcnt vmcnt(0)" ::: "memory");
        __syncthreads();
        ++done;
    }
    if (done && tid == 0) { __builtin_amdgcn_fence(__ATOMIC_RELEASE, "agent"); asm volatile("s_waitcnt vmcnt(0)" ::: "memory"); __hip_atomic_fetch_add(modcnt, done, __ATOMIC_RELAXED, __HIP_MEMORY_SCOPE_AGENT); }
}
__device__ __forceinline__ void p0_weights(const Args& A, LAS unsigned char* lds, int tid, int lane, int wave) {
    unsigned char* ws = A.ws;
    LAS float* scr = (LAS float*)(lds + wave * 16384);
    const int gw = blockIdx.x * 8 + wave, NGW = gridDim.x * 8;
    constexpr int IT_WIN = 16 * (NIN / 32), IT_SQ = 16 * 32, IT_W1 = 16 * 128, IT_W2 = 64 * 32;
    constexpr int NITEMS = IT_WIN + 3 * IT_SQ + IT_W1 + IT_W2;
    auto mk = [&](int it) -> TrItem {
        int r = it;
        if (r < IT_WIN) return TrItem{A.in[I_WIN], (bf16_t*)(ws + WS_WIN), DIN, NIN / 32, 1024, 0, r, 1}; r -= IT_WIN;
        if (r < IT_SQ) return TrItem{A.in[I_WCO], (bf16_t*)(ws + WS_BT2), 1024, 32, 2048, 0, r, 0}; r -= IT_SQ;
        if (r < IT_SQ) return TrItem{A.in[I_WMO], (bf16_t*)(ws + WS_BT2), 1024, 32, 2048, 1024, r, 0}; r -= IT_SQ;
        if (r < IT_SQ) return TrItem{A.in[I_WOUT], (bf16_t*)(ws + WS_WO), 1024, 32, 1024, 0, r, 0}; r -= IT_SQ;
        if (r < IT_W1) return TrItem{A.in[I_WFF1], (bf16_t*)(ws + WS_W1), 4096, 128, 1024, 0, r, 0}; r -= IT_W1;
        return TrItem{A.in[I_WFF2], (bf16_t*)(ws + WS_W2), 1024, 32, F1P, 0, r, 0};
    };
    if (gw < NITEMS) {
        f32x4 va[8], vb[8];
        TrItem cur = mk(gw); tr_load(cur, lane, va);
        for (int it = gw; it < NITEMS; it += 2 * NGW) {
            const bool h1 = it + NGW < NITEMS, h2 = it + 2 * NGW < NITEMS;
            TrItem nx = cur; if (h1) { nx = mk(it + NGW); tr_load(nx, lane, vb); }
            tr_finish(cur, lane, va, scr);
            if (!h1) break;
            if (h2) { cur = mk(it + 2 * NGW); tr_load(cur, lane, va); }
            tr_finish(nx, lane, vb, scr);
        }
    }
    for (int i = blockIdx.x * 512 + tid; i < NIN; i += gridDim.x * 512) { const int s = inproj_colmap(i); ((float*)(ws + WS_BIASP))[i] = s >= 0 ? A.in[I_BIN][s] : 0.f; }
}

__device__ __forceinline__ float wave_allsum(float x) { return lane63(wave_scan_add(x)); }
__device__ __forceinline__ void modulate_rows4(const float* xrow, const float* w, const float* sh, const float* sc, bf16_t* orow, int lane) {
    f32x4 v[4][4]; float r[4];
#pragma unroll
    for (int q = 0; q < 4; ++q)
#pragma unroll
        for (int j = 0; j < 4; ++j) v[q][j] = ((const f32x4*)(xrow + (size_t)q * DM))[lane + 64 * j];
#pragma unroll
    for (int q = 0; q < 4; ++q) { float s = 0.f;
#pragma unroll
        for (int j = 0; j < 4; ++j) s += (v[q][j].x * v[q][j].x + v[q][j].y * v[q][j].y) + (v[q][j].z * v[q][j].z + v[q][j].w * v[q][j].w);
        r[q] = rsqrtf(wave_allsum(s) * (1.f / DM) + EPS); }
#pragma unroll
    for (int j = 0; j < 4; ++j) { const f32x4 ww = ((const f32x4*)w)[lane + 64 * j], hh = ((const f32x4*)sh)[lane + 64 * j], cc = ((const f32x4*)sc)[lane + 64 * j];
        const f32x4 wc = ww * (cc + 1.f);
#pragma unroll
        for (int q = 0; q < 4; ++q) { const f32x4 y = (v[q][j] * r[q]) * wc + hh;
            u32x2 p; p.x = cvt_pk_bf16(y[0], y[1]); p.y = cvt_pk_bf16(y[2], y[3]); ((u32x2*)(orow + (size_t)q * DM))[lane + 64 * j] = p; } }
}

constexpr int L_QS = 0, L_KS = 18432, L_KTS = 36864, L_VTS = 54272, L_SS = 93440, L_CS = 128256, L_GW = 148992;
static_assert(L_GW + 8 * 512 <= LDS_BYTES, "mlstm LDS map");
#define BAR_LDS() asm volatile("s_waitcnt lgkmcnt(0)\n\ts_barrier" ::: "memory")

__device__ __forceinline__ void mlstm_seq(LAS unsigned char* lds, const bf16_t* Kb, const bf16_t* VTb, const bf16_t* Qb, const float* Gb, bf16_t* HD0, bf16_t* HD1, int seq, int tid, int lane, int w) {
    const int dir = seq >> 7, b = (seq >> 3) & 15, head = seq & 7;
    const int g = lane >> 4, l15 = lane & 15;
    bf16_t* HD = dir ? HD1 : HD0;
    for (int i = tid; i < 16 * 136; i += 512) { const int r = i / 136, cidx = i % 136; *(LAS bf16_t*)(lds + L_VTS + (128 + r) * 272 + cidx * 2) = (r == 0) ? (bf16_t)0x3F80 : (bf16_t)0; }
    f32x4 st[4], nst;
#pragma unroll
    for (int i = 0; i < 4; ++i) st[i] = (f32x4){0.f, 0.f, 0.f, 0.f};
    nst = (f32x4){0.f, 0.f, 0.f, 0.f};
    float mstate = 0.f;
    u32x4 pq[2], pk[2], pv[4]; float gi0, gi1, gf0, gf1;
    const int krow = tid & 127, kpc = tid >> 7;
    unsigned offq[2], offk[2], offv[4], offg0, offg1;
#pragma unroll
    for (int i = 0; i < 2; ++i) { const int p = tid + 512 * i, row = p >> 3, pc = p & 7; offq[i] = (unsigned)((dir ? 127 - row : row) * 512 + head * 64 + pc * 8);
        offk[i] = (unsigned)((dir ? 127 - krow : krow) * 512 + head * 64 + (kpc + 4 * i) * 8); }
#pragma unroll
    for (int i = 0; i < 4; ++i) { const int p = tid + 512 * i, v = p >> 4, pc = p & 15; offv[i] = (unsigned)((head * 128 + v) * MALL + pc * 8); }
    offg0 = (unsigned)((dir ? 127 - lane : lane) * 32 + dir * 8 + head); offg1 = (unsigned)((dir ? 63 - lane : lane + 64) * 32 + dir * 8 + head);
#define PREFETCH(cc) do { const int cc_ = (cc); const bool isctx_ = cc_ < 2; const int T_ = isctx_ ? CTXL : SEQ, c_ = isctx_ ? cc_ : cc_ - 2; \
        const int base_ = isctx_ ? MTOK + b * CTXL : b * SEQ; const int tok0_ = base_ + (dir ? T_ - 128 * (c_ + 1) : 128 * c_); \
        const bf16_t* qb_ = Qb + (size_t)tok0_ * 512; const bf16_t* kb_ = Kb + (size_t)tok0_ * 512; const bf16_t* vb_ = VTb + tok0_; const float* gb_ = Gb + (size_t)tok0_ * 32; \
        if (!isctx_) { _Pragma("unroll") for (int i = 0; i < 2; ++i) pq[i] = *(const u32x4*)(qb_ + offq[i]); } \
        _Pragma("unroll") for (int i = 0; i < 2; ++i) pk[i] = *(const u32x4*)(kb_ + offk[i]); \
        _Pragma("unroll") for (int i = 0; i < 4; ++i) pv[i] = *(const u32x4*)(vb_ + offv[i]); \
        gi0 = gb_[offg0]; gf0 = gb_[offg0 + 16]; gi1 = gb_[offg1]; gf1 = gb_[offg1 + 16]; \
    } while (0)
    PREFETCH(0);
    for (int cc = 0; cc < 18; ++cc) {
        const bool isctx = cc < 2; const int T_ = isctx ? CTXL : SEQ, c_ = isctx ? cc : cc - 2;
        const int tok0 = (isctx ? MTOK + b * CTXL : b * SEQ) + (dir ? T_ - 128 * (c_ + 1) : 128 * c_);
        const float b0 = wave_scan_add(gf0), b1 = wave_scan_add(gf1) + lane63(b0);
        const float a0 = gi0 - b0, a1 = gi1 - b1;
        const float Mc = fmaxf(mstate, lane63(wave_scan_max(fmaxf(a0, a1))));
        const float e0 = __expf(a0 - Mc), e1 = __expf(a1 - Mc), th0 = __expf(-b0 - Mc), th1 = __expf(-b1 - Mc);
        const float decay = __expf(mstate - Mc);
        mstate = lane63(b1) + Mc;
#pragma unroll
        for (int db = 0; db < 4; ++db) { st[db] = st[db] * decay; u32x2 p; p.x = cvt_pk_bf16(st[db][0], st[db][1]); p.y = cvt_pk_bf16(st[db][2], st[db][3]);
            *(LAS u32x2*)(lds + L_CS + (16 * w + l15) * 144 + (16 * db + 4 * g) * 2) = p; }
        if (w < 4) { nst = nst * decay; u32x2 p; p.x = cvt_pk_bf16(nst[0], nst[1]); p.y = cvt_pk_bf16(nst[2], nst[3]);
            *(LAS u32x2*)(lds + L_CS + (128 + l15) * 144 + (16 * w + 4 * g) * 2) = p; }
        if (!isctx) {
#pragma unroll
            for (int i = 0; i < 2; ++i) { const int p = tid + 512 * i, row = p >> 3, pc = p & 7; *(LAS u32x4*)(lds + L_QS + row * 144 + pc * 16) = pq[i]; }
        }
        {
            const float es = (w & 1) ? e1 : e0; const int kidx = dir ? 127 - krow : krow;
#pragma unroll
            for (int i = 0; i < 2; ++i) { const int pc = kpc + 4 * i;
                const unsigned ww[4] = {pk[i].x, pk[i].y, pk[i].z, pk[i].w}; unsigned sc4[4];
#pragma unroll
                for (int q2 = 0; q2 < 4; ++q2) { const unsigned pkd = cvt_pk_bf16(bf_lo(ww[q2]) * es, bf_hi(ww[q2]) * es); sc4[q2] = pkd;
                    *(LAS bf16_t*)(lds + L_KTS + (pc * 8 + 2 * q2) * 272 + kidx * 2) = (bf16_t)(pkd & 0xffffu);
                    *(LAS bf16_t*)(lds + L_KTS + (pc * 8 + 2 * q2 + 1) * 272 + kidx * 2) = (bf16_t)(pkd >> 16); }
                *(LAS u32x4*)(lds + L_KS + krow * 144 + pc * 16) = (u32x4){sc4[0], sc4[1], sc4[2], sc4[3]}; }
#pragma unroll
            for (int i = 0; i < 4; ++i) { const int p = tid + 512 * i, v = p >> 4, pc = p & 15; *(LAS u32x4*)(lds + L_VTS + v * 272 + pc * 16) = pv[i]; }
        }
        BAR_LDS();
        if (cc + 1 < 18) PREFETCH(cc + 1);
        if (!isctx) {
            const int tb = (w < 4) ? 2 * w : 15 - 2 * w;
            const int trow = 16 * tb + l15;
            const int klo = dir ? ((7 - tb) >> 1) : 0, khi = dir ? 3 : (tb >> 1);
            bf16x8 qf[2];
#pragma unroll
            for (int kk = 0; kk < 2; ++kk) qf[kk] = *(const LAS bf16x8*)(lds + L_QS + trow * 144 + (kk * 32 + g * 8) * 2);
#pragma unroll
            for (int sb = 0; sb < 8; ++sb) {
                f32x4 sa = (f32x4){0.f, 0.f, 0.f, 0.f};
                if (sb <= tb) {
#pragma unroll
                    for (int kk = 0; kk < 2; ++kk) { const bf16x8 kf = *(const LAS bf16x8*)(lds + L_KS + (16 * sb + l15) * 144 + (kk * 32 + g * 8) * 2);
                        sa = __builtin_amdgcn_mfma_f32_16x16x32_bf16(kf, qf[kk], sa, 0, 0, 0); }
                    if (sb == tb) { const int s0 = 16 * sb + 4 * g;
#pragma unroll
                        for (int r = 0; r < 4; ++r) sa[r] = (s0 + r <= trow) ? sa[r] : 0.f; }
                }
                const int s0 = 16 * sb + 4 * g;
                u32x2 p;
                if (dir) { p.x = cvt_pk_bf16(sa[3], sa[2]); p.y = cvt_pk_bf16(sa[1], sa[0]); *(LAS u32x2*)(lds + L_SS + trow * 272 + (124 - s0) * 2) = p; }
                else { p.x = cvt_pk_bf16(sa[0], sa[1]); p.y = cvt_pk_bf16(sa[2], sa[3]); *(LAS u32x2*)(lds + L_SS + trow * 272 + s0 * 2) = p; }
            }
            f32x4 num[9];
#pragma unroll
            for (int vb = 0; vb < 9; ++vb) { num[vb] = (f32x4){0.f, 0.f, 0.f, 0.f};
#pragma unroll
                for (int kk = 0; kk < 2; ++kk) { const bf16x8 cf = *(const LAS bf16x8*)(lds + L_CS + (16 * vb + l15) * 144 + (kk * 32 + g * 8) * 2);
                    num[vb] = __builtin_amdgcn_mfma_f32_16x16x32_bf16(cf, qf[kk], num[vb], 0, 0, 0); } }
#pragma unroll
            for (int kk = 0; kk < 4; ++kk) {
                if (kk >= klo && kk <= khi) {
                    const bf16x8 sf = *(const LAS bf16x8*)(lds + L_SS + trow * 272 + (kk * 32 + g * 8) * 2);
#pragma unroll
                    for (int vb = 0; vb < 9; ++vb) { const bf16x8 vf = *(const LAS bf16x8*)(lds + L_VTS + (16 * vb + l15) * 272 + (kk * 32 + g * 8) * 2);
                        num[vb] = __builtin_amdgcn_mfma_f32_16x16x32_bf16(vf, sf, num[vb], 0, 0, 0); }
                }
            }
            const float den = __shfl(num[8][0], l15);
            const float thr = __shfl((tb < 4) ? th0 : th1, (16 * tb + l15) & 63);
            const float inv = 1.f / fmaxf(fabsf(den), thr);
            const int tok = tok0 + (dir ? 127 - trow : trow);
            bf16_t* hp = HD + (size_t)tok * 1024 + head * 128 + 4 * g;
#pragma unroll
            for (int vb = 0; vb < 8; ++vb) { u32x2 p; p.x = cvt_pk_bf16(num[vb][0] * inv, num[vb][1] * inv); p.y = cvt_pk_bf16(num[vb][2] * inv, num[vb][3] * inv); *(u32x2*)(hp + 16 * vb) = p; }
        }
        {
            bf16x8 vf[4];
#pragma unroll
            for (int kk = 0; kk < 4; ++kk) vf[kk] = *(const LAS bf16x8*)(lds + L_VTS + (16 * w + l15) * 272 + (kk * 32 + g * 8) * 2);
#pragma unroll
            for (int db = 0; db < 4; ++db)
#pragma unroll
                for (int kk = 0; kk < 4; ++kk) { const bf16x8 kf = *(const LAS bf16x8*)(lds + L_KTS + (16 * db + l15) * 272 + (kk * 32 + g * 8) * 2);
                    st[db] = __builtin_amdgcn_mfma_f32_16x16x32_bf16(kf, vf[kk], st[db], 0, 0, 0); }
            if (w < 4) {
#pragma unroll
                for (int kk = 0; kk < 4; ++kk) { const bf16x8 kf = *(const LAS bf16x8*)(lds + L_KTS + (16 * w + l15) * 272 + (kk * 32 + g * 8) * 2);
                    const bf16x8 of = *(const LAS bf16x8*)(lds + L_VTS + (128 + l15) * 272 + (kk * 32 + g * 8) * 2);
                    nst = __builtin_amdgcn_mfma_f32_16x16x32_bf16(kf, of, nst, 0, 0, 0); }
            }
        }
        BAR_LDS();
    }
#undef PREFETCH
}

__device__ __forceinline__ void combine_rows4(const bf16_t* h0, const bf16_t* h1, bf16_t* ab, const float* nw, int lane) {
    u32x4 a[4][2], b[4][2], o[4][2];
#pragma unroll
    for (int q = 0; q < 4; ++q)
#pragma unroll
        for (int i = 0; i < 2; ++i) { const int p = lane + 64 * i;
            a[q][i] = *(const u32x4*)(h0 + (size_t)q * 1024 + 8 * p); b[q][i] = *(const u32x4*)(h1 + (size_t)q * 1024 + 8 * p); o[q][i] = *(const u32x4*)(ab + (size_t)q * 2048 + 8 * p); }
#pragma unroll
    for (int i = 0; i < 2; ++i) { const int p = lane + 64 * i;
        const f32x4 n0 = *(const f32x4*)(nw + 8 * p), n1 = *(const f32x4*)(nw + 8 * p + 4);
#pragma unroll
        for (int q = 0; q < 4; ++q) { const u32x4 aa = a[q][i], bb = b[q][i], oo = o[q][i];
            float s[8] = {bf_lo(aa.x) + bf_lo(bb.x), bf_hi(aa.x) + bf_hi(bb.x), bf_lo(aa.y) + bf_lo(bb.y), bf_hi(aa.y) + bf_hi(bb.y), bf_lo(aa.z) + bf_lo(bb.z), bf_hi(aa.z) + bf_hi(bb.z), bf_lo(aa.w) + bf_lo(bb.w), bf_hi(aa.w) + bf_hi(bb.w)};
            float ss = 0.f;
#pragma unroll
            for (int j = 0; j < 8; ++j) ss += s[j] * s[j];
            ss += dppf<0x121>(0.f, ss); ss += dppf<0x122>(0.f, ss); ss += dppf<0x124>(0.f, ss); ss += dppf<0x128>(0.f, ss);
            const float r = rsqrtf(ss * (1.f / 128.f) + EPS);
            const float og[8] = {bf_lo(oo.x), bf_hi(oo.x), bf_lo(oo.y), bf_hi(oo.y), bf_lo(oo.z), bf_hi(oo.z), bf_lo(oo.w), bf_hi(oo.w)};
            u32x4 qv;
            qv.x = cvt_pk_bf16(s[0] * r * n0[0] * og[0], s[1] * r * n0[1] * og[1]); qv.y = cvt_pk_bf16(s[2] * r * n0[2] * og[2], s[3] * r * n0[3] * og[3]);
            qv.z = cvt_pk_bf16(s[4] * r * n1[0] * og[4], s[5] * r * n1[1] * og[5]); qv.w = cvt_pk_bf16(s[6] * r * n1[2] * og[6], s[7] * r * n1[3] * og[7]);
            *(u32x4*)(ab + (size_t)q * 2048 + 8 * p) = qv; } }
}

#define XB_TMO      128
#define XB_XCNT(j)  (256  + 64 * (j))
#define XB_XSUB(j)  (1280 + 64 * (j))
#define XB_XGEN(j)  (2304 + 64 * (j))
#define XB_TOP      3328
#define XB_TOPGEN   3392
#define XCD_BAR_WORDS 3456
#define XB_SPIN_CAP (1u << 18)
__device__ __forceinline__ unsigned xb_ld(unsigned* p)              { return __hip_atomic_load(p, __ATOMIC_RELAXED, __HIP_MEMORY_SCOPE_AGENT); }
__device__ __forceinline__ unsigned xb_add(unsigned* p, unsigned v) { return __hip_atomic_fetch_add(p, v, __ATOMIC_RELAXED, __HIP_MEMORY_SCOPE_AGENT); }
__device__ __forceinline__ unsigned xb_xcc_id() { return (unsigned)__builtin_amdgcn_s_getreg((3 << 11) | 20) & 0xFu; }
#define XB_SPIN(cond, bar) do { unsigned _sp = 0; while (cond) { __builtin_amdgcn_s_sleep(1); \
    if ((++_sp & 255u) == 0u) { if (xb_ld(&(bar)[XB_TMO])) break; if (_sp > XB_SPIN_CAP) { atomicAdd(&(bar)[XB_TMO], 1u); break; } } } } while (0)
struct XcdBarrier { unsigned* bar; unsigned x; volatile LAS unsigned* st; };
__device__ __forceinline__ XcdBarrier xcd_barrier_post(unsigned* bar, volatile LAS unsigned* st) {
    XcdBarrier b; b.bar = bar; b.x = xb_xcc_id(); b.st = st;
    if (threadIdx.x == 0) (void)xb_add(&bar[XB_XCNT(b.x)], 1u);
    return b;
}
__device__ __forceinline__ void xcd_barrier_complete(unsigned* bar, unsigned x, unsigned& nloc, unsigned& nx) {
    const unsigned G = gridDim.x * gridDim.y * gridDim.z;
    unsigned sum, cnt, mine, sp = 0u;
    for (;;) {
        sum = 0u; cnt = 0u; mine = 0u;
#pragma unroll
        for (unsigned j = 0; j < 16; ++j) { const unsigned c = xb_ld(&bar[XB_XCNT(j)]); sum += c; cnt += (c > 0u) ? 1u : 0u; mine = (j == x) ? c : mine; }
        if (sum == G) break;
        __builtin_amdgcn_s_sleep(1);
        if ((++sp & 255u) == 0u) { if (xb_ld(&bar[XB_TMO])) break; if (sp > XB_SPIN_CAP) { atomicAdd(&bar[XB_TMO], 1u); break; } }
    }
    nloc = mine > 0u ? mine : 1u; nx = cnt > 0u ? cnt : 1u;
}
__device__ __forceinline__ void xcd_barrier(const XcdBarrier& b) {
    asm volatile("s_waitcnt vmcnt(0)" ::: "memory");
    __syncthreads();
    if (threadIdx.x == 0) {
        unsigned* bar = b.bar;
        __builtin_amdgcn_s_waitcnt(0);
        unsigned nloc = b.st[0], nx = b.st[1];
        if (nloc == 0u) { xcd_barrier_complete(bar, b.x, nloc, nx); b.st[0] = nloc; b.st[1] = nx; }
        const unsigned old = xb_add(&bar[XB_XSUB(b.x)], 1u);
        const unsigned gen = old / nloc;
        if (old + 1u == (gen + 1u) * nloc) {
            __builtin_amdgcn_fence(__ATOMIC_RELEASE, "agent");
            asm volatile("s_waitcnt vmcnt(0)" ::: "memory");
            const unsigned og = xb_add(&bar[XB_TOP], 1u);
            const unsigned tg = og / nx;
            if (og + 1u == (tg + 1u) * nx) xb_add(&bar[XB_TOPGEN], 1u);
            else XB_SPIN(xb_ld(&bar[XB_TOPGEN]) == tg, bar);
            __builtin_amdgcn_fence(__ATOMIC_ACQUIRE, "agent");
            xb_add(&bar[XB_XGEN(b.x)], 1u);
            asm volatile("s_waitcnt vmcnt(0)" ::: "memory");
        } else {
            XB_SPIN(xb_ld(&bar[XB_XGEN(b.x)]) == gen, bar);
            __builtin_amdgcn_fence(__ATOMIC_ACQUIRE, "agent");
            asm volatile("s_waitcnt vmcnt(0)" ::: "memory");
        }
    }
    __syncthreads();
}

constexpr int N_PHASES = 11;
__global__ void __launch_bounds__(512, 2) mk_fwd(Args A) {
    extern __shared__ __attribute__((aligned(16))) unsigned char lds_raw[];
    LAS unsigned char* lds = (LAS unsigned char*)lds_raw;
    cg::grid_group grid = cg::this_grid();
    const int tid = threadIdx.x, lane = tid & 63, wave = __builtin_amdgcn_readfirstlane(tid >> 6);
    const int G = gridDim.x, gw = blockIdx.x * 8 + wave, NGW = G * 8;
    unsigned char* ws = A.ws;
    const float* mod = (const float*)(ws + WS_MOD);
    bf16_t* H = (bf16_t*)(ws + WS_H);
    const int lo = A.ph_lo, hi = A.ph_hi;
#ifndef PHMASK
#define PHMASK 0x7ff
#endif
#ifndef REPMASK
#define REPMASK 0
#endif
#ifndef XSYNC
#define XSYNC 0
#endif
#ifndef TS_LO
#define TS_LO -2
#define TS_HI -2
#endif
#define REP(k) for (int rep_ = 0; rep_ < 1 + ((REPMASK >> (k)) & 1); ++rep_)
#define IN(k) (((PHMASK >> (k)) & 1) && lo <= (k) && (k) < hi)
    unsigned* barw = (unsigned*)(ws + WS_BAR);
    volatile LAS unsigned* bst = (volatile LAS unsigned*)(lds + LDS_BYTES - 16);
    if (tid < 4) bst[tid] = 0u;
    __syncthreads();
    if (hi < 0) grid.sync();
    XcdBarrier xbar = xcd_barrier_post(barw, bst);
    unsigned long long ts_a = 0, ts_b = 0;
    if (TS_LO == -1) ts_a = __builtin_amdgcn_s_memrealtime();
#define SEAM(k) do { if (IN(k) && IN((k) + 1)) xcd_barrier(xbar); if (TS_LO == (k)) ts_a = __builtin_amdgcn_s_memrealtime(); if (TS_HI == (k)) ts_b = __builtin_amdgcn_s_memrealtime(); } while (0)

    if (IN(0)) {
        unsigned* modcnt = (unsigned*)(ws + WS_MODCNT);
        p0_mod(A, lds, tid, lane, wave, modcnt);
        if (TS_LO == 20) ts_a = __builtin_amdgcn_s_memrealtime(); if (TS_HI == 20) ts_b = __builtin_amdgcn_s_memrealtime();
        __syncthreads();
        p0_weights(A, lds, tid, lane, wave);
        if (TS_LO == 21) ts_a = __builtin_amdgcn_s_memrealtime(); if (TS_HI == 21) ts_b = __builtin_amdgcn_s_memrealtime();
        if (tid == 0) { unsigned sp = 0; while (__hip_atomic_load(modcnt, __ATOMIC_RELAXED, __HIP_MEMORY_SCOPE_AGENT) < 6144u / 32u) { __builtin_amdgcn_s_sleep(2); if (++sp > (1u << 22)) break; }
            __builtin_amdgcn_fence(__ATOMIC_ACQUIRE, "agent"); asm volatile("s_waitcnt vmcnt(0)" ::: "memory"); }
        __syncthreads();
        for (int row = 4 * gw; row < MALL; row += 4 * NGW) {
            const bool isx = row < MTOK; const int bb = isx ? (row >> 11) : 16;
            const float* xr = isx ? A.in[I_X] + (size_t)row * DM : A.in[I_CTX] + (size_t)(row - MTOK) * DM;
            modulate_rows4(xr, A.in[I_N1W], mod + bb * 6144, mod + bb * 6144 + 1024, H + (size_t)row * DM, lane);
        }
    }
    if (TS_LO == 0) ts_a = __builtin_amdgcn_s_memrealtime(); if (TS_HI == 0) ts_b = __builtin_amdgcn_s_memrealtime();
    SEAM(1);
    if (IN(2)) REP(2) {
        pg8::Gemm g{H, (const bf16_t*)(ws + WS_WIN), 1024, 1024, 1024, 0}; pg8::InProjOrder S{G, (int)blockIdx.x};
        EpiInProj E{(bf16_t*)(ws + WS_K), (bf16_t*)(ws + WS_VT), (bf16_t*)(ws + WS_Q), (float*)(ws + WS_G), (bf16_t*)(ws + WS_AB), (bf16_t*)A.out, (const float*)(ws + WS_BIASP), A.in[I_CONVW]};
        pg8::gemm_phase<EpiInProj, pg8::InProjOrder>(lds, g, S, E);
    }
    SEAM(2);
    if (IN(3)) REP(3) {
        for (int seq = blockIdx.x; seq < 256; seq += G)
            mlstm_seq(lds, (const bf16_t*)(ws + WS_K), (const bf16_t*)(ws + WS_VT), (const bf16_t*)(ws + WS_Q), (const float*)(ws + WS_G), (bf16_t*)(ws + WS_H), (bf16_t*)(ws + WS_HD1), seq, tid, lane, wave);
    }
    SEAM(3);
    if (IN(4)) {
        for (int row = 4 * gw; row < MTOK; row += 4 * NGW)
            combine_rows4((const bf16_t*)(ws + WS_H) + (size_t)row * 1024, (const bf16_t*)(ws + WS_HD1) + (size_t)row * 1024, (bf16_t*)(ws + WS_AB) + (size_t)row * 2048 + 1024, A.in[I_MNW], lane);
    }
    SEAM(4);
    if (IN(5)) REP(5) {
        pg8::Gemm g{(const bf16_t*)(ws + WS_AB), (const bf16_t*)(ws + WS_BT2), 1024, 2048, 2048, 0}; pg8::SplitKOrder S; S.base.init(MTOK, 1024, G, (int)blockIdx.x);
        EpiG2 E{(const bf16_t*)A.out, (bf16_t*)(ws + WS_H)};
        pg8::gemm_phase<EpiG2, pg8::SplitKOrder>(lds, g, S, E);
    }
    SEAM(5);
    if (IN(6)) REP(6) {
        pg8::Gemm g{(const bf16_t*)(ws + WS_H), (const bf16_t*)(ws + WS_WO), 1024, 1024, 1024, 0}; pg8::StaticOrder S; S.init(MTOK, 1024, G, (int)blockIdx.x);
        EpiResNorm<0> E{A.in[I_X], A.out, mod + 2048, 0, H, A.in[I_N2W], mod, (float*)(ws + WS_XBUF), (unsigned*)(ws + WS_CNT), lds + 131072};
        pg8::gemm_phase<EpiResNorm<0>, pg8::StaticOrder>(lds, g, S, E);
    }
    SEAM(6);
    if (IN(8)) REP(8) {
        pg8::Gemm g{H, (const bf16_t*)(ws + WS_W1), 1024, 1024, 1024, 0}; pg8::StaticOrder S; S.init(MTOK, DFF, G, (int)blockIdx.x);
        EpiRelu2 E{(bf16_t*)(ws + WS_F1), DFF};
        pg8::gemm_phase<EpiRelu2, pg8::StaticOrder>(lds, g, S, E);
    }
    SEAM(8);
    if (IN(9)) {
        pg8::Gemm g{(const bf16_t*)(ws + WS_F1), (const bf16_t*)(ws + WS_W2), DFF, DFF, F1P, 1}; pg8::StaticOrder S; S.init(MTOK, 1024, G, (int)blockIdx.x);
        EpiResNorm<1> E{A.out, A.out, mod + 5120, 1, nullptr, A.in[I_FNW], mod, (float*)(ws + WS_XBUF) + (size_t)MTOK * 4, (unsigned*)(ws + WS_CNT) + 128 * 64, lds + 131072};
        pg8::gemm_phase<EpiResNorm<1>, pg8::StaticOrder>(lds, g, S, E);
    }
    if (TS_LO > -2) {
        xcd_barrier(xbar); if (TS_HI == 9) ts_b = __builtin_amdgcn_s_memrealtime();
        if (blockIdx.x == 0) { const int n = (int)((ts_b - ts_a) / 100ull); for (int i = tid; i < n; i += 512) A.out[(size_t)i * 4096 + 3] += 0.25f; }
    }
#undef IN
#undef SEAM
}

#ifndef MK_N_LAUNCHES
#define MK_N_LAUNCHES 1
#endif
extern "C" void kernel_launch(void* const* d_in, const int* in_sizes, int n_in, void* d_out, int out_size, void* d_ws, size_t ws_size, hipStream_t stream) {
    static int grid = 0;
    if (grid == 0) {
        if (n_in != 18 || out_size != MTOK * DM || ws_size < WS_END) { fprintf(stderr, "kernel_launch: unexpected shapes (n_in %d out %d ws %zu)\n", n_in, out_size, ws_size); grid = -1; return; }
        int dev = 0, cus = 0, per_cu = 0;
        hipGetDevice(&dev); hipDeviceGetAttribute(&cus, hipDeviceAttributeMultiprocessorCount, dev);
        hipFuncSetAttribute((const void*)mk_fwd, hipFuncAttributeMaxDynamicSharedMemorySize, LDS_BYTES);
        if (hipOccupancyMaxActiveBlocksPerMultiprocessor(&per_cu, (const void*)mk_fwd, 512, LDS_BYTES) != hipSuccess || per_cu < 1) { fprintf(stderr, "kernel_launch: occupancy query says %d\n", per_cu); per_cu = 1; }
        (void)hipGetLastError();
        grid = cus * per_cu;
        if (grid > 256) grid = 256;
    }
    if (grid < 0) return;
    Args a{};
    for (int i = 0; i < 18; ++i) a.in[i] = (const float*)d_in[i];
    a.out = (float*)d_out; a.ws = (unsigned char*)d_ws;
    (void)hipMemsetAsync((unsigned char*)d_ws + WS_BAR, 0, 256 * 1024, stream);
#if MK_N_LAUNCHES == 1
    a.ph_lo = 0; a.ph_hi = N_PHASES;
    void* args[] = {&a};
    hipError_t e = hipLaunchCooperativeKernel((const void*)mk_fwd, dim3(grid), dim3(512), args, LDS_BYTES, stream);
    if (e != hipSuccess) fprintf(stderr, "cooperative launch failed: %s (grid %d)\n", hipGetErrorString(e), grid);
#else
    for (int p = 0; p < N_PHASES; ++p) { a.ph_lo = p; a.ph_hi = p + 1; hipLaunchKernelGGL(mk_fwd, dim3(grid), dim3(512), LDS_BYTES, stream, a); }
#endif
}
```

```cpp
#include <hip/hip_runtime.h>
#include <hip/hip_cooperative_groups.h>
#include <cstdio>
#include <cstdint>
namespace cg = cooperative_groups;

#define LAS __attribute__((address_space(3)))
typedef unsigned short bf16_t;
typedef short bf16x8 __attribute__((ext_vector_type(8)));
typedef float f32x4 __attribute__((ext_vector_type(4)));
typedef unsigned u32x4 __attribute__((ext_vector_type(4)));
typedef unsigned u32x2 __attribute__((ext_vector_type(2)));

constexpr int DM = 1024, NB = 16, SEQ = 2048, CTXL = 256, NH = 8, DK = 64, DV = 128, DFF = 4096;
constexpr int MTOK = NB * SEQ;
constexpr int MCTX = NB * CTXL;
constexpr int MALL = MTOK + MCTX;
constexpr int DIN = 8224, NIN = 8448;
constexpr float EPS = 1e-6f;
constexpr int OFF_K = 0, OFF_V = 512, OFF_IG = 1536, OFF_Q = 1568, OFF_O = 2080, OFF_XIN = 3104, OFF_GC = 4128, OFF_GB = 5152, OFF_MRG = 6176;

constexpr size_t MiB = 1u << 20;
constexpr size_t WS_MOD = 0;
constexpr size_t WS_BIASP = 512 * 1024;
constexpr size_t WS_BAR = 768 * 1024;
constexpr size_t WS_MODCNT = 900 * 1024;
constexpr size_t WS_CNT = 800 * 1024;
constexpr size_t WS_XBUF = 450 * MiB;
constexpr size_t WS_WIN = 1 * MiB;
constexpr size_t WS_BT2 = 18 * MiB;
constexpr size_t WS_WO = 22 * MiB;
constexpr size_t WS_W1 = 24 * MiB;
constexpr int F1P = DFF + 64;
constexpr size_t WS_W2 = 452 * MiB;
constexpr size_t WS_H = 40 * MiB;
constexpr size_t WS_K = 112 * MiB;
constexpr size_t WS_VT = 148 * MiB;
constexpr size_t WS_Q = 220 * MiB;
constexpr size_t WS_G = 252 * MiB;
constexpr size_t WS_AB = 258 * MiB;
constexpr size_t WS_HD1 = 386 * MiB;
constexpr size_t WS_F1 = 112 * MiB;
constexpr size_t WS_END = 462 * MiB;

constexpr int LDS_BYTES = 155648;

typedef float f32x2_t __attribute__((ext_vector_type(2))); typedef __bf16 bf16x2_t __attribute__((ext_vector_type(2)));
__device__ __forceinline__ unsigned cvt_pk_bf16(float lo, float hi) { const f32x2_t v = {lo, hi}; const bf16x2_t b = __builtin_convertvector(v, bf16x2_t); return __builtin_bit_cast(unsigned, b); }
__device__ __forceinline__ float bf_lo(unsigned w) { return __uint_as_float(w << 16); }
__device__ __forceinline__ float bf_hi(unsigned w) { return __uint_as_float(w & 0xffff0000u); }
__device__ __forceinline__ float sigm(float x) { return __builtin_amdgcn_rcpf(1.f + __expf(-x)); }
__device__ __forceinline__ float wave_sum(float v) {
#pragma unroll
    for (int o = 1; o < 64; o <<= 1) v += __shfl_xor(v, o);
    return v;
}
__device__ __forceinline__ float wave_max(float v) {
#pragma unroll
    for (int o = 1; o < 64; o <<= 1) v = fmaxf(v, __shfl_xor(v, o));
    return v;
}
template <int CTRL, int RM = 0xf> __device__ __forceinline__ float dppf(float old, float src) {
    return __int_as_float(__builtin_amdgcn_update_dpp(__float_as_int(old), __float_as_int(src), CTRL, RM, 0xf, false));
}
__device__ __forceinline__ float wave_scan_add(float x) {
    x += dppf<0x111>(0.f, x); x += dppf<0x112>(0.f, x); x += dppf<0x114>(0.f, x); x += dppf<0x118>(0.f, x);
    x += dppf<0x142, 0xA>(0.f, x); x += dppf<0x143, 0xC>(0.f, x); return x;
}
__device__ __forceinline__ float wave_scan_max(float x) {
    const float ninf = -INFINITY;
    x = fmaxf(x, dppf<0x111>(ninf, x)); x = fmaxf(x, dppf<0x112>(ninf, x)); x = fmaxf(x, dppf<0x114>(ninf, x)); x = fmaxf(x, dppf<0x118>(ninf, x));
    x = fmaxf(x, dppf<0x142, 0xA>(ninf, x)); x = fmaxf(x, dppf<0x143, 0xC>(ninf, x)); return x;
}
__device__ __forceinline__ float lane63(float x) { return __int_as_float(__builtin_amdgcn_readlane(__float_as_int(x), 63)); }
__device__ __forceinline__ float logsig(float x) { return fminf(x, 0.f) - __logf(1.f + __expf(-fabsf(x))); }

namespace pg8 {
constexpr int BM = 256, BK = 64, HALF = 128, HTB = HALF * BK * 2, STAGE_BYTES = 8 * HTB, NXCD = 8, WGM = 8;
__host__ __device__ __forceinline__ int lds_byte(int r, int c) { const int st = (r >> 4) * 2 + (c >> 5), rr = r & 15, cc = c & 31, ob = rr * 64 + cc * 2; return st * 1024 + (ob ^ (((ob >> 9) & 1) << 5)); }
__host__ __device__ __forceinline__ void stage_rc(int b, int& R, int& C) { const int st = b / 1024, sb = b % 1024, swz = sb ^ (((sb >> 9) & 1) << 5); R = (st >> 1) * 16 + swz / 64; C = (st & 1) * 32 + (swz % 64) / 2; }
__host__ __device__ __forceinline__ int perm32(int rho) { const int n = rho >> 4, i = rho & 15; return 8 * (i >> 2) + 4 * n + (i & 3); }

struct Unit { int pm, pn, sw, h; };
struct Gemm { const bf16_t* A; const bf16_t* Bt; int K, lda, ldb, atile; };

__device__ __forceinline__ void rect_map(int l, int nM, int nN, int& pm, int& pn) {
    const int nig = WGM * nN, gid = l / nig, fm = gid * WGM, gsz = (nM - fm) < WGM ? (nM - fm) : WGM, rem = l % nig;
    pm = fm + rem % gsz; pn = rem / gsz;
}
struct StaticOrder {
    int nM, nN, nwg, G, c, rev = 0;
    __device__ void init(int M, int N, int G_, int c_) { nM = M / BM; nN = N / BM; nwg = nM * nN; G = G_; c = c_; }
    __device__ bool next(int i, Unit& u) const {
        const long L = (long)i * G + c; if (L >= nwg) return false;
        int wgid = (int)L; { const int q = nwg / NXCD, r = nwg % NXCD, xcd = wgid % NXCD, off = wgid / NXCD; wgid = (xcd < r ? xcd * (q + 1) : r * (q + 1) + (xcd - r) * q) + off; }
        rect_map(wgid, nM, nN, u.pm, u.pn); if (rev) u.pm = nM - 1 - u.pm; u.sw = 0; u.h = 0; return true;
    }
};
struct InProjOrder {
    int G, c;
    static constexpr int N_RC = 128 * 26, N_RB = 144 * 4, N_RA = 144 * 3, NWG = N_RC + N_RB + N_RA;
    __device__ bool next(int i, Unit& u) const {
        const long L = (long)i * G + c; if (L >= NWG) return false;
        int w = (int)L; w = (w % NXCD) * (NWG / NXCD) + w / NXCD;
        int a, b; u.h = 0;
        if (w < N_RC) { rect_map(w, 128, 26, a, b); u.pm = a; u.pn = 7 + b; u.sw = 0; }
        else if (w < N_RC + N_RB) { rect_map(w - N_RC, 144, 4, a, b); u.pm = 3 + b; u.pn = a; u.sw = 1; }
        else { rect_map(w - N_RC - N_RB, 144, 3, a, b); u.pm = a; u.pn = b; u.sw = 0; }
        return true;
    }
};
static_assert(InProjOrder::NWG % NXCD == 0, "in-proj unit count");
struct SplitKOrder {
    StaticOrder base;
    __device__ bool next(int i, Unit& u) const { if (!base.next(i >> 1, u)) return false; u.h = i & 1; return true; }
};

template <class Epi, class Sched>
__device__ __forceinline__ void gemm_phase(LAS unsigned char* lds, const Gemm g, const Sched& S, const Epi& E) {
    const int tid = threadIdx.x, wid = __builtin_amdgcn_readfirstlane(tid >> 6), lane = tid & 63, wr = wid >> 2, wc = wid & 3, fr = lane & 15, fq = lane >> 4;
    const int K = g.K, nt = K / BK;
    unsigned voffA[2], voffB[2];
#pragma unroll
    for (int i = 0; i < 2; ++i) { int R, C; stage_rc(tid * 16 + i * 8192, R, C); const int Rb = (R & ~31) + perm32(R & 31);
        voffA[i] = g.atile ? (unsigned)(R * BK + C) * 2u : (unsigned)(R * g.lda + C) * 2u; voffB[i] = (unsigned)(Rb * g.ldb + C) * 2u; }
    const size_t kstep = (size_t)(BK * 2), kstepA = g.atile ? (size_t)HTB : kstep;
    const size_t hstepA = g.atile ? (size_t)(g.lda / BK) * HTB : (size_t)HALF * g.lda * 2, hstepB = (size_t)HALF * g.ldb * 2;
    const unsigned ldsw = (unsigned)wid * 1024u;
    const int aoff = lds_byte(wr * 64 + fr, fq * 8), boff = lds_byte(wc * 32 + fr, fq * 8);
#define PG8_SA(b, h) (((b) * 2 + (h)) * HTB)
#define PG8_SB(b, h) ((4 + (b) * 2 + (h)) * HTB)
#define PG8_STAGE(bufoff, gbase, voff) do { _Pragma("unroll") for (int _i = 0; _i < 2; ++_i) \
        __builtin_amdgcn_global_load_lds((const unsigned*)((const char*)(gbase) + (voff)[_i]), (LAS unsigned*)(lds + (bufoff) + ldsw + _i * 8192), 16, 0, 0); } while (0)
#define PG8_LDA(dst, b, h) do { _Pragma("unroll") for (int m = 0; m < 4; ++m) _Pragma("unroll") for (int k = 0; k < 2; ++k) dst[m][k] = *(const LAS bf16x8*)(lds + PG8_SA(b, h) + aoff + m * 2048 + k * 1024); } while (0)
#define PG8_LDB(dst, b, h) do { _Pragma("unroll") for (int n = 0; n < 2; ++n) _Pragma("unroll") for (int k = 0; k < 2; ++k) dst[n][k] = *(const LAS bf16x8*)(lds + PG8_SB(b, h) + boff + n * 2048 + k * 1024); } while (0)
#define PG8_MMA(ai, bj, At, Bt) do { __builtin_amdgcn_s_setprio(1); _Pragma("unroll") for (int m = 0; m < 4; ++m) _Pragma("unroll") for (int n = 0; n < 2; ++n) _Pragma("unroll") for (int k = 0; k < 2; ++k) \
        acc[ai][bj][m][n] = __builtin_amdgcn_mfma_f32_16x16x32_bf16(Bt[n][k], At[m][k], acc[ai][bj][m][n], 0, 0, 0); __builtin_amdgcn_s_setprio(0); } while (0)
#define PG8_WAIT_V(n) asm volatile("s_waitcnt vmcnt(" #n ")" ::: "memory")
#define PG8_WAIT_L(n) asm volatile("s_waitcnt lgkmcnt(" #n ")" ::: "memory")
#define PG8_BAR __builtin_amdgcn_s_barrier()
#define PG8_SCHED __builtin_amdgcn_sched_barrier(0)
#define PG8_PA(u) ((const char*)((u).sw ? g.Bt : g.A) + (size_t)(u).pm * 2 * hstepA + (size_t)(u).h * K * 2)
#define PG8_PB(u) ((const char*)((u).sw ? g.A : g.Bt) + (size_t)(u).pn * 2 * hstepB + (size_t)(u).h * K * 2)
    Unit cur, nxt; int ui = 0;
    if (!S.next(0, cur)) return;
    f32x4 acc[2][2][4][2];
#pragma unroll
    for (int a = 0; a < 2; ++a)
#pragma unroll
        for (int b = 0; b < 2; ++b)
#pragma unroll
            for (int m = 0; m < 4; ++m)
#pragma unroll
                for (int n = 0; n < 2; ++n) acc[a][b][m][n] = (f32x4){0.f, 0.f, 0.f, 0.f};
    bf16x8 At[4][2], B0[2][2], B1[2][2];
    const char* cA = PG8_PA(cur); const char* cB = PG8_PB(cur);
    PG8_STAGE(PG8_SB(0, 0), cB, voffB); PG8_STAGE(PG8_SB(0, 1), cB + hstepB, voffB); PG8_STAGE(PG8_SA(0, 0), cA, voffA); PG8_STAGE(PG8_SA(0, 1), cA + hstepA, voffA);
    if (wr == 1) PG8_BAR;
    PG8_WAIT_V(2); PG8_BAR;
    PG8_STAGE(PG8_SB(1, 0), cB + kstep, voffB); PG8_STAGE(PG8_SA(1, 0), cA + kstepA, voffA); PG8_STAGE(PG8_SB(1, 1), cB + hstepB + kstep, voffB);
    PG8_WAIT_V(6); PG8_BAR;
    for (;;) {
        const bool has_next = S.next(ui + 1, nxt);
        const char* nA = has_next ? PG8_PA(nxt) : cA; const char* nB = has_next ? PG8_PB(nxt) : cB;
        for (int t = 0; t < nt; t += 2) {
            const bool last = (t == nt - 2);
            const char* a1 = cA + (size_t)(t + 1) * kstepA;
            const char* a2 = last ? nA : cA + (size_t)(t + 2) * kstepA; const char* b2 = last ? nB : cB + (size_t)(t + 2) * kstep;
            const char* a3 = a2 + kstepA; const char* b3 = b2 + kstep;
            PG8_LDB(B0, 0, 0); PG8_LDB(B1, 0, 1); PG8_SCHED; PG8_LDA(At, 0, 0); PG8_STAGE(PG8_SA(1, 1), a1 + hstepA, voffA);
            PG8_WAIT_V(8); PG8_WAIT_L(0); PG8_BAR; PG8_MMA(0, 0, At, B0); PG8_MMA(0, 1, At, B1); PG8_BAR; PG8_SCHED;
            PG8_LDA(At, 0, 1); PG8_STAGE(PG8_SB(0, 0), b2, voffB); PG8_STAGE(PG8_SB(0, 1), b2 + hstepB, voffB); PG8_STAGE(PG8_SA(0, 0), a2, voffA);
            PG8_WAIT_V(8); PG8_WAIT_L(0); PG8_BAR; PG8_MMA(1, 0, At, B0); PG8_MMA(1, 1, At, B1); PG8_BAR; PG8_SCHED;
            PG8_LDB(B0, 1, 0); PG8_LDB(B1, 1, 1); PG8_SCHED; PG8_LDA(At, 1, 0); PG8_STAGE(PG8_SA(0, 1), a2 + hstepA, voffA);
            PG8_WAIT_V(8); PG8_WAIT_L(0); PG8_BAR; PG8_MMA(0, 0, At, B0); PG8_MMA(0, 1, At, B1); PG8_BAR; PG8_SCHED;
            PG8_LDA(At, 1, 1); PG8_STAGE(PG8_SB(1, 0), b3, voffB); PG8_STAGE(PG8_SB(1, 1), b3 + hstepB, voffB); PG8_STAGE(PG8_SA(1, 0), a3, voffA);
            PG8_WAIT_V(8); PG8_WAIT_L(0); PG8_BAR; PG8_MMA(1, 0, At, B0); PG8_MMA(1, 1, At, B1); PG8_BAR; PG8_SCHED;
        }
        if (wr == 0) PG8_BAR;
        bool keep = false;
        if constexpr (Epi::HAS_MID) keep = (cur.h == 0);
        if constexpr (Epi::HAS_MID) { if (keep) E.mid(acc, cur, wr, wc, fr, fq); else E(acc, cur, wr, wc, fr, fq); }
        else E(acc, cur, wr, wc, fr, fq);
        if (!has_next) break;
        if (!keep)
#pragma unroll
        for (int a = 0; a < 2; ++a)
#pragma unroll
            for (int b = 0; b < 2; ++b)
#pragma unroll
                for (int m = 0; m < 4; ++m)
#pragma unroll
                    for (int n = 0; n < 2; ++n) acc[a][b][m][n] = (f32x4){0.f, 0.f, 0.f, 0.f};
        cur = nxt; cA = nA; cB = nB; ++ui;
        if (wr == 1) PG8_BAR;
    }
    PG8_WAIT_V(0);
    PG8_BAR;
#undef PG8_SA
#undef PG8_SB
#undef PG8_STAGE
#undef PG8_LDA
#undef PG8_LDB
#undef PG8_MMA
#undef PG8_WAIT_V
#undef PG8_WAIT_L
#undef PG8_BAR
#undef PG8_SCHED
#undef PG8_PA
#undef PG8_PB
}
}
using pg8::Unit;

typedef f32x4 Acc[2][2][4][2];

__device__ __forceinline__ u32x4 pack8(const f32x4 v0, const f32x4 v1) {
    u32x4 w; w.x = cvt_pk_bf16(v0[0], v0[1]); w.y = cvt_pk_bf16(v0[2], v0[3]); w.z = cvt_pk_bf16(v1[0], v1[1]); w.w = cvt_pk_bf16(v1[2], v1[3]); return w;
}

struct EpiInProj {
    static constexpr bool HAS_MID = false;
    bf16_t* Kb; bf16_t* VTb; bf16_t* Qb; float* Gb; bf16_t* AB; bf16_t* MG; const float* biasp; const float* convw;
    __device__ __forceinline__ void operator()(Acc& acc, const Unit& u, int wr, int wc, int fr, int fq) const {
        if (u.sw) {
            const int r0 = u.pm * 256 + wr * 64 + fr, t0 = u.pn * 256 + wc * 32 + 8 * fq;
#pragma unroll
            for (int ai = 0; ai < 2; ++ai)
#pragma unroll
                for (int m = 0; m < 4; ++m) { const int wrow = r0 + ai * 128 + m * 16; const float bs = biasp[wrow]; bf16_t* rowp = VTb + (size_t)(wrow - 768) * MALL + t0;
#pragma unroll
                    for (int bj = 0; bj < 2; ++bj) *(u32x4*)(rowp + bj * 128) = pack8(acc[ai][bj][m][0] + bs, acc[ai][bj][m][1] + bs); }
            return;
        }
        const int row0 = u.pm * 256 + wr * 64 + fr, pn = u.pn;
        const int cb = pn * 256 + wc * 32 + 8 * fq;
        if (pn == 2) {
            if (wc == 0) {
                const f32x4 b0 = *(const f32x4*)(biasp + cb), b1 = *(const f32x4*)(biasp + cb + 4);
#pragma unroll
                for (int ai = 0; ai < 2; ++ai)
#pragma unroll
                    for (int m = 0; m < 4; ++m) { float* gp = Gb + (size_t)(row0 + ai * 128 + m * 16) * 32 + 8 * fq;
                        f32x4 g0 = acc[ai][0][m][0] + b0, g1 = acc[ai][0][m][1] + b1;
                        if (fq >= 2) {
#pragma unroll
                            for (int j = 0; j < 4; ++j) { g0[j] = logsig(g0[j]); g1[j] = logsig(g1[j]); } }
                        *(f32x4*)gp = g0; *(f32x4*)(gp + 4) = g1; }
            }
            return;
        }
        if (pn >= 9 && pn < 25) {
            const int ch = 64 * (pn - 9) + 16 * wc + 4 * fq;
            const f32x4 bX = *(const f32x4*)(biasp + cb), bC = *(const f32x4*)(biasp + cb + 4), bB = *(const f32x4*)(biasp + cb + 128), bO = *(const f32x4*)(biasp + cb + 132);
            const f32x4 w0 = *(const f32x4*)(convw + ch), w1 = *(const f32x4*)(convw + 1024 + ch), w2 = *(const f32x4*)(convw + 2048 + ch);
#pragma unroll
            for (int ai = 0; ai < 2; ++ai) {
                f32x4 uu[4];
#pragma unroll
                for (int m = 0; m < 4; ++m) uu[m] = (acc[ai][0][m][0] + bX) * (acc[ai][0][m][1] + bC);
#pragma unroll
                for (int m = 0; m < 4; ++m) {
                    f32x4 pv, nx;
#pragma unroll
                    for (int j = 0; j < 4; ++j) {
                        const float pold = (m > 0) ? dppf<0x121>(0.f, uu[m > 0 ? m - 1 : 0][j]) : 0.f;
                        pv[j] = dppf<0x111>(pold, uu[m][j]);
                        const float nold = (m < 3) ? dppf<0x12F>(0.f, uu[m < 3 ? m + 1 : 3][j]) : 0.f;
                        nx[j] = dppf<0x101>(nold, uu[m][j]);
                    }
                    const f32x4 cv = w0 * pv + w1 * uu[m] + w2 * nx;
                    const f32x4 aa = (acc[ai][1][m][0] + bB) * cv;
                    f32x4 os = acc[ai][1][m][1] + bO;
#pragma unroll
                    for (int j = 0; j < 4; ++j) os[j] = sigm(os[j]);
                    bf16_t* rp = AB + (size_t)(row0 + ai * 128 + m * 16) * 2048 + ch;
                    u32x2 wa, wo; wa.x = cvt_pk_bf16(aa[0], aa[1]); wa.y = cvt_pk_bf16(aa[2], aa[3]); wo.x = cvt_pk_bf16(os[0], os[1]); wo.y = cvt_pk_bf16(os[2], os[3]);
                    *(u32x2*)rp = wa; *(u32x2*)(rp + 1024) = wo;
                }
            }
            return;
        }
        if (pn >= 25) {
            const int ch = 128 * (pn - 25) + 32 * wc + 8 * fq;
            f32x4 ba[2], bb[2];
#pragma unroll
            for (int n = 0; n < 2; ++n) { ba[n] = *(const f32x4*)(biasp + cb + 4 * n); bb[n] = *(const f32x4*)(biasp + cb + 128 + 4 * n); }
#pragma unroll
            for (int ai = 0; ai < 2; ++ai)
#pragma unroll
                for (int m = 0; m < 4; ++m) { bf16_t* rp = MG + (size_t)(row0 + ai * 128 + m * 16) * 2048 + ch;
                    f32x4 rr[2], gg[2];
#pragma unroll
                    for (int n = 0; n < 2; ++n) { const f32x4 xa = acc[ai][0][m][n] + ba[n], xb = acc[ai][1][m][n] + bb[n];
#pragma unroll
                        for (int j = 0; j < 4; ++j) { const float ea = 1.f + __expf(-xa[j]), eb = 1.f + __expf(-xb[j]); rr[n][j] = eb * __builtin_amdgcn_rcpf(ea); gg[n][j] = __builtin_amdgcn_rcpf(eb); } }
                    *(u32x4*)rp = pack8(rr[0], rr[1]); *(u32x4*)(rp + 1024) = pack8(gg[0], gg[1]); }
            return;
        }
        bf16_t* base; int ldc, col0, mode;
        if (pn < 2) { base = Kb; ldc = 512; col0 = pn * 256; mode = 0; }
        else { base = Qb; ldc = 512; col0 = (pn - 7) * 256; mode = 1; }
        col0 += wc * 32 + 8 * fq;
        f32x4 bv[2][2];
#pragma unroll
        for (int bj = 0; bj < 2; ++bj)
#pragma unroll
            for (int n = 0; n < 2; ++n) bv[bj][n] = *(const f32x4*)(biasp + cb + bj * 128 + 4 * n);
#pragma unroll
        for (int ai = 0; ai < 2; ++ai)
#pragma unroll
            for (int m = 0; m < 4; ++m) { bf16_t* rowp = base + (size_t)(row0 + ai * 128 + m * 16) * ldc + col0;
#pragma unroll
                for (int bj = 0; bj < 2; ++bj) { f32x4 v0 = acc[ai][bj][m][0] + bv[bj][0], v1 = acc[ai][bj][m][1] + bv[bj][1];
                    if (mode == 0) { v0 = v0 * 0.125f; v1 = v1 * 0.125f; }
                    *(u32x4*)(rowp + bj * 128) = pack8(v0, v1); } }
    }
};

struct EpiG2 {
    static constexpr bool HAS_MID = true;
    const bf16_t* MG; bf16_t* MRG;
    __device__ __forceinline__ void mid(Acc& acc, const Unit& u, int wr, int wc, int fr, int fq) const {
        const int row0 = u.pm * 256 + wr * 64 + fr, col0 = u.pn * 256 + wc * 32 + 8 * fq;
#pragma unroll
        for (int ai = 0; ai < 2; ++ai) {
            u32x4 rr[4][2];
#pragma unroll
            for (int m = 0; m < 4; ++m)
#pragma unroll
                for (int bj = 0; bj < 2; ++bj) rr[m][bj] = *(const u32x4*)(MG + (size_t)(row0 + ai * 128 + m * 16) * 2048 + col0 + bj * 128);
#pragma unroll
            for (int m = 0; m < 4; ++m)
#pragma unroll
                for (int bj = 0; bj < 2; ++bj) { const u32x4 q = rr[m][bj];
                    const f32x4 r0 = {bf_lo(q.x), bf_hi(q.x), bf_lo(q.y), bf_hi(q.y)}, r1 = {bf_lo(q.z), bf_hi(q.z), bf_lo(q.w), bf_hi(q.w)};
                    acc[ai][bj][m][0] = acc[ai][bj][m][0] * r0; acc[ai][bj][m][1] = acc[ai][bj][m][1] * r1; }
            asm volatile("" ::: "memory");
        }
    }
    __device__ __forceinline__ void operator()(Acc& acc, const Unit& u, int wr, int wc, int fr, int fq) const {
        const int row0 = u.pm * 256 + wr * 64 + fr, col0 = u.pn * 256 + wc * 32 + 8 * fq;
#pragma unroll
        for (int ai = 0; ai < 2; ++ai) {
            u32x4 gg[4][2];
#pragma unroll
            for (int m = 0; m < 4; ++m)
#pragma unroll
                for (int bj = 0; bj < 2; ++bj) gg[m][bj] = *(const u32x4*)(MG + (size_t)(row0 + ai * 128 + m * 16) * 2048 + col0 + bj * 128 + 1024);
#pragma unroll
            for (int m = 0; m < 4; ++m)
#pragma unroll
                for (int bj = 0; bj < 2; ++bj) { const u32x4 gb = gg[m][bj];
                    const f32x4 g0 = {bf_lo(gb.x), bf_hi(gb.x), bf_lo(gb.y), bf_hi(gb.y)}, g1 = {bf_lo(gb.z), bf_hi(gb.z), bf_lo(gb.w), bf_hi(gb.w)};
                    *(u32x4*)(MRG + (size_t)(row0 + ai * 128 + m * 16) * 1024 + col0 + bj * 128) = pack8(acc[ai][bj][m][0] * g0, acc[ai][bj][m][1] * g1); }
            asm volatile("" ::: "memory");
        }
    }
};
struct EpiRes {
    static constexpr bool HAS_MID = false;
    const float* base; float* out; const float* gate;
    __device__ __forceinline__ void operator()(Acc& acc, const Unit& u, int wr, int wc, int fr, int fq) const {
        const int row0 = u.pm * 256 + wr * 64 + fr, col0 = u.pn * 256 + wc * 32 + 8 * fq;
        const float* gp = gate + (size_t)((u.pm * 256) >> 11) * 6144 + col0;
        f32x4 gv[2][2];
#pragma unroll
        for (int bj = 0; bj < 2; ++bj)
#pragma unroll
            for (int n = 0; n < 2; ++n) gv[bj][n] = *(const f32x4*)(gp + bj * 128 + 4 * n);
#pragma unroll
        for (int ai = 0; ai < 2; ++ai)
#pragma unroll
            for (int m = 0; m < 4; ++m) { const size_t off = (size_t)(row0 + ai * 128 + m * 16) * 1024 + col0;
#pragma unroll
                for (int bj = 0; bj < 2; ++bj)
#pragma unroll
                    for (int n = 0; n < 2; ++n) { const f32x4 bs = *(const f32x4*)(base + off + bj * 128 + 4 * n);
                        *(f32x4*)(out + off + bj * 128 + 4 * n) = bs + gv[bj][n] * acc[ai][bj][m][n]; } }
    }
};
template <int mode> struct EpiResNorm {
    static constexpr bool HAS_MID = false;
    const float* base; float* out; const float* gate; int mode_unused;
    bf16_t* h2; const float* nw; const float* mod;
    bf16_t* x1b;
    float* xbuf; unsigned* cnt; LAS unsigned char* xl;
    __device__ __forceinline__ void operator()(Acc& acc, const Unit& u, int wr, int wc, int fr, int fq) const {
        const int wid = wr * 4 + wc, lane = fq * 16 + fr;
        const int row0 = u.pm * 256 + wr * 64 + fr, col0 = u.pn * 256 + wc * 32 + 8 * fq, bb = (u.pm * 256) >> 11;
        {
            const float* gp = gate + (size_t)bb * 6144 + col0;
            f32x4 gv[2][2];
#pragma unroll
            for (int bj = 0; bj < 2; ++bj)
#pragma unroll
                for (int n = 0; n < 2; ++n) gv[bj][n] = *(const f32x4*)(gp + bj * 128 + 4 * n);
#pragma unroll
            for (int ai = 0; ai < 2; ++ai)
#pragma unroll
                for (int m = 0; m < 4; ++m) { const size_t off = (size_t)(row0 + ai * 128 + m * 16) * 1024 + col0;
#pragma unroll
                    for (int bj = 0; bj < 2; ++bj) {
                        if (mode == 1) { const u32x4 q = *(const u32x4*)(x1b + off + bj * 128);
                            const f32x4 b0 = {bf_lo(q.x), bf_hi(q.x), bf_lo(q.y), bf_hi(q.y)}, b1 = {bf_lo(q.z), bf_hi(q.z), bf_lo(q.w), bf_hi(q.w)};
                            acc[ai][bj][m][0] = b0 + gv[bj][0] * acc[ai][bj][m][0]; acc[ai][bj][m][1] = b1 + gv[bj][1] * acc[ai][bj][m][1]; }
                        else {
#pragma unroll
                            for (int n = 0; n < 2; ++n) { const f32x4 bs = *(const f32x4*)(base + off + bj * 128 + 4 * n); acc[ai][bj][m][n] = bs + gv[bj][n] * acc[ai][bj][m][n]; } }
                    }
                    asm volatile("" : "+v"(acc[ai][0][m][0]), "+v"(acc[ai][0][m][1]), "+v"(acc[ai][1][m][0]), "+v"(acc[ai][1][m][1]));
                    if (m & 1) asm volatile("" ::: "memory"); }
        }
        LAS float* P = (LAS float*)xl; LAS float* S = (LAS float*)(xl + 4096);
#pragma unroll
        for (int ai = 0; ai < 2; ++ai)
#pragma unroll
            for (int m = 0; m < 4; ++m) { float q = 0.f;
#pragma unroll
                for (int bj = 0; bj < 2; ++bj)
#pragma unroll
                    for (int n = 0; n < 2; ++n) { const f32x4 x = acc[ai][bj][m][n]; q += (x[0] * x[0] + x[1] * x[1]) + (x[2] * x[2] + x[3] * x[3]); }
                q += __shfl_xor(q, 16); q += __shfl_xor(q, 32);
                if (fq == 0) P[(ai * 128 + wr * 64 + m * 16 + fr) * 4 + wc] = q; }
        asm volatile("s_waitcnt lgkmcnt(0)\n\ts_barrier" ::: "memory");
        const int row = wid * 32 + (lane & 31);
        if (lane < 32) { const float tot = (P[row * 4 + 0] + P[row * 4 + 1]) + (P[row * 4 + 2] + P[row * 4 + 3]);
            __hip_atomic_store(xbuf + (size_t)(u.pm * 256 + row) * 4 + u.pn, tot, __ATOMIC_RELAXED, __HIP_MEMORY_SCOPE_AGENT); }
        asm volatile("s_waitcnt vmcnt(0)" ::: "memory");
        if (lane == 0) __hip_atomic_fetch_add(cnt + 64 * u.pm, 1u, __ATOMIC_RELAXED, __HIP_MEMORY_SCOPE_AGENT);
        if (wid == 0) {
            unsigned sp = 0;
            while ((unsigned)__builtin_amdgcn_readfirstlane(__hip_atomic_load(cnt + 64 * u.pm, __ATOMIC_RELAXED, __HIP_MEMORY_SCOPE_AGENT)) < 32u) { __builtin_amdgcn_s_sleep(2); if (++sp > (1u << 20)) break; }
            __builtin_amdgcn_fence(__ATOMIC_ACQUIRE, "agent");
        }
        asm volatile("s_waitcnt vmcnt(0) lgkmcnt(0)\n\ts_barrier" ::: "memory");
        if (lane < 32) { const float* sl = xbuf + (size_t)(u.pm * 256 + row) * 4; float t = 0.f;
#pragma unroll
            for (int k = 0; k < 4; ++k) t += __hip_atomic_load(sl + k, __ATOMIC_RELAXED, __HIP_MEMORY_SCOPE_AGENT);
            S[row] = rsqrtf(t * (1.f / 1024.f) + EPS); }
        asm volatile("s_waitcnt vmcnt(0) lgkmcnt(0)\n\ts_barrier" ::: "memory");
#pragma unroll
        for (int bj = 0; bj < 2; ++bj) {
            const int c = col0 + bj * 128;
            f32x4 w0 = *(const f32x4*)(nw + c), w1 = *(const f32x4*)(nw + c + 4), h0 = (f32x4){0.f, 0.f, 0.f, 0.f}, h1 = h0;
            if (mode == 0) { const float* mb = mod + (size_t)bb * 6144 + c; w0 = w0 * (*(const f32x4*)(mb + 4096) + 1.f); w1 = w1 * (*(const f32x4*)(mb + 4100) + 1.f); h0 = *(const f32x4*)(mb + 3072); h1 = *(const f32x4*)(mb + 3076); }
#pragma unroll
            for (int ai = 0; ai < 2; ++ai)
#pragma unroll
                for (int m = 0; m < 4; ++m) { asm volatile("" ::: "memory"); const int rl = ai * 128 + wr * 64 + m * 16 + fr; const float r = S[rl]; const size_t off = (size_t)(u.pm * 256 + rl) * 1024 + c;
                    const f32x4 v0 = acc[ai][bj][m][0], v1 = acc[ai][bj][m][1];
                    if (mode == 0) { *(u32x4*)(x1b + off) = pack8(v0, v1); *(u32x4*)(h2 + off) = pack8((v0 * r) * w0 + h0, (v1 * r) * w1 + h1); }
                    else { *(f32x4*)(out + off) = (v0 * r) * w0; *(f32x4*)(out + off + 4) = (v1 * r) * w1; } }
        }
    }
};
struct EpiRelu2 {
    static constexpr bool HAS_MID = false;
    bf16_t* O; int ldc;
    __device__ __forceinline__ void operator()(Acc& acc, const Unit& u, int wr, int wc, int fr, int fq) const {
        const int row0 = u.pm * 256 + wr * 64 + fr, col0 = u.pn * 256 + wc * 32 + 8 * fq;
#pragma unroll
        for (int ai = 0; ai < 2; ++ai)
#pragma unroll
            for (int m = 0; m < 4; ++m) { const int row = row0 + ai * 128 + m * 16;
#pragma unroll
                for (int bj = 0; bj < 2; ++bj) { f32x4 v0 = acc[ai][bj][m][0], v1 = acc[ai][bj][m][1]; const int col = col0 + bj * 128;
                    bf16_t* rowp = O + ((size_t)(row >> 7) * (ldc >> 6) + (col >> 6)) * 8192 + (row & 127) * 64 + (col & 63) - bj * 128;
#pragma unroll
                    for (int j = 0; j < 4; ++j) { const float a = fmaxf(v0[j], 0.f), b = fmaxf(v1[j], 0.f); v0[j] = a * a; v1[j] = b * b; }
                    *(u32x4*)(rowp + bj * 128) = pack8(v0, v1); } }
    }
};

__device__ __forceinline__ int inproj_colmap(int n) {
    if (n < 512) return OFF_K + n;
    if (n < 768) { const int j = n - 512; return j < 32 ? OFF_IG + j : -1; }
    if (n < 1792) return OFF_V + (n - 768);
    if (n < 2304) return OFF_Q + (n - 1792);
    if (n < 6400) { const int lc = (n - 2304) & 255, jt = (n - 2304) >> 8, bj = lc >> 7, wc = (lc >> 5) & 3, fq = (lc >> 3) & 3, nn = (lc >> 2) & 1, jj = lc & 3;
        const int seg = 2 * bj + nn, ch = 64 * jt + 16 * wc + 4 * fq + jj;
        return (seg == 0 ? OFF_XIN : seg == 1 ? OFF_GC : seg == 2 ? OFF_GB : OFF_O) + ch; }
    { const int lc = (n - 6400) & 255, jt = (n - 6400) >> 8; return OFF_MRG + (lc >> 7) * 1024 + 128 * jt + (lc & 127); }
}
struct TrItem { const float* W; bf16_t* out; int ldw, nblk, ldo, kofs, item, map; };
__device__ __forceinline__ void tr_load(const TrItem& t, int lane, f32x4 (&v)[8]) {
    const int kb = t.item / t.nblk, nb = t.item % t.nblk, k0 = 64 * kb, n0 = 32 * nb;
    const int n4 = lane & 7, kr = lane >> 3;
    const int nn = n0 + 4 * n4; const int src = t.map ? inproj_colmap(nn) : nn;
#pragma unroll
    for (int it = 0; it < 8; ++it) v[it] = (src >= 0) ? *(const f32x4*)(t.W + (size_t)(k0 + 8 * it + kr) * t.ldw + src) : (f32x4){0.f, 0.f, 0.f, 0.f};
}
__device__ __forceinline__ void tr_finish(const TrItem& t, int lane, const f32x4 (&v)[8], LAS float* scr) {
    const int kb = t.item / t.nblk, nb = t.item % t.nblk, k0 = 64 * kb, n0 = 32 * nb;
    const int n4 = lane & 7, kr = lane >> 3;
#pragma unroll
    for (int it = 0; it < 8; ++it) { LAS float* d = scr + (8 * it + kr) * 33 + 4 * n4; d[0] = v[it][0]; d[1] = v[it][1]; d[2] = v[it][2]; d[3] = v[it][3]; }
    asm volatile("s_waitcnt lgkmcnt(0)" ::: "memory");
    const int c = lane & 7;
#pragma unroll
    for (int j = 0; j < 4; ++j) { const int n = (lane >> 3) + 8 * j; const LAS float* s = scr + (8 * c) * 33 + n;
        u32x4 o; o.x = cvt_pk_bf16(s[0 * 33], s[1 * 33]); o.y = cvt_pk_bf16(s[2 * 33], s[3 * 33]); o.z = cvt_pk_bf16(s[4 * 33], s[5 * 33]); o.w = cvt_pk_bf16(s[6 * 33], s[7 * 33]);
        *(u32x4*)(t.out + (size_t)(n0 + n) * t.ldo + t.kofs + k0 + 8 * c) = o; }
    asm volatile("s_waitcnt lgkmcnt(0)" ::: "memory");
}

struct Args { const float* in[18]; float* out; unsigned char* ws; int ph_lo, ph_hi; };
enum { I_X = 0, I_C, I_CTX, I_CCTX, I_WMOD, I_BMOD, I_N1W, I_WIN, I_BIN, I_CONVW, I_MNW, I_WCO, I_WMO, I_WOUT, I_N2W, I_WFF1, I_WFF2, I_FNW };

__device__ __forceinline__ void p0_mod(const Args& A, LAS unsigned char* lds, int tid, int lane, int wave, unsigned* modcnt) {
    unsigned char* ws = A.ws;
    LAS float* sl = (LAS float*)lds;
    LAS float* red = (LAS float*)(lds + 17 * 4096);
    bool filled = false; unsigned done = 0;
    for (int item = blockIdx.x; item < 6144 / 32; item += gridDim.x) {
        if (!filled) {
            float cv[34];
#pragma unroll
            for (int j = 0; j < 34; ++j) { const int i = tid + 512 * j; cv[j] = i < 16 * 1024 ? A.in[I_C][i] : A.in[I_CCTX][i - 16 * 1024]; }
#pragma unroll
            for (int j = 0; j < 34; ++j) sl[tid + 512 * j] = cv[j] * sigm(cv[j]);
            __syncthreads(); filled = true;
        }
        const int col = lane & 31, kh = lane >> 5, n0 = item * 32, kbase = 128 * wave + 64 * kh;
        float a[17];
#pragma unroll
        for (int r = 0; r < 17; ++r) a[r] = 0.f;
        const float* wp = A.in[I_WMOD] + (size_t)kbase * 6144 + n0 + col;
        float wv[64];
#pragma unroll
        for (int j = 0; j < 64; ++j) wv[j] = wp[(size_t)j * 6144];
#pragma unroll
        for (int i = 0; i < 64; i += 8) {
#pragma unroll
            for (int r = 0; r < 17; ++r) { const f32x4 s4 = *(const LAS f32x4*)(sl + r * 1024 + kbase + i), s5 = *(const LAS f32x4*)(sl + r * 1024 + kbase + i + 4);
                a[r] += (s4[0] * wv[i + 0] + s4[1] * wv[i + 1]) + (s4[2] * wv[i + 2] + s4[3] * wv[i + 3]) + (s5[0] * wv[i + 4] + s5[1] * wv[i + 5]) + (s5[2] * wv[i + 6] + s5[3] * wv[i + 7]); }
        }
#pragma unroll
        for (int r = 0; r < 17; ++r) red[((wave * 2 + kh) * 17 + r) * 32 + col] = a[r];
        __syncthreads();
        for (int o = tid; o < 17 * 32; o += 512) { const int r = o >> 5, cc = o & 31; float s = A.in[I_BMOD][n0 + cc];
#pragma unroll
            for (int p = 0; p < 16; ++p) s += red[(p * 17 + r) * 32 + cc];
            ((float*)(ws + WS_MOD))[r * 6144 + n0 + cc] = s; }
        asm volatile("s_waitcnt vmcnt(0)" ::: "memory");
        __syncthreads();
        ++done;
    }
    if (done && tid == 0) { __builtin_amdgcn_fence(__ATOMIC_RELEASE, "agent"); asm volatile("s_waitcnt vmcnt(0)" ::: "memory"); __hip_atomic_fetch_add(modcnt, done, __ATOMIC_RELAXED, __HIP_MEMORY_SCOPE_AGENT); }
}
__device__ __forceinline__ void p0_weights(const Args& A, LAS unsigned char* lds, int tid, int lane, int wave) {
    unsigned char* ws = A.ws;
    LAS float* scr = (LAS float*)(lds + wave * 16384);
    const int gw = blockIdx.x * 8 + wave, NGW = gridDim.x * 8;
    constexpr int IT_WIN = 16 * (NIN / 32), IT_SQ = 16 * 32, IT_W1 = 16 * 128, IT_W2 = 64 * 32;
    constexpr int NITEMS = IT_WIN + 3 * IT_SQ + IT_W1 + IT_W2;
    auto mk = [&](int it) -> TrItem {
        int r = it;
        if (r < IT_WIN) return TrItem{A.in[I_WIN], (bf16_t*)(ws + WS_WIN), DIN, NIN / 32, 1024, 0, r, 1}; r -= IT_WIN;
        if (r < IT_SQ) return TrItem{A.in[I_WCO], (bf16_t*)(ws + WS_BT2), 1024, 32, 2048, 0, r, 0}; r -= IT_SQ;
        if (r < IT_SQ) return TrItem{A.in[I_WMO], (bf16_t*)(ws + WS_BT2), 1024, 32, 2048, 1024, r, 0}; r -= IT_SQ;
        if (r < IT_SQ) return TrItem{A.in[I_WOUT], (bf16_t*)(ws + WS_WO), 1024, 32, 1024, 0, r, 0}; r -= IT_SQ;
        if (r < IT_W1) return TrItem{A.in[I_WFF1], (bf16_t*)(ws + WS_W1), 4096, 128, 1024, 0, r, 0}; r -= IT_W1;
        return TrItem{A.in[I_WFF2], (bf16_t*)(ws + WS_W2), 1024, 32, F1P, 0, r, 0};
    };
    if (gw < NITEMS) {
        f32x4 va[8], vb[8];
        TrItem cur = mk(gw); tr_load(cur, lane, va);
        for (int it = gw; it < NITEMS; it += 2 * NGW) {
            const bool h1 = it + NGW < NITEMS, h2 = it + 2 * NGW < NITEMS;
            TrItem nx = cur; if (h1) { nx = mk(it + NGW); tr_load(nx, lane, vb); }
            tr_finish(cur, lane, va, scr);
            if (!h1) break;
            if (h2) { cur = mk(it + 2 * NGW); tr_load(cur, lane, va); }
            tr_finish(nx, lane, vb, scr);
        }
    }
    for (int i = blockIdx.x * 512 + tid; i < NIN; i += gridDim.x * 512) { const int s = inproj_colmap(i); ((float*)(ws + WS_BIASP))[i] = s >= 0 ? A.in[I_BIN][s] : 0.f; }
}

__device__ __forceinline__ float wave_allsum(float x) { return lane63(wave_scan_add(x)); }
__device__ __forceinline__ void modulate_rows4(const float* xrow, const float* w, const float* sh, const float* sc, bf16_t* orow, int lane) {
    f32x4 v[4][4]; float r[4];
#pragma unroll
    for (int q = 0; q < 4; ++q)
#pragma unroll
        for (int j = 0; j < 4; ++j) v[q][j] = ((const f32x4*)(xrow + (size_t)q * DM))[lane + 64 * j];
#pragma unroll
    for (int q = 0; q < 4; ++q) { float s = 0.f;
#pragma unroll
        for (int j = 0; j < 4; ++j) s += (v[q][j].x * v[q][j].x + v[q][j].y * v[q][j].y) + (v[q][j].z * v[q][j].z + v[q][j].w * v[q][j].w);
        r[q] = rsqrtf(wave_allsum(s) * (1.f / DM) + EPS); }
#pragma unroll
    for (int j = 0; j < 4; ++j) { const f32x4 ww = ((const f32x4*)w)[lane + 64 * j], hh = ((const f32x4*)sh)[lane + 64 * j], cc = ((const f32x4*)sc)[lane + 64 * j];
        const f32x4 wc = ww * (cc + 1.f);
#pragma unroll
        for (int q = 0; q < 4; ++q) { const f32x4 y = (v[q][j] * r[q]) * wc + hh;
            u32x2 p; p.x = cvt_pk_bf16(y[0], y[1]); p.y = cvt_pk_bf16(y[2], y[3]); ((u32x2*)(orow + (size_t)q * DM))[lane + 64 * j] = p; } }
}

constexpr int L_QS = 0, L_KS = 18432, L_KTS = 36864, L_VTS = 54272, L_SS = 93440, L_CS = 128256, L_GW = 148992;
static_assert(L_GW + 8 * 512 <= LDS_BYTES, "mlstm LDS map");
#define BAR_LDS() asm volatile("s_waitcnt lgkmcnt(0)\n\ts_barrier" ::: "memory")

__device__ __forceinline__ void mlstm_seq(LAS unsigned char* lds, const bf16_t* Kb, const bf16_t* VTb, const bf16_t* Qb, const float* Gb, bf16_t* HD0, bf16_t* HD1, int seq, int tid, int lane, int w) {
    const int dir = seq >> 7, b = (seq >> 3) & 15, head = seq & 7;
    const int g = lane >> 4, l15 = lane & 15;
    bf16_t* HD = dir ? HD1 : HD0;
    for (int i = tid; i < 16 * 136; i += 512) { const int r = i / 136, cidx = i % 136; *(LAS bf16_t*)(lds + L_VTS + (128 + r) * 272 + cidx * 2) = (r == 0) ? (bf16_t)0x3F80 : (bf16_t)0; }
    f32x4 st[4], nst;
#pragma unroll
    for (int i = 0; i < 4; ++i) st[i] = (f32x4){0.f, 0.f, 0.f, 0.f};
    nst = (f32x4){0.f, 0.f, 0.f, 0.f};
    float mstate = 0.f;
    u32x4 pq[2], pk[2], pv[4]; float gi0, gi1, gf0, gf1;
    const int krow = tid & 127, kpc = tid >> 7;
    unsigned offq[2], offk[2], offv[4], offg0, offg1;
#pragma unroll
    for (int i = 0; i < 2; ++i) { const int p = tid + 512 * i, row = p >> 3, pc = p & 7; offq[i] = (unsigned)((dir ? 127 - row : row) * 512 + head * 64 + pc * 8);
        offk[i] = (unsigned)((dir ? 127 - krow : krow) * 512 + head * 64 + (kpc + 4 * i) * 8); }
#pragma unroll
    for (int i = 0; i < 4; ++i) { const int p = tid + 512 * i, v = p >> 4, pc = p & 15; offv[i] = (unsigned)((head * 128 + v) * MALL + pc * 8); }
    offg0 = (unsigned)((dir ? 127 - lane : lane) * 32 + dir * 8 + head); offg1 = (unsigned)((dir ? 63 - lane : lane + 64) * 32 + dir * 8 + head);
#define PREFETCH(cc) do { const int cc_ = (cc); const bool isctx_ = cc_ < 2; const int T_ = isctx_ ? CTXL : SEQ, c_ = isctx_ ? cc_ : cc_ - 2; \
        const int base_ = isctx_ ? MTOK + b * CTXL : b * SEQ; const int tok0_ = base_ + (dir ? T_ - 128 * (c_ + 1) : 128 * c_); \
        const bf16_t* qb_ = Qb + (size_t)tok0_ * 512; const bf16_t* kb_ = Kb + (size_t)tok0_ * 512; const bf16_t* vb_ = VTb + tok0_; const float* gb_ = Gb + (size_t)tok0_ * 32; \
        if (!isctx_) { _Pragma("unroll") for (int i = 0; i < 2; ++i) pq[i] = *(const u32x4*)(qb_ + offq[i]); } \
        _Pragma("unroll") for (int i = 0; i < 2; ++i) pk[i] = *(const u32x4*)(kb_ + offk[i]); \
        _Pragma("unroll") for (int i = 0; i < 4; ++i) pv[i] = *(const u32x4*)(vb_ + offv[i]); \
        gi0 = gb_[offg0]; gf0 = gb_[offg0 + 16]; gi1 = gb_[offg1]; gf1 = gb_[offg1 + 16]; \
    } while (0)
    PREFETCH(0);
    for (int cc = 0; cc < 18; ++cc) {
        const bool isctx = cc < 2; const int T_ = isctx ? CTXL : SEQ, c_ = isctx ? cc : cc - 2;
        const int tok0 = (isctx ? MTOK + b * CTXL : b * SEQ) + (dir ? T_ - 128 * (c_ + 1) : 128 * c_);
        const float b0 = wave_scan_add(gf0), b1 = wave_scan_add(gf1) + lane63(b0);
        const float a0 = gi0 - b0, a1 = gi1 - b1;
        const float Mc = fmaxf(mstate, lane63(wave_scan_max(fmaxf(a0, a1))));
        const float e0 = __expf(a0 - Mc), e1 = __expf(a1 - Mc), th0 = __expf(-b0 - Mc), th1 = __expf(-b1 - Mc);
        const float decay = __expf(mstate - Mc);
        mstate = lane63(b1) + Mc;
#pragma unroll
        for (int db = 0; db < 4; ++db) { st[db] = st[db] * decay; u32x2 p; p.x = cvt_pk_bf16(st[db][0], st[db][1]); p.y = cvt_pk_bf16(st[db][2], st[db][3]);
            *(LAS u32x2*)(lds + L_CS + (16 * w + l15) * 144 + (16 * db + 4 * g) * 2) = p; }
        if (w < 4) { nst = nst * decay; u32x2 p; p.x = cvt_pk_bf16(nst[0], nst[1]); p.y = cvt_pk_bf16(nst[2], nst[3]);
            *(LAS u32x2*)(lds + L_CS + (128 + l15) * 144 + (16 * w + 4 * g) * 2) = p; }
        if (!isctx) {
#pragma unroll
            for (int i = 0; i < 2; ++i) { const int p = tid + 512 * i, row = p >> 3, pc = p & 7; *(LAS u32x4*)(lds + L_QS + row * 144 + pc * 16) = pq[i]; }
        }
        {
            const float es = (w & 1) ? e1 : e0; const int kidx = dir ? 127 - krow : krow;
#pragma unroll
            for (int i = 0; i < 2; ++i) { const int pc = kpc + 4 * i;
                const unsigned ww[4] = {pk[i].x, pk[i].y, pk[i].z, pk[i].w}; unsigned sc4[4];
#pragma unroll
                for (int q2 = 0; q2 < 4; ++q2) { const unsigned pkd = cvt_pk_bf16(bf_lo(ww[q2]) * es, bf_hi(ww[q2]) * es); sc4[q2] = pkd;
                    *(LAS bf16_t*)(lds + L_KTS + (pc * 8 + 2 * q2) * 272 + kidx * 2) = (bf16_t)(pkd & 0xffffu);
                    *(LAS bf16_t*)(lds + L_KTS + (pc * 8 + 2 * q2 + 1) * 272 + kidx * 2) = (bf16_t)(pkd >> 16); }
                *(LAS u32x4*)(lds + L_KS + krow * 144 + pc * 16) = (u32x4){sc4[0], sc4[1], sc4[2], sc4[3]}; }
#pragma unroll
            for (int i = 0; i < 4; ++i) { const int p = tid + 512 * i, v = p >> 4, pc = p & 15; *(LAS u32x4*)(lds + L_VTS + v * 272 + pc * 16) = pv[i]; }
        }
        BAR_LDS();
        if (cc + 1 < 18) PREFETCH(cc + 1);
        if (!isctx) {
            const int tb = (w < 4) ? 2 * w : 15 - 2 * w;
            const int trow = 16 * tb + l15;
            const int klo = dir ? ((7 - tb) >> 1) : 0, khi = dir ? 3 : (tb >> 1);
            bf16x8 qf[2];
#pragma unroll
            for (int kk = 0; kk < 2; ++kk) qf[kk] = *(const LAS bf16x8*)(lds + L_QS + trow * 144 + (kk * 32 + g * 8) * 2);
#pragma unroll
            for (int sb = 0; sb < 8; ++sb) {
                f32x4 sa = (f32x4){0.f, 0.f, 0.f, 0.f};
                if (sb <= tb) {
#pragma unroll
                    for (int kk = 0; kk < 2; ++kk) { const bf16x8 kf = *(const LAS bf16x8*)(lds + L_KS + (16 * sb + l15) * 144 + (kk * 32 + g * 8) * 2);
                        sa = __builtin_amdgcn_mfma_f32_16x16x32_bf16(kf, qf[kk], sa, 0, 0, 0); }
                    if (sb == tb) { const int s0 = 16 * sb + 4 * g;
#pragma unroll
                        for (int r = 0; r < 4; ++r) sa[r] = (s0 + r <= trow) ? sa[r] : 0.f; }
                }
                const int s0 = 16 * sb + 4 * g;
                u32x2 p;
                if (dir) { p.x = cvt_pk_bf16(sa[3], sa[2]); p.y = cvt_pk_bf16(sa[1], sa[0]); *(LAS u32x2*)(lds + L_SS + trow * 272 + (124 - s0) * 2) = p; }
                else { p.x = cvt_pk_bf16(sa[0], sa[1]); p.y = cvt_pk_bf16(sa[2], sa[3]); *(LAS u32x2*)(lds + L_SS + trow * 272 + s0 * 2) = p; }
            }
            f32x4 num[9];
#pragma unroll
            for (int vb = 0; vb < 9; ++vb) { num[vb] = (f32x4){0.f, 0.f, 0.f, 0.f};
#pragma unroll
                for (int kk = 0; kk < 2; ++kk) { const bf16x8 cf = *(const LAS bf16x8*)(lds + L_CS + (16 * vb + l15) * 144 + (kk * 32 + g * 8) * 2);
                    num[vb] = __builtin_amdgcn_mfma_f32_16x16x32_bf16(cf, qf[kk], num[vb], 0, 0, 0); } }
#pragma unroll
            for (int kk = 0; kk < 4; ++kk) {
                if (kk >= klo && kk <= khi) {
                    const bf16x8 sf = *(const LAS bf16x8*)(lds + L_SS + trow * 272 + (kk * 32 + g * 8) * 2);
#pragma unroll
                    for (int vb = 0; vb < 9; ++vb) { const bf16x8 vf = *(const LAS bf16x8*)(lds + L_VTS + (16 * vb + l15) * 272 + (kk * 32 + g * 8) * 2);
                        num[vb] = __builtin_amdgcn_mfma_f32_16x16x32_bf16(vf, sf, num[vb], 0, 0, 0); }
                }
            }
            const float den = __shfl(num[8][0], l15);
            const float thr = __shfl((tb < 4) ? th0 : th1, (16 * tb + l15) & 63);
            const float inv = 1.f / fmaxf(fabsf(den), thr);
            const int tok = tok0 + (dir ? 127 - trow : trow);
            bf16_t* hp = HD + (size_t)tok * 1024 + head * 128 + 4 * g;
#pragma unroll
            for (int vb = 0; vb < 8; ++vb) { u32x2 p; p.x = cvt_pk_bf16(num[vb][0] * inv, num[vb][1] * inv); p.y = cvt_pk_bf16(num[vb][2] * inv, num[vb][3] * inv); *(u32x2*)(hp + 16 * vb) = p; }
        }
        {
            bf16x8 vf[4];
#pragma unroll
            for (int kk = 0; kk < 4; ++kk) vf[kk] = *(const LAS bf16x8*)(lds + L_VTS + (16 * w + l15) * 272 + (kk * 32 + g * 8) * 2);
#pragma unroll
            for (int db = 0; db < 4; ++db)
#pragma unroll
                for (int kk = 0; kk < 4; ++kk) { const bf16x8 kf = *(const LAS bf16x8*)(lds + L_KTS + (16 * db + l15) * 272 + (kk * 32 + g * 8) * 2);
                    st[db] = __builtin_amdgcn_mfma_f32_16x16x32_bf16(kf, vf[kk], st[db], 0, 0, 0); }
            if (w < 4) {
#pragma unroll
                for (int kk = 0; kk < 4; ++kk) { const bf16x8 kf = *(const LAS bf16x8*)(lds + L_KTS + (16 * w + l15) * 272 + (kk * 32 + g * 8) * 2);
                    const bf16x8 of = *(const LAS bf16x8*)(lds + L_VTS + (128 + l15) * 272 + (kk * 32 + g * 8) * 2);
                    nst = __builtin_amdgcn_mfma_f32_16x16x32_bf16(kf, of, nst, 0, 0, 0); }
            }
        }
        BAR_LDS();
    }
#undef PREFETCH
}

__device__ __forceinline__ void combine_rows4(const bf16_t* h0, const bf16_t* h1, bf16_t* ab, const float* nw, int lane) {
    u32x4 a[4][2], b[4][2], o[4][2];
#pragma unroll
    for (int q = 0; q < 4; ++q)
#pragma unroll
        for (int i = 0; i < 2; ++i) { const int p = lane + 64 * i;
            a[q][i] = *(const u32x4*)(h0 + (size_t)q * 1024 + 8 * p); b[q][i] = *(const u32x4*)(h1 + (size_t)q * 1024 + 8 * p); o[q][i] = *(const u32x4*)(ab + (size_t)q * 2048 + 8 * p); }
#pragma unroll
    for (int i = 0; i < 2; ++i) { const int p = lane + 64 * i;
        const f32x4 n0 = *(const f32x4*)(nw + 8 * p), n1 = *(const f32x4*)(nw + 8 * p + 4);
#pragma unroll
        for (int q = 0; q < 4; ++q) { const u32x4 aa = a[q][i], bb = b[q][i], oo = o[q][i];
            float s[8] = {bf_lo(aa.x) + bf_lo(bb.x), bf_hi(aa.x) + bf_hi(bb.x), bf_lo(aa.y) + bf_lo(bb.y), bf_hi(aa.y) + bf_hi(bb.y), bf_lo(aa.z) + bf_lo(bb.z), bf_hi(aa.z) + bf_hi(bb.z), bf_lo(aa.w) + bf_lo(bb.w), bf_hi(aa.w) + bf_hi(bb.w)};
            float ss = 0.f;
#pragma unroll
            for (int j = 0; j < 8; ++j) ss += s[j] * s[j];
            ss += dppf<0x121>(0.f, ss); ss += dppf<0x122>(0.f, ss); ss += dppf<0x124>(0.f, ss); ss += dppf<0x128>(0.f, ss);
            const float r = rsqrtf(ss * (1.f / 128.f) + EPS);
            const float og[8] = {bf_lo(oo.x), bf_hi(oo.x), bf_lo(oo.y), bf_hi(oo.y), bf_lo(oo.z), bf_hi(oo.z), bf_lo(oo.w), bf_hi(oo.w)};
            u32x4 qv;
            qv.x = cvt_pk_bf16(s[0] * r * n0[0] * og[0], s[1] * r * n0[1] * og[1]); qv.y = cvt_pk_bf16(s[2] * r * n0[2] * og[2], s[3] * r * n0[3] * og[3]);
            qv.z = cvt_pk_bf16(s[4] * r * n1[0] * og[4], s[5] * r * n1[1] * og[5]); qv.w = cvt_pk_bf16(s[6] * r * n1[2] * og[6], s[7] * r * n1[3] * og[7]);
            *(u32x4*)(ab + (size_t)q * 2048 + 8 * p) = qv; } }
}

#define XB_TMO      128
#define XB_XCNT(j)  (256  + 64 * (j))
#define XB_XSUB(j)  (1280 + 64 * (j))
#define XB_XGEN(j)  (2304 + 64 * (j))
#define XB_TOP      3328
#define XB_TOPGEN   3392
#define XCD_BAR_WORDS 3456
#define XB_SPIN_CAP (1u << 18)
__device__ __forceinline__ unsigned xb_ld(unsigned* p)              { return __hip_atomic_load(p, __ATOMIC_RELAXED, __HIP_MEMORY_SCOPE_AGENT); }
__device__ __forceinline__ unsigned xb_add(unsigned* p, unsigned v) { return __hip_atomic_fetch_add(p, v, __ATOMIC_RELAXED, __HIP_MEMORY_SCOPE_AGENT); }
__device__ __forceinline__ unsigned xb_xcc_id() { return (unsigned)__builtin_amdgcn_s_getreg((3 << 11) | 20) & 0xFu; }
#define XB_SPIN(cond, bar) do { unsigned _sp = 0; while (cond) { __builtin_amdgcn_s_sleep(1); \
    if ((++_sp & 255u) == 0u) { if (xb_ld(&(bar)[XB_TMO])) break; if (_sp > XB_SPIN_CAP) { atomicAdd(&(bar)[XB_TMO], 1u); break; } } } } while (0)
struct XcdBarrier { unsigned* bar; unsigned x; volatile LAS unsigned* st; };
__device__ __forceinline__ XcdBarrier xcd_barrier_post(unsigned* bar, volatile LAS unsigned* st) {
    XcdBarrier b; b.bar = bar; b.x = xb_xcc_id(); b.st = st;
    if (threadIdx.x == 0) (void)xb_add(&bar[XB_XCNT(b.x)], 1u);
    return b;
}
__device__ __forceinline__ void xcd_barrier_complete(unsigned* bar, unsigned x, unsigned& nloc, unsigned& nx) {
    const unsigned G = gridDim.x * gridDim.y * gridDim.z;
    unsigned sum, cnt, mine, sp = 0u;
    for (;;) {
        sum = 0u; cnt = 0u; mine = 0u;
#pragma unroll
        for (unsigned j = 0; j < 16; ++j) { const unsigned c = xb_ld(&bar[XB_XCNT(j)]); sum += c; cnt += (c > 0u) ? 1u : 0u; mine = (j == x) ? c : mine; }
        if (sum == G) break;
        __builtin_amdgcn_s_sleep(1);
        if ((++sp & 255u) == 0u) { if (xb_ld(&bar[XB_TMO])) break; if (sp > XB_SPIN_CAP) { atomicAdd(&bar[XB_TMO], 1u); break; } }
    }
    nloc = mine > 0u ? mine : 1u; nx = cnt > 0u ? cnt : 1u;
}
__device__ __forceinline__ void xcd_barrier(const XcdBarrier& b) {
    asm volatile("s_waitcnt vmcnt(0)" ::: "memory");
    __syncthreads();
    if (threadIdx.x == 0) {
        unsigned* bar = b.bar;
        __builtin_amdgcn_s_waitcnt(0);
        unsigned nloc = b.st[0], nx = b.st[1];
        if (nloc == 0u) { xcd_barrier_complete(bar, b.x, nloc, nx); b.st[0] = nloc; b.st[1] = nx; }
        const unsigned old = xb_add(&bar[XB_XSUB(b.x)], 1u);
        const unsigned gen = old / nloc;
        if (old + 1u == (gen + 1u) * nloc) {
            __builtin_amdgcn_fence(__ATOMIC_RELEASE, "agent");
            asm volatile("s_waitcnt vmcnt(0)" ::: "memory");
            const unsigned og = xb_add(&bar[XB_TOP], 1u);
            const unsigned tg = og / nx;
            if (og + 1u == (tg + 1u) * nx) xb_add(&bar[XB_TOPGEN], 1u);
            else XB_SPIN(xb_ld(&bar[XB_TOPGEN]) == tg, bar);
            __builtin_amdgcn_fence(__ATOMIC_ACQUIRE, "agent");
            xb_add(&bar[XB_XGEN(b.x)], 1u);
            asm volatile("s_waitcnt vmcnt(0)" ::: "memory");
        } else {
            XB_SPIN(xb_ld(&bar[XB_XGEN(b.x)]) == gen, bar);
            __builtin_amdgcn_fence(__ATOMIC_ACQUIRE, "agent");
            asm volatile("s_waitcnt vmcnt(0)" ::: "memory");
        }
    }
    __syncthreads();
}

constexpr int N_PHASES = 11;
__global__ void __launch_bounds__(512, 2) mk_fwd(Args A) {
    extern __shared__ __attribute__((aligned(16))) unsigned char lds_raw[];
    LAS unsigned char* lds = (LAS unsigned char*)lds_raw;
    cg::grid_group grid = cg::this_grid();
    const int tid = threadIdx.x, lane = tid & 63, wave = __builtin_amdgcn_readfirstlane(tid >> 6);
    const int G = gridDim.x, gw = blockIdx.x * 8 + wave, NGW = G * 8;
    unsigned char* ws = A.ws;
    const float* mod = (const float*)(ws + WS_MOD);
    bf16_t* H = (bf16_t*)(ws + WS_H);
    const int lo = A.ph_lo, hi = A.ph_hi;
#ifndef PHMASK
#define PHMASK 0x7ff
#endif
#ifndef REPMASK
#define REPMASK 0
#endif
#ifndef XSYNC
#define XSYNC 0
#endif
#ifndef TS_LO
#define TS_LO -2
#define TS_HI -2
#endif
#define REP(k) for (int rep_ = 0; rep_ < 1 + ((REPMASK >> (k)) & 1); ++rep_)
#define IN(k) (((PHMASK >> (k)) & 1) && lo <= (k) && (k) < hi)
    unsigned* barw = (unsigned*)(ws + WS_BAR);
    volatile LAS unsigned* bst = (volatile LAS unsigned*)(lds + LDS_BYTES - 16);
    if (tid < 4) bst[tid] = 0u;
    __syncthreads();
    if (hi < 0) grid.sync();
    XcdBarrier xbar = xcd_barrier_post(barw, bst);
    unsigned long long ts_a = 0, ts_b = 0;
    if (TS_LO == -1) ts_a = __builtin_amdgcn_s_memrealtime();
#define SEAM(k) do { if (IN(k) && IN((k) + 1)) xcd_barrier(xbar); if (TS_LO == (k)) ts_a = __builtin_amdgcn_s_memrealtime(); if (TS_HI == (k)) ts_b = __builtin_amdgcn_s_memrealtime(); } while (0)

    if (IN(0)) {
        unsigned* modcnt = (unsigned*)(ws + WS_MODCNT);
        p0_mod(A, lds, tid, lane, wave, modcnt);
        if (TS_LO == 20) ts_a = __builtin_amdgcn_s_memrealtime(); if (TS_HI == 20) ts_b = __builtin_amdgcn_s_memrealtime();
        __syncthreads();
        p0_weights(A, lds, tid, lane, wave);
        if (TS_LO == 21) ts_a = __builtin_amdgcn_s_memrealtime(); if (TS_HI == 21) ts_b = __builtin_amdgcn_s_memrealtime();
        if (tid == 0) { unsigned sp = 0; while (__hip_atomic_load(modcnt, __ATOMIC_RELAXED, __HIP_MEMORY_SCOPE_AGENT) < 6144u / 32u) { __builtin_amdgcn_s_sleep(2); if (++sp > (1u << 22)) break; }
            __builtin_amdgcn_fence(__ATOMIC_ACQUIRE, "agent"); asm volatile("s_waitcnt vmcnt(0)" ::: "memory"); }
        __syncthreads();
        for (int row = 4 * gw; row < MALL; row += 4 * NGW) {
            const bool isx = row < MTOK; const int bb = isx ? (row >> 11) : 16;
            const float* xr = isx ? A.in[I_X] + (size_t)row * DM : A.in[I_CTX] + (size_t)(row - MTOK) * DM;
            modulate_rows4(xr, A.in[I_N1W], mod + bb * 6144, mod + bb * 6144 + 1024, H + (size_t)row * DM, lane);
        }
    }
    if (TS_LO == 0) ts_a = __builtin_amdgcn_s_memrealtime(); if (TS_HI == 0) ts_b = __builtin_amdgcn_s_memrealtime();
    SEAM(1);
    if (IN(2)) REP(2) {
        pg8::Gemm g{H, (const bf16_t*)(ws + WS_WIN), 1024, 1024, 1024, 0}; pg8::InProjOrder S{G, (int)blockIdx.x};
        EpiInProj E{(bf16_t*)(ws + WS_K), (bf16_t*)(ws + WS_VT), (bf16_t*)(ws + WS_Q), (float*)(ws + WS_G), (bf16_t*)(ws + WS_AB), (bf16_t*)A.out, (const float*)(ws + WS_BIASP), A.in[I_CONVW]};
        pg8::gemm_phase<EpiInProj, pg8::InProjOrder>(lds, g, S, E);
    }
    SEAM(2);
    if (IN(3)) REP(3) {
        for (int seq = blockIdx.x; seq < 256; seq += G)
            mlstm_seq(lds, (const bf16_t*)(ws + WS_K), (const bf16_t*)(ws + WS_VT), (const bf16_t*)(ws + WS_Q), (const float*)(ws + WS_G), (bf16_t*)(ws + WS_H), (bf16_t*)(ws + WS_HD1), seq, tid, lane, wave);
    }
    SEAM(3);
    if (IN(4)) {
        for (int row = 4 * gw; row < MTOK; row += 4 * NGW)
            combine_rows4((const bf16_t*)(ws + WS_H) + (size_t)row * 1024, (const bf16_t*)(ws + WS_HD1) + (size_t)row * 1024, (bf16_t*)(ws + WS_AB) + (size_t)row * 2048 + 1024, A.in[I_MNW], lane);
    }
    SEAM(4);
    if (IN(5)) REP(5) {
        pg8::Gemm g{(const bf16_t*)(ws + WS_AB), (const bf16_t*)(ws + WS_BT2), 1024, 2048, 2048, 0}; pg8::SplitKOrder S; S.base.init(MTOK, 1024, G, (int)blockIdx.x);
        EpiG2 E{(const bf16_t*)A.out, (bf16_t*)(ws + WS_H)};
        pg8::gemm_phase<EpiG2, pg8::SplitKOrder>(lds, g, S, E);
    }
    SEAM(5);
    if (IN(6)) REP(6) {
        pg8::Gemm g{(const bf16_t*)(ws + WS_H), (const bf16_t*)(ws + WS_WO), 1024, 1024, 1024, 0}; pg8::StaticOrder S; S.init(MTOK, 1024, G, (int)blockIdx.x);
        EpiResNorm<0> E{A.in[I_X], A.out, mod + 2048, 0, H, A.in[I_N2W], mod, (bf16_t*)(ws + WS_HD1), (float*)(ws + WS_XBUF), (unsigned*)(ws + WS_CNT), lds + 131072};
        pg8::gemm_phase<EpiResNorm<0>, pg8::StaticOrder>(lds, g, S, E);
    }
    SEAM(6);
    if (IN(8)) REP(8) {
        pg8::Gemm g{H, (const bf16_t*)(ws + WS_W1), 1024, 1024, 1024, 0}; pg8::StaticOrder S; S.init(MTOK, DFF, G, (int)blockIdx.x);
        EpiRelu2 E{(bf16_t*)(ws + WS_F1), DFF};
        pg8::gemm_phase<EpiRelu2, pg8::StaticOrder>(lds, g, S, E);
    }
    SEAM(8);
    if (IN(9)) {
        pg8::Gemm g{(const bf16_t*)(ws + WS_F1), (const bf16_t*)(ws + WS_W2), DFF, DFF, F1P, 1}; pg8::StaticOrder S; S.init(MTOK, 1024, G, (int)blockIdx.x);
        EpiResNorm<1> E{A.out, A.out, mod + 5120, 1, nullptr, A.in[I_FNW], mod, (bf16_t*)(ws + WS_HD1), (float*)(ws + WS_XBUF) + (size_t)MTOK * 4, (unsigned*)(ws + WS_CNT) + 128 * 64, lds + 131072};
        pg8::gemm_phase<EpiResNorm<1>, pg8::StaticOrder>(lds, g, S, E);
    }
    if (TS_LO > -2) {
        xcd_barrier(xbar); if (TS_HI == 9) ts_b = __builtin_amdgcn_s_memrealtime();
        if (blockIdx.x == 0) { const int n = (int)((ts_b - ts_a) / 100ull); for (int i = tid; i < n; i += 512) A.out[(size_t)i * 4096 + 3] += 0.25f; }
    }
#undef IN
#undef SEAM
}

#ifndef MK_N_LAUNCHES
#define MK_N_LAUNCHES 1
#endif
extern "C" void kernel_launch(void* const* d_in, const int* in_sizes, int n_in, void* d_out, int out_size, void* d_ws, size_t ws_size, hipStream_t stream) {
    static int grid = 0;
    if (grid == 0) {
        if (n_in != 18 || out_size != MTOK * DM || ws_size < WS_END) { fprintf(stderr, "kernel_launch: unexpected shapes (n_in %d out %d ws %zu)\n", n_in, out_size, ws_size); grid = -1; return; }
        int dev = 0, cus = 0, per_cu = 0;
        hipGetDevice(&dev); hipDeviceGetAttribute(&cus, hipDeviceAttributeMultiprocessorCount, dev);
        hipFuncSetAttribute((const void*)mk_fwd, hipFuncAttributeMaxDynamicSharedMemorySize, LDS_BYTES);
        if (hipOccupancyMaxActiveBlocksPerMultiprocessor(&per_cu, (const void*)mk_fwd, 512, LDS_BYTES) != hipSuccess || per_cu < 1) { fprintf(stderr, "kernel_launch: occupancy query says %d\n", per_cu); per_cu = 1; }
        (void)hipGetLastError();
        grid = cus * per_cu;
        if (grid > 256) grid = 256;
    }
    if (grid < 0) return;
    Args a{};
    for (int i = 0; i < 18; ++i) a.in[i] = (const float*)d_in[i];
    a.out = (float*)d_out; a.ws = (unsigned char*)d_ws;
    (void)hipMemsetAsync((unsigned char*)d_ws + WS_BAR, 0, 256 * 1024, stream);
#if MK_N_LAUNCHES == 1
    a.ph_lo = 0; a.ph_hi = N_PHASES;
    void* args[] = {&a};
    hipError_t e = hipLaunchCooperativeKernel((const void*)mk_fwd, dim3(grid), dim3(512), args, LDS_BYTES, stream);
    if (e != hipSuccess) fprintf(stderr, "cooperative launch failed: %s (grid %d)\n", hipGetErrorString(e), grid);
#else
    for (int p = 0; p < N_PHASES; ++p) { a.ph_lo = p; a.ph_hi = p + 1; hipLaunchKernelGGL(mk_fwd, dim3(grid), dim3(512), LDS_BYTES, stream, a); }
#endif
}
```

```cpp
#include <hip/hip_runtime.h>
#include <hip/hip_cooperative_groups.h>
#include <cstdio>
#include <cstdint>
namespace cg = cooperative_groups;

#define LAS __attribute__((address_space(3)))
typedef unsigned short bf16_t;
typedef short bf16x8 __attribute__((ext_vector_type(8)));
typedef float f32x4 __attribute__((ext_vector_type(4)));
typedef unsigned u32x4 __attribute__((ext_vector_type(4)));
typedef unsigned u32x2 __attribute__((ext_vector_type(2)));

constexpr int DM = 1024, NB = 16, SEQ = 2048, CTXL = 256, NH = 8, DK = 64, DV = 128, DFF = 4096;
constexpr int MTOK = NB * SEQ;
constexpr int MCTX = NB * CTXL;
constexpr int MALL = MTOK + MCTX;
constexpr int DIN = 8224, NIN = 8448;
constexpr float EPS = 1e-6f;
constexpr int OFF_K = 0, OFF_V = 512, OFF_IG = 1536, OFF_Q = 1568, OFF_O = 2080, OFF_XIN = 3104, OFF_GC = 4128, OFF_GB = 5152, OFF_MRG = 6176;

constexpr size_t MiB = 1u << 20;
constexpr size_t WS_MOD = 0;
constexpr size_t WS_BIASP = 512 * 1024;
constexpr size_t WS_BAR = 768 * 1024;
constexpr size_t WS_MODCNT = 900 * 1024;
constexpr size_t WS_CNT = 800 * 1024;
constexpr size_t WS_XBUF = 450 * MiB;
constexpr size_t WS_WIN = 1 * MiB;
constexpr size_t WS_BT2 = 18 * MiB;
constexpr size_t WS_WO = 22 * MiB;
constexpr size_t WS_W1 = 24 * MiB;
constexpr int F1P = DFF + 64;
constexpr size_t WS_W2 = 452 * MiB;
constexpr size_t WS_H = 40 * MiB;
constexpr size_t WS_K = 112 * MiB;
constexpr size_t WS_VT = 148 * MiB;
constexpr size_t WS_Q = 220 * MiB;
constexpr size_t WS_G = 252 * MiB;
constexpr size_t WS_AB = 258 * MiB;
constexpr size_t WS_HD1 = 386 * MiB;
constexpr size_t WS_F1 = 112 * MiB;
constexpr size_t WS_END = 462 * MiB;

constexpr int LDS_BYTES = 155648;

typedef float f32x2_t __attribute__((ext_vector_type(2))); typedef __bf16 bf16x2_t __attribute__((ext_vector_type(2)));
__device__ __forceinline__ unsigned cvt_pk_bf16(float lo, float hi) { const f32x2_t v = {lo, hi}; const bf16x2_t b = __builtin_convertvector(v, bf16x2_t); return __builtin_bit_cast(unsigned, b); }
__device__ __forceinline__ float bf_lo(unsigned w) { return __uint_as_float(w << 16); }
__device__ __forceinline__ float bf_hi(unsigned w) { return __uint_as_float(w & 0xffff0000u); }
__device__ __forceinline__ float sigm(float x) { return __builtin_amdgcn_rcpf(1.f + __expf(-x)); }
__device__ __forceinline__ float wave_sum(float v) {
#pragma unroll
    for (int o = 1; o < 64; o <<= 1) v += __shfl_xor(v, o);
    return v;
}
__device__ __forceinline__ float wave_max(float v) {
#pragma unroll
    for (int o = 1; o < 64; o <<= 1) v = fmaxf(v, __shfl_xor(v, o));
    return v;
}
template <int CTRL, int RM = 0xf> __device__ __forceinline__ float dppf(float old, float src) {
    return __int_as_float(__builtin_amdgcn_update_dpp(__float_as_int(old), __float_as_int(src), CTRL, RM, 0xf, false));
}
__device__ __forceinline__ float wave_scan_add(float x) {
    x += dppf<0x111>(0.f, x); x += dppf<0x112>(0.f, x); x += dppf<0x114>(0.f, x); x += dppf<0x118>(0.f, x);
    x += dppf<0x142, 0xA>(0.f, x); x += dppf<0x143, 0xC>(0.f, x); return x;
}
__device__ __forceinline__ float wave_scan_max(float x) {
    const float ninf = -INFINITY;
    x = fmaxf(x, dppf<0x111>(ninf, x)); x = fmaxf(x, dppf<0x112>(ninf, x)); x = fmaxf(x, dppf<0x114>(ninf, x)); x = fmaxf(x, dppf<0x118>(ninf, x));
    x = fmaxf(x, dppf<0x142, 0xA>(ninf, x)); x = fmaxf(x, dppf<0x143, 0xC>(ninf, x)); return x;
}
__device__ __forceinline__ float lane63(float x) { return __int_as_float(__builtin_amdgcn_readlane(__float_as_int(x), 63)); }
__device__ __forceinline__ float logsig(float x) { return fminf(x, 0.f) - __logf(1.f + __expf(-fabsf(x))); }

namespace pg8 {
constexpr int BM = 256, BK = 64, HALF = 128, HTB = HALF * BK * 2, STAGE_BYTES = 8 * HTB, NXCD = 8, WGM = 8;
__host__ __device__ __forceinline__ int lds_byte(int r, int c) { const int st = (r >> 4) * 2 + (c >> 5), rr = r & 15, cc = c & 31, ob = rr * 64 + cc * 2; return st * 1024 + (ob ^ (((ob >> 9) & 1) << 5)); }
__host__ __device__ __forceinline__ void stage_rc(int b, int& R, int& C) { const int st = b / 1024, sb = b % 1024, swz = sb ^ (((sb >> 9) & 1) << 5); R = (st >> 1) * 16 + swz / 64; C = (st & 1) * 32 + (swz % 64) / 2; }
__host__ __device__ __forceinline__ int perm32(int rho) { const int n = rho >> 4, i = rho & 15; return 8 * (i >> 2) + 4 * n + (i & 3); }

struct Unit { int pm, pn, sw, h; };
struct Gemm { const bf16_t* A; const bf16_t* Bt; int K, lda, ldb, atile; };

__device__ __forceinline__ void rect_map(int l, int nM, int nN, int& pm, int& pn) {
    const int nig = WGM * nN, gid = l / nig, fm = gid * WGM, gsz = (nM - fm) < WGM ? (nM - fm) : WGM, rem = l % nig;
    pm = fm + rem % gsz; pn = rem / gsz;
}
struct StaticOrder {
    int nM, nN, nwg, G, c, rev = 0;
    __device__ void init(int M, int N, int G_, int c_) { nM = M / BM; nN = N / BM; nwg = nM * nN; G = G_; c = c_; }
    __device__ bool next(int i, Unit& u) const {
        const long L = (long)i * G + c; if (L >= nwg) return false;
        int wgid = (int)L; { const int q = nwg / NXCD, r = nwg % NXCD, xcd = wgid % NXCD, off = wgid / NXCD; wgid = (xcd < r ? xcd * (q + 1) : r * (q + 1) + (xcd - r) * q) + off; }
        rect_map(wgid, nM, nN, u.pm, u.pn); if (rev) u.pm = nM - 1 - u.pm; u.sw = 0; u.h = 0; return true;
    }
};
struct InProjOrder {
    int G, c;
    static constexpr int N_RC = 128 * 26, N_RB = 144 * 4, N_RA = 144 * 3, NWG = N_RC + N_RB + N_RA;
    __device__ bool next(int i, Unit& u) const {
        const long L = (long)i * G + c; if (L >= NWG) return false;
        int w = (int)L; w = (w % NXCD) * (NWG / NXCD) + w / NXCD;
        int a, b; u.h = 0;
        if (w < N_RC) { rect_map(w, 128, 26, a, b); u.pm = a; u.pn = 7 + b; u.sw = 0; }
        else if (w < N_RC + N_RB) { rect_map(w - N_RC, 144, 4, a, b); u.pm = 3 + b; u.pn = a; u.sw = 1; }
        else { rect_map(w - N_RC - N_RB, 144, 3, a, b); u.pm = a; u.pn = b; u.sw = 0; }
        return true;
    }
};
static_assert(InProjOrder::NWG % NXCD == 0, "in-proj unit count");
struct SplitKOrder {
    StaticOrder base;
    __device__ bool next(int i, Unit& u) const { if (!base.next(i >> 1, u)) return false; u.h = i & 1; return true; }
};

template <class Epi, class Sched>
__device__ __forceinline__ void gemm_phase(LAS unsigned char* lds, const Gemm g, const Sched& S, const Epi& E) {
    const int tid = threadIdx.x, wid = __builtin_amdgcn_readfirstlane(tid >> 6), lane = tid & 63, wr = wid >> 2, wc = wid & 3, fr = lane & 15, fq = lane >> 4;
    const int K = g.K, nt = K / BK;
    unsigned voffA[2], voffB[2];
#pragma unroll
    for (int i = 0; i < 2; ++i) { int R, C; stage_rc(tid * 16 + i * 8192, R, C); const int Rb = (R & ~31) + perm32(R & 31);
        voffA[i] = g.atile ? (unsigned)(R * BK + C) * 2u : (unsigned)(R * g.lda + C) * 2u; voffB[i] = (unsigned)(Rb * g.ldb + C) * 2u; }
    const size_t kstep = (size_t)(BK * 2), kstepA = g.atile ? (size_t)HTB : kstep;
    const size_t hstepA = g.atile ? (size_t)(g.lda / BK) * HTB : (size_t)HALF * g.lda * 2, hstepB = (size_t)HALF * g.ldb * 2;
    const unsigned ldsw = (unsigned)wid * 1024u;
    const int aoff = lds_byte(wr * 64 + fr, fq * 8), boff = lds_byte(wc * 32 + fr, fq * 8);
#define PG8_SA(b, h) (((b) * 2 + (h)) * HTB)
#define PG8_SB(b, h) ((4 + (b) * 2 + (h)) * HTB)
#define PG8_STAGE(bufoff, gbase, voff) do { _Pragma("unroll") for (int _i = 0; _i < 2; ++_i) \
        __builtin_amdgcn_global_load_lds((const unsigned*)((const char*)(gbase) + (voff)[_i]), (LAS unsigned*)(lds + (bufoff) + ldsw + _i * 8192), 16, 0, 0); } while (0)
#define PG8_LDA(dst, b, h) do { _Pragma("unroll") for (int m = 0; m < 4; ++m) _Pragma("unroll") for (int k = 0; k < 2; ++k) dst[m][k] = *(const LAS bf16x8*)(lds + PG8_SA(b, h) + aoff + m * 2048 + k * 1024); } while (0)
#define PG8_LDB(dst, b, h) do { _Pragma("unroll") for (int n = 0; n < 2; ++n) _Pragma("unroll") for (int k = 0; k < 2; ++k) dst[n][k] = *(const LAS bf16x8*)(lds + PG8_SB(b, h) + boff + n * 2048 + k * 1024); } while (0)
#define PG8_MMA(ai, bj, At, Bt) do { __builtin_amdgcn_s_setprio(1); _Pragma("unroll") for (int m = 0; m < 4; ++m) _Pragma("unroll") for (int n = 0; n < 2; ++n) _Pragma("unroll") for (int k = 0; k < 2; ++k) \
        acc[ai][bj][m][n] = __builtin_amdgcn_mfma_f32_16x16x32_bf16(Bt[n][k], At[m][k], acc[ai][bj][m][n], 0, 0, 0); __builtin_amdgcn_s_setprio(0); } while (0)
#define PG8_WAIT_V(n) asm volatile("s_waitcnt vmcnt(" #n ")" ::: "memory")
#define PG8_WAIT_L(n) asm volatile("s_waitcnt lgkmcnt(" #n ")" ::: "memory")
#define PG8_BAR __builtin_amdgcn_s_barrier()
#define PG8_SCHED __builtin_amdgcn_sched_barrier(0)
#define PG8_PA(u) ((const char*)((u).sw ? g.Bt : g.A) + (size_t)(u).pm * 2 * hstepA + (size_t)(u).h * K * 2)
#define PG8_PB(u) ((const char*)((u).sw ? g.A : g.Bt) + (size_t)(u).pn * 2 * hstepB + (size_t)(u).h * K * 2)
    Unit cur, nxt; int ui = 0;
    if (!S.next(0, cur)) return;
    f32x4 acc[2][2][4][2];
#pragma unroll
    for (int a = 0; a < 2; ++a)
#pragma unroll
        for (int b = 0; b < 2; ++b)
#pragma unroll
            for (int m = 0; m < 4; ++m)
#pragma unroll
                for (int n = 0; n < 2; ++n) acc[a][b][m][n] = (f32x4){0.f, 0.f, 0.f, 0.f};
    bf16x8 At[4][2], B0[2][2], B1[2][2];
    const char* cA = PG8_PA(cur); const char* cB = PG8_PB(cur);
    PG8_STAGE(PG8_SB(0, 0), cB, voffB); PG8_STAGE(PG8_SB(0, 1), cB + hstepB, voffB); PG8_STAGE(PG8_SA(0, 0), cA, voffA); PG8_STAGE(PG8_SA(0, 1), cA + hstepA, voffA);
    if (wr == 1) PG8_BAR;
    PG8_WAIT_V(2); PG8_BAR;
    PG8_STAGE(PG8_SB(1, 0), cB + kstep, voffB); PG8_STAGE(PG8_SA(1, 0), cA + kstepA, voffA); PG8_STAGE(PG8_SB(1, 1), cB + hstepB + kstep, voffB);
    PG8_WAIT_V(6); PG8_BAR;
    for (;;) {
        const bool has_next = S.next(ui + 1, nxt);
        const char* nA = has_next ? PG8_PA(nxt) : cA; const char* nB = has_next ? PG8_PB(nxt) : cB;
        for (int t = 0; t < nt; t += 2) {
            const bool last = (t == nt - 2);
            const char* a1 = cA + (size_t)(t + 1) * kstepA;
            const char* a2 = last ? nA : cA + (size_t)(t + 2) * kstepA; const char* b2 = last ? nB : cB + (size_t)(t + 2) * kstep;
            const char* a3 = a2 + kstepA; const char* b3 = b2 + kstep;
            PG8_LDB(B0, 0, 0); PG8_LDB(B1, 0, 1); PG8_SCHED; PG8_LDA(At, 0, 0); PG8_STAGE(PG8_SA(1, 1), a1 + hstepA, voffA);
            PG8_WAIT_V(8); PG8_WAIT_L(0); PG8_BAR; PG8_MMA(0, 0, At, B0); PG8_MMA(0, 1, At, B1); PG8_BAR; PG8_SCHED;
            PG8_LDA(At, 0, 1); PG8_STAGE(PG8_SB(0, 0), b2, voffB); PG8_STAGE(PG8_SB(0, 1), b2 + hstepB, voffB); PG8_STAGE(PG8_SA(0, 0), a2, voffA);
            PG8_WAIT_V(8); PG8_WAIT_L(0); PG8_BAR; PG8_MMA(1, 0, At, B0); PG8_MMA(1, 1, At, B1); PG8_BAR; PG8_SCHED;
            PG8_LDB(B0, 1, 0); PG8_LDB(B1, 1, 1); PG8_SCHED; PG8_LDA(At, 1, 0); PG8_STAGE(PG8_SA(0, 1), a2 + hstepA, voffA);
            PG8_WAIT_V(8); PG8_WAIT_L(0); PG8_BAR; PG8_MMA(0, 0, At, B0); PG8_MMA(0, 1, At, B1); PG8_BAR; PG8_SCHED;
            PG8_LDA(At, 1, 1); PG8_STAGE(PG8_SB(1, 0), b3, voffB); PG8_STAGE(PG8_SB(1, 1), b3 + hstepB, voffB); PG8_STAGE(PG8_SA(1, 0), a3, voffA);
            PG8_WAIT_V(8); PG8_WAIT_L(0); PG8_BAR; PG8_MMA(1, 0, At, B0); PG8_MMA(1, 1, At, B1); PG8_BAR; PG8_SCHED;
        }
        if (wr == 0) PG8_BAR;
        bool keep = false;
        if constexpr (Epi::HAS_MID) keep = (cur.h == 0);
        if constexpr (Epi::HAS_MID) { if (keep) E.mid(acc, cur, wr, wc, fr, fq); else E(acc, cur, wr, wc, fr, fq); }
        else E(acc, cur, wr, wc, fr, fq);
        if (!has_next) break;
        if (!keep)
#pragma unroll
        for (int a = 0; a < 2; ++a)
#pragma unroll
            for (int b = 0; b < 2; ++b)
#pragma unroll
                for (int m = 0; m < 4; ++m)
#pragma unroll
                    for (int n = 0; n < 2; ++n) acc[a][b][m][n] = (f32x4){0.f, 0.f, 0.f, 0.f};
        cur = nxt; cA = nA; cB = nB; ++ui;
        if (wr == 1) PG8_BAR;
    }
    PG8_WAIT_V(0);
    PG8_BAR;
#undef PG8_SA
#undef PG8_SB
#undef PG8_STAGE
#undef PG8_LDA
#undef PG8_LDB
#undef PG8_MMA
#undef PG8_WAIT_V
#undef PG8_WAIT_L
#undef PG8_BAR
#undef PG8_SCHED
#undef PG8_PA
#undef PG8_PB
}
}
using pg8::Unit;

typedef f32x4 Acc[2][2][4][2];

__device__ __forceinline__ u32x4 pack8(const f32x4 v0, const f32x4 v1) {
    u32x4 w; w.x = cvt_pk_bf16(v0[0], v0[1]); w.y = cvt_pk_bf16(v0[2], v0[3]); w.z = cvt_pk_bf16(v1[0], v1[1]); w.w = cvt_pk_bf16(v1[2], v1[3]); return w;
}

struct EpiInProj {
    static constexpr bool HAS_MID = false;
    bf16_t* Kb; bf16_t* VTb; bf16_t* Qb; float* Gb; bf16_t* AB; bf16_t* MG; const float* biasp; const float* convw;
    __device__ __forceinline__ void operator()(Acc& acc, const Unit& u, int wr, int wc, int fr, int fq) const {
        if (u.sw) {
            const int r0 = u.pm * 256 + wr * 64 + fr, t0 = u.pn * 256 + wc * 32 + 8 * fq;
#pragma unroll
            for (int ai = 0; ai < 2; ++ai)
#pragma unroll
                for (int m = 0; m < 4; ++m) { const int wrow = r0 + ai * 128 + m * 16; const float bs = biasp[wrow]; bf16_t* rowp = VTb + (size_t)(wrow - 768) * MALL + t0;
#pragma unroll
                    for (int bj = 0; bj < 2; ++bj) *(u32x4*)(rowp + bj * 128) = pack8(acc[ai][bj][m][0] + bs, acc[ai][bj][m][1] + bs); }
            return;
        }
        const int row0 = u.pm * 256 + wr * 64 + fr, pn = u.pn;
        const int cb = pn * 256 + wc * 32 + 8 * fq;
        if (pn == 2) {
            if (wc == 0) {
                const f32x4 b0 = *(const f32x4*)(biasp + cb), b1 = *(const f32x4*)(biasp + cb + 4);
#pragma unroll
                for (int ai = 0; ai < 2; ++ai)
#pragma unroll
                    for (int m = 0; m < 4; ++m) { float* gp = Gb + (size_t)(8 * fq) * MALL + (row0 + ai * 128 + m * 16);
                        f32x4 g0 = acc[ai][0][m][0] + b0, g1 = acc[ai][0][m][1] + b1;
                        if (fq >= 2) {
#pragma unroll
                            for (int j = 0; j < 4; ++j) { g0[j] = logsig(g0[j]); g1[j] = logsig(g1[j]); } }
#pragma unroll
                        for (int j = 0; j < 4; ++j) { gp[(size_t)j * MALL] = g0[j]; gp[(size_t)(4 + j) * MALL] = g1[j]; } }
            }
            return;
        }
        if (pn >= 9 && pn < 25) {
            const int ch = 64 * (pn - 9) + 16 * wc + 4 * fq;
            const f32x4 bX = *(const f32x4*)(biasp + cb), bC = *(const f32x4*)(biasp + cb + 4), bB = *(const f32x4*)(biasp + cb + 128), bO = *(const f32x4*)(biasp + cb + 132);
            const f32x4 w0 = *(const f32x4*)(convw + ch), w1 = *(const f32x4*)(convw + 1024 + ch), w2 = *(const f32x4*)(convw + 2048 + ch);
#pragma unroll
            for (int ai = 0; ai < 2; ++ai) {
                f32x4 uu[4];
#pragma unroll
                for (int m = 0; m < 4; ++m) uu[m] = (acc[ai][0][m][0] + bX) * (acc[ai][0][m][1] + bC);
#pragma unroll
                for (int m = 0; m < 4; ++m) {
                    f32x4 pv, nx;
#pragma unroll
                    for (int j = 0; j < 4; ++j) {
                        const float pold = (m > 0) ? dppf<0x121>(0.f, uu[m > 0 ? m - 1 : 0][j]) : 0.f;
                        pv[j] = dppf<0x111>(pold, uu[m][j]);
                        const float nold = (m < 3) ? dppf<0x12F>(0.f, uu[m < 3 ? m + 1 : 3][j]) : 0.f;
                        nx[j] = dppf<0x101>(nold, uu[m][j]);
                    }
                    const f32x4 cv = w0 * pv + w1 * uu[m] + w2 * nx;
                    const f32x4 aa = (acc[ai][1][m][0] + bB) * cv;
                    f32x4 os = acc[ai][1][m][1] + bO;
#pragma unroll
                    for (int j = 0; j < 4; ++j) os[j] = sigm(os[j]);
                    bf16_t* rp = AB + (size_t)(row0 + ai * 128 + m * 16) * 2048 + ch;
                    u32x2 wa, wo; wa.x = cvt_pk_bf16(aa[0], aa[1]); wa.y = cvt_pk_bf16(aa[2], aa[3]); wo.x = cvt_pk_bf16(os[0], os[1]); wo.y = cvt_pk_bf16(os[2], os[3]);
                    *(u32x2*)rp = wa; *(u32x2*)(rp + 1024) = wo;
                }
            }
            return;
        }
        if (pn >= 25) {
            const int ch = 128 * (pn - 25) + 32 * wc + 8 * fq;
            f32x4 ba[2], bb[2];
#pragma unroll
            for (int n = 0; n < 2; ++n) { ba[n] = *(const f32x4*)(biasp + cb + 4 * n); bb[n] = *(const f32x4*)(biasp + cb + 128 + 4 * n); }
#pragma unroll
            for (int ai = 0; ai < 2; ++ai)
#pragma unroll
                for (int m = 0; m < 4; ++m) { bf16_t* rp = MG + (size_t)(row0 + ai * 128 + m * 16) * 2048 + ch;
                    f32x4 rr[2], gg[2];
#pragma unroll
                    for (int n = 0; n < 2; ++n) { const f32x4 xa = acc[ai][0][m][n] + ba[n], xb = acc[ai][1][m][n] + bb[n];
#pragma unroll
                        for (int j = 0; j < 4; ++j) { const float ea = 1.f + __expf(-xa[j]), eb = 1.f + __expf(-xb[j]); rr[n][j] = eb * __builtin_amdgcn_rcpf(ea); gg[n][j] = __builtin_amdgcn_rcpf(eb); } }
                    *(u32x4*)rp = pack8(rr[0], rr[1]); *(u32x4*)(rp + 1024) = pack8(gg[0], gg[1]); }
            return;
        }
        bf16_t* base; int ldc, col0, mode;
        if (pn < 2) { base = Kb; ldc = 512; col0 = pn * 256; mode = 0; }
        else { base = Qb; ldc = 512; col0 = (pn - 7) * 256; mode = 1; }
        col0 += wc * 32 + 8 * fq;
        f32x4 bv[2][2];
#pragma unroll
        for (int bj = 0; bj < 2; ++bj)
#pragma unroll
            for (int n = 0; n < 2; ++n) bv[bj][n] = *(const f32x4*)(biasp + cb + bj * 128 + 4 * n);
#pragma unroll
        for (int ai = 0; ai < 2; ++ai)
#pragma unroll
            for (int m = 0; m < 4; ++m) { bf16_t* rowp = base + (size_t)(row0 + ai * 128 + m * 16) * ldc + col0;
#pragma unroll
                for (int bj = 0; bj < 2; ++bj) { f32x4 v0 = acc[ai][bj][m][0] + bv[bj][0], v1 = acc[ai][bj][m][1] + bv[bj][1];
                    if (mode == 0) { v0 = v0 * 0.125f; v1 = v1 * 0.125f; }
                    *(u32x4*)(rowp + bj * 128) = pack8(v0, v1); } }
    }
};

struct EpiG2 {
    static constexpr bool HAS_MID = true;
    const bf16_t* MG; bf16_t* MRG;
    __device__ __forceinline__ void mid(Acc& acc, const Unit& u, int wr, int wc, int fr, int fq) const {
        const int row0 = u.pm * 256 + wr * 64 + fr, col0 = u.pn * 256 + wc * 32 + 8 * fq;
#pragma unroll
        for (int ai = 0; ai < 2; ++ai) {
            u32x4 rr[4][2];
#pragma unroll
            for (int m = 0; m < 4; ++m)
#pragma unroll
                for (int bj = 0; bj < 2; ++bj) rr[m][bj] = *(const u32x4*)(MG + (size_t)(row0 + ai * 128 + m * 16) * 2048 + col0 + bj * 128);
#pragma unroll
            for (int m = 0; m < 4; ++m)
#pragma unroll
                for (int bj = 0; bj < 2; ++bj) { const u32x4 q = rr[m][bj];
                    const f32x4 r0 = {bf_lo(q.x), bf_hi(q.x), bf_lo(q.y), bf_hi(q.y)}, r1 = {bf_lo(q.z), bf_hi(q.z), bf_lo(q.w), bf_hi(q.w)};
                    acc[ai][bj][m][0] = acc[ai][bj][m][0] * r0; acc[ai][bj][m][1] = acc[ai][bj][m][1] * r1; }
            asm volatile("" ::: "memory");
        }
    }
    __device__ __forceinline__ void operator()(Acc& acc, const Unit& u, int wr, int wc, int fr, int fq) const {
        const int row0 = u.pm * 256 + wr * 64 + fr, col0 = u.pn * 256 + wc * 32 + 8 * fq;
#pragma unroll
        for (int ai = 0; ai < 2; ++ai) {
            u32x4 gg[4][2];
#pragma unroll
            for (int m = 0; m < 4; ++m)
#pragma unroll
                for (int bj = 0; bj < 2; ++bj) gg[m][bj] = *(const u32x4*)(MG + (size_t)(row0 + ai * 128 + m * 16) * 2048 + col0 + bj * 128 + 1024);
#pragma unroll
            for (int m = 0; m < 4; ++m)
#pragma unroll
                for (int bj = 0; bj < 2; ++bj) { const u32x4 gb = gg[m][bj];
                    const f32x4 g0 = {bf_lo(gb.x), bf_hi(gb.x), bf_lo(gb.y), bf_hi(gb.y)}, g1 = {bf_lo(gb.z), bf_hi(gb.z), bf_lo(gb.w), bf_hi(gb.w)};
                    *(u32x4*)(MRG + (size_t)(row0 + ai * 128 + m * 16) * 1024 + col0 + bj * 128) = pack8(acc[ai][bj][m][0] * g0, acc[ai][bj][m][1] * g1); }
            asm volatile("" ::: "memory");
        }
    }
};
struct EpiRes {
    static constexpr bool HAS_MID = false;
    const float* base; float* out; const float* gate;
    __device__ __forceinline__ void operator()(Acc& acc, const Unit& u, int wr, int wc, int fr, int fq) const {
        const int row0 = u.pm * 256 + wr * 64 + fr, col0 = u.pn * 256 + wc * 32 + 8 * fq;
        const float* gp = gate + (size_t)((u.pm * 256) >> 11) * 6144 + col0;
        f32x4 gv[2][2];
#pragma unroll
        for (int bj = 0; bj < 2; ++bj)
#pragma unroll
            for (int n = 0; n < 2; ++n) gv[bj][n] = *(const f32x4*)(gp + bj * 128 + 4 * n);
#pragma unroll
        for (int ai = 0; ai < 2; ++ai)
#pragma unroll
            for (int m = 0; m < 4; ++m) { const size_t off = (size_t)(row0 + ai * 128 + m * 16) * 1024 + col0;
#pragma unroll
                for (int bj = 0; bj < 2; ++bj)
#pragma unroll
                    for (int n = 0; n < 2; ++n) { const f32x4 bs = *(const f32x4*)(base + off + bj * 128 + 4 * n);
                        *(f32x4*)(out + off + bj * 128 + 4 * n) = bs + gv[bj][n] * acc[ai][bj][m][n]; } }
    }
};
template <int mode> struct EpiResNorm {
    static constexpr bool HAS_MID = false;
    const float* base; float* out; const float* gate; int mode_unused;
    bf16_t* h2; const float* nw; const float* mod;
    bf16_t* x1b;
    float* xbuf; unsigned* cnt; LAS unsigned char* xl;
    __device__ __forceinline__ void operator()(Acc& acc, const Unit& u, int wr, int wc, int fr, int fq) const {
        const int wid = wr * 4 + wc, lane = fq * 16 + fr;
        const int row0 = u.pm * 256 + wr * 64 + fr, col0 = u.pn * 256 + wc * 32 + 8 * fq, bb = (u.pm * 256) >> 11;
        {
            const float* gp = gate + (size_t)bb * 6144 + col0;
            f32x4 gv[2][2];
#pragma unroll
            for (int bj = 0; bj < 2; ++bj)
#pragma unroll
                for (int n = 0; n < 2; ++n) gv[bj][n] = *(const f32x4*)(gp + bj * 128 + 4 * n);
#pragma unroll
            for (int ai = 0; ai < 2; ++ai)
#pragma unroll
                for (int m = 0; m < 4; ++m) { const size_t off = (size_t)(row0 + ai * 128 + m * 16) * 1024 + col0;
#pragma unroll
                    for (int bj = 0; bj < 2; ++bj) {
                        if (mode == 1) { const u32x4 q = *(const u32x4*)(x1b + off + bj * 128);
                            const f32x4 b0 = {bf_lo(q.x), bf_hi(q.x), bf_lo(q.y), bf_hi(q.y)}, b1 = {bf_lo(q.z), bf_hi(q.z), bf_lo(q.w), bf_hi(q.w)};
                            acc[ai][bj][m][0] = b0 + gv[bj][0] * acc[ai][bj][m][0]; acc[ai][bj][m][1] = b1 + gv[bj][1] * acc[ai][bj][m][1]; }
                        else {
#pragma unroll
                            for (int n = 0; n < 2; ++n) { const f32x4 bs = *(const f32x4*)(base + off + bj * 128 + 4 * n); acc[ai][bj][m][n] = bs + gv[bj][n] * acc[ai][bj][m][n]; } }
                    }
                    asm volatile("" : "+v"(acc[ai][0][m][0]), "+v"(acc[ai][0][m][1]), "+v"(acc[ai][1][m][0]), "+v"(acc[ai][1][m][1]));
                    if (m & 1) asm volatile("" ::: "memory"); }
        }
        LAS float* P = (LAS float*)xl; LAS float* S = (LAS float*)(xl + 4096);
#pragma unroll
        for (int ai = 0; ai < 2; ++ai)
#pragma unroll
            for (int m = 0; m < 4; ++m) { float q = 0.f;
#pragma unroll
                for (int bj = 0; bj < 2; ++bj)
#pragma unroll
                    for (int n = 0; n < 2; ++n) { const f32x4 x = acc[ai][bj][m][n]; q += (x[0] * x[0] + x[1] * x[1]) + (x[2] * x[2] + x[3] * x[3]); }
                q += __shfl_xor(q, 16); q += __shfl_xor(q, 32);
                if (fq == 0) P[(ai * 128 + wr * 64 + m * 16 + fr) * 4 + wc] = q; }
        asm volatile("s_waitcnt lgkmcnt(0)\n\ts_barrier" ::: "memory");
        const int row = wid * 32 + (lane & 31);
        if (lane < 32) { const float tot = (P[row * 4 + 0] + P[row * 4 + 1]) + (P[row * 4 + 2] + P[row * 4 + 3]);
            __hip_atomic_store(xbuf + (size_t)(u.pm * 256 + row) * 4 + u.pn, tot, __ATOMIC_RELAXED, __HIP_MEMORY_SCOPE_AGENT); }
        asm volatile("s_waitcnt vmcnt(0)" ::: "memory");
        if (lane == 0) __hip_atomic_fetch_add(cnt + 64 * u.pm, 1u, __ATOMIC_RELAXED, __HIP_MEMORY_SCOPE_AGENT);
        if (wid == 0) {
            unsigned sp = 0;
            while ((unsigned)__builtin_amdgcn_readfirstlane(__hip_atomic_load(cnt + 64 * u.pm, __ATOMIC_RELAXED, __HIP_MEMORY_SCOPE_AGENT)) < 32u) { __builtin_amdgcn_s_sleep(2); if (++sp > (1u << 20)) break; }
            __builtin_amdgcn_fence(__ATOMIC_ACQUIRE, "agent");
        }
        asm volatile("s_waitcnt vmcnt(0) lgkmcnt(0)\n\ts_barrier" ::: "memory");
        if (lane < 32) { const float* sl = xbuf + (size_t)(u.pm * 256 + row) * 4; float t = 0.f;
#pragma unroll
            for (int k = 0; k < 4; ++k) t += __hip_atomic_load(sl + k, __ATOMIC_RELAXED, __HIP_MEMORY_SCOPE_AGENT);
            S[row] = rsqrtf(t * (1.f / 1024.f) + EPS); }
        asm volatile("s_waitcnt vmcnt(0) lgkmcnt(0)\n\ts_barrier" ::: "memory");
#pragma unroll
        for (int bj = 0; bj < 2; ++bj) {
            const int c = col0 + bj * 128;
            f32x4 w0 = *(const f32x4*)(nw + c), w1 = *(const f32x4*)(nw + c + 4), h0 = (f32x4){0.f, 0.f, 0.f, 0.f}, h1 = h0;
            if (mode == 0) { const float* mb = mod + (size_t)bb * 6144 + c; w0 = w0 * (*(const f32x4*)(mb + 4096) + 1.f); w1 = w1 * (*(const f32x4*)(mb + 4100) + 1.f); h0 = *(const f32x4*)(mb + 3072); h1 = *(const f32x4*)(mb + 3076); }
#pragma unroll
            for (int ai = 0; ai < 2; ++ai)
#pragma unroll
                for (int m = 0; m < 4; ++m) { asm volatile("" ::: "memory"); const int rl = ai * 128 + wr * 64 + m * 16 + fr; const float r = S[rl]; const size_t off = (size_t)(u.pm * 256 + rl) * 1024 + c;
                    const f32x4 v0 = acc[ai][bj][m][0], v1 = acc[ai][bj][m][1];
                    if (mode == 0) { *(u32x4*)(x1b + off) = pack8(v0, v1); *(u32x4*)(h2 + off) = pack8((v0 * r) * w0 + h0, (v1 * r) * w1 + h1); }
                    else { *(f32x4*)(out + off) = (v0 * r) * w0; *(f32x4*)(out + off + 4) = (v1 * r) * w1; } }
        }
    }
};
struct EpiRelu2 {
    static constexpr bool HAS_MID = false;
    bf16_t* O; int ldc;
    __device__ __forceinline__ void operator()(Acc& acc, const Unit& u, int wr, int wc, int fr, int fq) const {
        const int row0 = u.pm * 256 + wr * 64 + fr, col0 = u.pn * 256 + wc * 32 + 8 * fq;
#pragma unroll
        for (int ai = 0; ai < 2; ++ai)
#pragma unroll
            for (int m = 0; m < 4; ++m) { const int row = row0 + ai * 128 + m * 16;
#pragma unroll
                for (int bj = 0; bj < 2; ++bj) { f32x4 v0 = acc[ai][bj][m][0], v1 = acc[ai][bj][m][1]; const int col = col0 + bj * 128;
                    bf16_t* rowp = O + ((size_t)(row >> 7) * (ldc >> 6) + (col >> 6)) * 8192 + (row & 127) * 64 + (col & 63) - bj * 128;
#pragma unroll
                    for (int j = 0; j < 4; ++j) { const float a = fmaxf(v0[j], 0.f), b = fmaxf(v1[j], 0.f); v0[j] = a * a; v1[j] = b * b; }
                    *(u32x4*)(rowp + bj * 128) = pack8(v0, v1); } }
    }
};

__device__ __forceinline__ int inproj_colmap(int n) {
    if (n < 512) return OFF_K + n;
    if (n < 768) { const int j = n - 512; return j < 32 ? OFF_IG + j : -1; }
    if (n < 1792) return OFF_V + (n - 768);
    if (n < 2304) return OFF_Q + (n - 1792);
    if (n < 6400) { const int lc = (n - 2304) & 255, jt = (n - 2304) >> 8, bj = lc >> 7, wc = (lc >> 5) & 3, fq = (lc >> 3) & 3, nn = (lc >> 2) & 1, jj = lc & 3;
        const int seg = 2 * bj + nn, ch = 64 * jt + 16 * wc + 4 * fq + jj;
        return (seg == 0 ? OFF_XIN : seg == 1 ? OFF_GC : seg == 2 ? OFF_GB : OFF_O) + ch; }
    { const int lc = (n - 6400) & 255, jt = (n - 6400) >> 8; return OFF_MRG + (lc >> 7) * 1024 + 128 * jt + (lc & 127); }
}
struct TrItem { const float* W; bf16_t* out; int ldw, nblk, ldo, kofs, item, map; };
__device__ __forceinline__ void tr_load(const TrItem& t, int lane, f32x4 (&v)[8]) {
    const int kb = t.item / t.nblk, nb = t.item % t.nblk, k0 = 64 * kb, n0 = 32 * nb;
    const int n4 = lane & 7, kr = lane >> 3;
    const int nn = n0 + 4 * n4; const int src = t.map ? inproj_colmap(nn) : nn;
#pragma unroll
    for (int it = 0; it < 8; ++it) v[it] = (src >= 0) ? *(const f32x4*)(t.W + (size_t)(k0 + 8 * it + kr) * t.ldw + src) : (f32x4){0.f, 0.f, 0.f, 0.f};
}
__device__ __forceinline__ void tr_finish(const TrItem& t, int lane, const f32x4 (&v)[8], LAS float* scr) {
    const int kb = t.item / t.nblk, nb = t.item % t.nblk, k0 = 64 * kb, n0 = 32 * nb;
    const int n4 = lane & 7, kr = lane >> 3;
#pragma unroll
    for (int it = 0; it < 8; ++it) { LAS float* d = scr + (8 * it + kr) * 33 + 4 * n4; d[0] = v[it][0]; d[1] = v[it][1]; d[2] = v[it][2]; d[3] = v[it][3]; }
    asm volatile("s_waitcnt lgkmcnt(0)" ::: "memory");
    const int c = lane & 7;
#pragma unroll
    for (int j = 0; j < 4; ++j) { const int n = (lane >> 3) + 8 * j; const LAS float* s = scr + (8 * c) * 33 + n;
        u32x4 o; o.x = cvt_pk_bf16(s[0 * 33], s[1 * 33]); o.y = cvt_pk_bf16(s[2 * 33], s[3 * 33]); o.z = cvt_pk_bf16(s[4 * 33], s[5 * 33]); o.w = cvt_pk_bf16(s[6 * 33], s[7 * 33]);
        *(u32x4*)(t.out + (size_t)(n0 + n) * t.ldo + t.kofs + k0 + 8 * c) = o; }
    asm volatile("s_waitcnt lgkmcnt(0)" ::: "memory");
}

struct Args { const float* in[18]; float* out; unsigned char* ws; int ph_lo, ph_hi; };
enum { I_X = 0, I_C, I_CTX, I_CCTX, I_WMOD, I_BMOD, I_N1W, I_WIN, I_BIN, I_CONVW, I_MNW, I_WCO, I_WMO, I_WOUT, I_N2W, I_WFF1, I_WFF2, I_FNW };

__device__ __forceinline__ void p0_mod(const Args& A, LAS unsigned char* lds, int tid, int lane, int wave, unsigned* modcnt) {
    unsigned char* ws = A.ws;
    LAS float* sl = (LAS float*)lds;
    LAS float* red = (LAS float*)(lds + 17 * 4096);
    bool filled = false; unsigned done = 0;
    for (int item = blockIdx.x; item < 6144 / 32; item += gridDim.x) {
        if (!filled) {
            float cv[34];
#pragma unroll
            for (int j = 0; j < 34; ++j) { const int i = tid + 512 * j; cv[j] = i < 16 * 1024 ? A.in[I_C][i] : A.in[I_CCTX][i - 16 * 1024]; }
#pragma unroll
            for (int j = 0; j < 34; ++j) sl[tid + 512 * j] = cv[j] * sigm(cv[j]);
            __syncthreads(); filled = true;
        }
        const int col = lane & 31, kh = lane >> 5, n0 = item * 32, kbase = 128 * wave + 64 * kh;
        float a[17];
#pragma unroll
        for (int r = 0; r < 17; ++r) a[r] = 0.f;
        const float* wp = A.in[I_WMOD] + (size_t)kbase * 6144 + n0 + col;
        float wv[64];
#pragma unroll
        for (int j = 0; j < 64; ++j) wv[j] = wp[(size_t)j * 6144];
#pragma unroll
        for (int i = 0; i < 64; i += 8) {
#pragma unroll
            for (int r = 0; r < 17; ++r) { const f32x4 s4 = *(const LAS f32x4*)(sl + r * 1024 + kbase + i), s5 = *(const LAS f32x4*)(sl + r * 1024 + kbase + i + 4);
                a[r] += (s4[0] * wv[i + 0] + s4[1] * wv[i + 1]) + (s4[2] * wv[i + 2] + s4[3] * wv[i + 3]) + (s5[0] * wv[i + 4] + s5[1] * wv[i + 5]) + (s5[2] * wv[i + 6] + s5[3] * wv[i + 7]); }
        }
#pragma unroll
        for (int r = 0; r < 17; ++r) red[((wave * 2 + kh) * 17 + r) * 32 + col] = a[r];
        __syncthreads();
        for (int o = tid; o < 17 * 32; o += 512) { const int r = o >> 5, cc = o & 31; float s = A.in[I_BMOD][n0 + cc];
#pragma unroll
            for (int p = 0; p < 16; ++p) s += red[(p * 17 + r) * 32 + cc];
            ((float*)(ws + WS_MOD))[r * 6144 + n0 + cc] = s; }
        asm volatile("s_waitcnt vmcnt(0)" ::: "memory");
        __syncthreads();
        ++done;
    }
    if (done && tid == 0) { __builtin_amdgcn_fence(__ATOMIC_RELEASE, "agent"); asm volatile("s_waitcnt vmcnt(0)" ::: "memory"); __hip_atomic_fetch_add(modcnt, done, __ATOMIC_RELAXED, __HIP_MEMORY_SCOPE_AGENT); }
}
__device__ __forceinline__ void p0_weights(const Args& A, LAS unsigned char* lds, int tid, int lane, int wave) {
    unsigned char* ws = A.ws;
    LAS float* scr = (LAS float*)(lds + wave * 16384);
    const int gw = blockIdx.x * 8 + wave, NGW = gridDim.x * 8;
    constexpr int IT_WIN = 16 * (NIN / 32), IT_SQ = 16 * 32, IT_W1 = 16 * 128, IT_W2 = 64 * 32;
    constexpr int NITEMS = IT_WIN + 3 * IT_SQ + IT_W1 + IT_W2;
    auto mk = [&](int it) -> TrItem {
        int r = it;
        if (r < IT_WIN) return TrItem{A.in[I_WIN], (bf16_t*)(ws + WS_WIN), DIN, NIN / 32, 1024, 0, r, 1}; r -= IT_WIN;
        if (r < IT_SQ) return TrItem{A.in[I_WCO], (bf16_t*)(ws + WS_BT2), 1024, 32, 2048, 0, r, 0}; r -= IT_SQ;
        if (r < IT_SQ) return TrItem{A.in[I_WMO], (bf16_t*)(ws + WS_BT2), 1024, 32, 2048, 1024, r, 0}; r -= IT_SQ;
        if (r < IT_SQ) return TrItem{A.in[I_WOUT], (bf16_t*)(ws + WS_WO), 1024, 32, 1024, 0, r, 0}; r -= IT_SQ;
        if (r < IT_W1) return TrItem{A.in[I_WFF1], (bf16_t*)(ws + WS_W1), 4096, 128, 1024, 0, r, 0}; r -= IT_W1;
        return TrItem{A.in[I_WFF2], (bf16_t*)(ws + WS_W2), 1024, 32, F1P, 0, r, 0};
    };
    if (gw < NITEMS) {
        f32x4 va[8], vb[8];
        TrItem cur = mk(gw); tr_load(cur, lane, va);
        for (int it = gw; it < NITEMS; it += 2 * NGW) {
            const bool h1 = it + NGW < NITEMS, h2 = it + 2 * NGW < NITEMS;
            TrItem nx = cur; if (h1) { nx = mk(it + NGW); tr_load(nx, lane, vb); }
            tr_finish(cur, lane, va, scr);
            if (!h1) break;
            if (h2) { cur = mk(it + 2 * NGW); tr_load(cur, lane, va); }
            tr_finish(nx, lane, vb, scr);
        }
    }
    for (int i = blockIdx.x * 512 + tid; i < NIN; i += gridDim.x * 512) { const int s = inproj_colmap(i); ((float*)(ws + WS_BIASP))[i] = s >= 0 ? A.in[I_BIN][s] : 0.f; }
}

__device__ __forceinline__ float wave_allsum(float x) { return lane63(wave_scan_add(x)); }
__device__ __forceinline__ void modulate_rows4(const float* xrow, const float* w, const float* sh, const float* sc, bf16_t* orow, int lane) {
    f32x4 v[4][4]; float r[4];
#pragma unroll
    for (int q = 0; q < 4; ++q)
#pragma unroll
        for (int j = 0; j < 4; ++j) v[q][j] = ((const f32x4*)(xrow + (size_t)q * DM))[lane + 64 * j];
#pragma unroll
    for (int q = 0; q < 4; ++q) { float s = 0.f;
#pragma unroll
        for (int j = 0; j < 4; ++j) s += (v[q][j].x * v[q][j].x + v[q][j].y * v[q][j].y) + (v[q][j].z * v[q][j].z + v[q][j].w * v[q][j].w);
        r[q] = rsqrtf(wave_allsum(s) * (1.f / DM) + EPS); }
#pragma unroll
    for (int j = 0; j < 4; ++j) { const f32x4 ww = ((const f32x4*)w)[lane + 64 * j], hh = ((const f32x4*)sh)[lane + 64 * j], cc = ((const f32x4*)sc)[lane + 64 * j];
        const f32x4 wc = ww * (cc + 1.f);
#pragma unroll
        for (int q = 0; q < 4; ++q) { const f32x4 y = (v[q][j] * r[q]) * wc + hh;
            u32x2 p; p.x = cvt_pk_bf16(y[0], y[1]); p.y = cvt_pk_bf16(y[2], y[3]); ((u32x2*)(orow + (size_t)q * DM))[lane + 64 * j] = p; } }
}

constexpr int L_QS = 0, L_KS = 18432, L_KTS = 36864, L_VTS = 54272, L_SS = 93440, L_CS = 128256, L_GW = 148992;
static_assert(L_GW + 8 * 512 <= LDS_BYTES, "mlstm LDS map");
#define BAR_LDS() asm volatile("s_waitcnt lgkmcnt(0)\n\ts_barrier" ::: "memory")

__device__ __forceinline__ void mlstm_seq(LAS unsigned char* lds, const bf16_t* Kb, const bf16_t* VTb, const bf16_t* Qb, const float* Gb, bf16_t* HD0, bf16_t* HD1, int seq, int tid, int lane, int w) {
    const int dir = seq >> 7, b = (seq >> 3) & 15, head = seq & 7;
    const int g = lane >> 4, l15 = lane & 15;
    bf16_t* HD = dir ? HD1 : HD0;
    for (int i = tid; i < 16 * 136; i += 512) { const int r = i / 136, cidx = i % 136; *(LAS bf16_t*)(lds + L_VTS + (128 + r) * 272 + cidx * 2) = (r == 0) ? (bf16_t)0x3F80 : (bf16_t)0; }
    f32x4 st[4], nst;
#pragma unroll
    for (int i = 0; i < 4; ++i) st[i] = (f32x4){0.f, 0.f, 0.f, 0.f};
    nst = (f32x4){0.f, 0.f, 0.f, 0.f};
    float mstate = 0.f;
    u32x4 pq[2], pk[2], pv[4]; float gi0, gi1, gf0, gf1;
    const int krow = tid & 127, kpc = tid >> 7;
    unsigned offq[2], offk[2], offv[4], offg0, offg1;
#pragma unroll
    for (int i = 0; i < 2; ++i) { const int p = tid + 512 * i, row = p >> 3, pc = p & 7; offq[i] = (unsigned)((dir ? 127 - row : row) * 512 + head * 64 + pc * 8);
        offk[i] = (unsigned)((dir ? 127 - krow : krow) * 512 + head * 64 + (kpc + 4 * i) * 8); }
#pragma unroll
    for (int i = 0; i < 4; ++i) { const int p = tid + 512 * i, v = p >> 4, pc = p & 15; offv[i] = (unsigned)((head * 128 + v) * MALL + pc * 8); }
    offg0 = (unsigned)((dir * 8 + head) * MALL + (dir ? 127 - lane : lane)); offg1 = (unsigned)((dir * 8 + head) * MALL + (dir ? 63 - lane : lane + 64));
#define PREFETCH(cc) do { const int cc_ = (cc); const bool isctx_ = cc_ < 2; const int T_ = isctx_ ? CTXL : SEQ, c_ = isctx_ ? cc_ : cc_ - 2; \
        const int base_ = isctx_ ? MTOK + b * CTXL : b * SEQ; const int tok0_ = base_ + (dir ? T_ - 128 * (c_ + 1) : 128 * c_); \
        const bf16_t* qb_ = Qb + (size_t)tok0_ * 512; const bf16_t* kb_ = Kb + (size_t)tok0_ * 512; const bf16_t* vb_ = VTb + tok0_; const float* gb_ = Gb + tok0_; \
        if (!isctx_) { _Pragma("unroll") for (int i = 0; i < 2; ++i) pq[i] = *(const u32x4*)(qb_ + offq[i]); } \
        _Pragma("unroll") for (int i = 0; i < 2; ++i) pk[i] = *(const u32x4*)(kb_ + offk[i]); \
        _Pragma("unroll") for (int i = 0; i < 4; ++i) pv[i] = *(const u32x4*)(vb_ + offv[i]); \
        gi0 = gb_[offg0]; gf0 = gb_[offg0 + 16 * MALL]; gi1 = gb_[offg1]; gf1 = gb_[offg1 + 16 * MALL]; \
    } while (0)
    PREFETCH(0);
    for (int cc = 0; cc < 18; ++cc) {
        const bool isctx = cc < 2; const int T_ = isctx ? CTXL : SEQ, c_ = isctx ? cc : cc - 2;
        const int tok0 = (isctx ? MTOK + b * CTXL : b * SEQ) + (dir ? T_ - 128 * (c_ + 1) : 128 * c_);
        const float b0 = wave_scan_add(gf0), b1 = wave_scan_add(gf1) + lane63(b0);
        const float a0 = gi0 - b0, a1 = gi1 - b1;
        const float Mc = fmaxf(mstate, lane63(wave_scan_max(fmaxf(a0, a1))));
        const float e0 = __expf(a0 - Mc), e1 = __expf(a1 - Mc), th0 = __expf(-b0 - Mc), th1 = __expf(-b1 - Mc);
        const float decay = __expf(mstate - Mc);
        mstate = lane63(b1) + Mc;
#pragma unroll
        for (int db = 0; db < 4; ++db) { st[db] = st[db] * decay; u32x2 p; p.x = cvt_pk_bf16(st[db][0], st[db][1]); p.y = cvt_pk_bf16(st[db][2], st[db][3]);
            *(LAS u32x2*)(lds + L_CS + (16 * w + l15) * 144 + (16 * db + 4 * g) * 2) = p; }
        if (w < 4) { nst = nst * decay; u32x2 p; p.x = cvt_pk_bf16(nst[0], nst[1]); p.y = cvt_pk_bf16(nst[2], nst[3]);
            *(LAS u32x2*)(lds + L_CS + (128 + l15) * 144 + (16 * w + 4 * g) * 2) = p; }
        if (!isctx) {
#pragma unroll
            for (int i = 0; i < 2; ++i) { const int p = tid + 512 * i, row = p >> 3, pc = p & 7; *(LAS u32x4*)(lds + L_QS + row * 144 + pc * 16) = pq[i]; }
        }
        {
            const float es = (w & 1) ? e1 : e0; const int kidx = dir ? 127 - krow : krow;
#pragma unroll
            for (int i = 0; i < 2; ++i) { const int pc = kpc + 4 * i;
                const unsigned ww[4] = {pk[i].x, pk[i].y, pk[i].z, pk[i].w}; unsigned sc4[4];
#pragma unroll
                for (int q2 = 0; q2 < 4; ++q2) { const unsigned pkd = cvt_pk_bf16(bf_lo(ww[q2]) * es, bf_hi(ww[q2]) * es); sc4[q2] = pkd;
                    *(LAS bf16_t*)(lds + L_KTS + (pc * 8 + 2 * q2) * 272 + kidx * 2) = (bf16_t)(pkd & 0xffffu);
                    *(LAS bf16_t*)(lds + L_KTS + (pc * 8 + 2 * q2 + 1) * 272 + kidx * 2) = (bf16_t)(pkd >> 16); }
                *(LAS u32x4*)(lds + L_KS + krow * 144 + pc * 16) = (u32x4){sc4[0], sc4[1], sc4[2], sc4[3]}; }
#pragma unroll
            for (int i = 0; i < 4; ++i) { const int p = tid + 512 * i, v = p >> 4, pc = p & 15; *(LAS u32x4*)(lds + L_VTS + v * 272 + pc * 16) = pv[i]; }
        }
        BAR_LDS();
        if (cc + 1 < 18) PREFETCH(cc + 1);
        if (!isctx) {
            const int tb = (w < 4) ? 2 * w : 15 - 2 * w;
            const int trow = 16 * tb + l15;
            const int klo = dir ? ((7 - tb) >> 1) : 0, khi = dir ? 3 : (tb >> 1);
            bf16x8 qf[2];
#pragma unroll
            for (int kk = 0; kk < 2; ++kk) qf[kk] = *(const LAS bf16x8*)(lds + L_QS + trow * 144 + (kk * 32 + g * 8) * 2);
#pragma unroll
            for (int sb = 0; sb < 8; ++sb) {
                f32x4 sa = (f32x4){0.f, 0.f, 0.f, 0.f};
                if (sb <= tb) {
#pragma unroll
                    for (int kk = 0; kk < 2; ++kk) { const bf16x8 kf = *(const LAS bf16x8*)(lds + L_KS + (16 * sb + l15) * 144 + (kk * 32 + g * 8) * 2);
                        sa = __builtin_amdgcn_mfma_f32_16x16x32_bf16(kf, qf[kk], sa, 0, 0, 0); }
                    if (sb == tb) { const int s0 = 16 * sb + 4 * g;
#pragma unroll
                        for (int r = 0; r < 4; ++r) sa[r] = (s0 + r <= trow) ? sa[r] : 0.f; }
                }
                const int s0 = 16 * sb + 4 * g;
                u32x2 p;
                if (dir) { p.x = cvt_pk_bf16(sa[3], sa[2]); p.y = cvt_pk_bf16(sa[1], sa[0]); *(LAS u32x2*)(lds + L_SS + trow * 272 + (124 - s0) * 2) = p; }
                else { p.x = cvt_pk_bf16(sa[0], sa[1]); p.y = cvt_pk_bf16(sa[2], sa[3]); *(LAS u32x2*)(lds + L_SS + trow * 272 + s0 * 2) = p; }
            }
            f32x4 num[9];
#pragma unroll
            for (int vb = 0; vb < 9; ++vb) { num[vb] = (f32x4){0.f, 0.f, 0.f, 0.f};
#pragma unroll
                for (int kk = 0; kk < 2; ++kk) { const bf16x8 cf = *(const LAS bf16x8*)(lds + L_CS + (16 * vb + l15) * 144 + (kk * 32 + g * 8) * 2);
                    num[vb] = __builtin_amdgcn_mfma_f32_16x16x32_bf16(cf, qf[kk], num[vb], 0, 0, 0); } }
#pragma unroll
            for (int kk = 0; kk < 4; ++kk) {
                if (kk >= klo && kk <= khi) {
                    const bf16x8 sf = *(const LAS bf16x8*)(lds + L_SS + trow * 272 + (kk * 32 + g * 8) * 2);
#pragma unroll
                    for (int vb = 0; vb < 9; ++vb) { const bf16x8 vf = *(const LAS bf16x8*)(lds + L_VTS + (16 * vb + l15) * 272 + (kk * 32 + g * 8) * 2);
                        num[vb] = __builtin_amdgcn_mfma_f32_16x16x32_bf16(vf, sf, num[vb], 0, 0, 0); }
                }
            }
            const float den = __shfl(num[8][0], l15);
            const float thr = __shfl((tb < 4) ? th0 : th1, (16 * tb + l15) & 63);
            const float inv = 1.f / fmaxf(fabsf(den), thr);
            const int tok = tok0 + (dir ? 127 - trow : trow);
            bf16_t* hp = HD + (size_t)tok * 1024 + head * 128 + 4 * g;
#pragma unroll
            for (int vb = 0; vb < 8; ++vb) { u32x2 p; p.x = cvt_pk_bf16(num[vb][0] * inv, num[vb][1] * inv); p.y = cvt_pk_bf16(num[vb][2] * inv, num[vb][3] * inv); *(u32x2*)(hp + 16 * vb) = p; }
        }
        {
            bf16x8 vf[4];
#pragma unroll
            for (int kk = 0; kk < 4; ++kk) vf[kk] = *(const LAS bf16x8*)(lds + L_VTS + (16 * w + l15) * 272 + (kk * 32 + g * 8) * 2);
#pragma unroll
            for (int db = 0; db < 4; ++db)
#pragma unroll
                for (int kk = 0; kk < 4; ++kk) { const bf16x8 kf = *(const LAS bf16x8*)(lds + L_KTS + (16 * db + l15) * 272 + (kk * 32 + g * 8) * 2);
                    st[db] = __builtin_amdgcn_mfma_f32_16x16x32_bf16(kf, vf[kk], st[db], 0, 0, 0); }
            if (w < 4) {
#pragma unroll
                for (int kk = 0; kk < 4; ++kk) { const bf16x8 kf = *(const LAS bf16x8*)(lds + L_KTS + (16 * w + l15) * 272 + (kk * 32 + g * 8) * 2);
                    const bf16x8 of = *(const LAS bf16x8*)(lds + L_VTS + (128 + l15) * 272 + (kk * 32 + g * 8) * 2);
                    nst = __builtin_amdgcn_mfma_f32_16x16x32_bf16(kf, of, nst, 0, 0, 0); }
            }
        }
        BAR_LDS();
    }
#undef PREFETCH
}

__device__ __forceinline__ void combine_rows4(const bf16_t* h0, const bf16_t* h1, bf16_t* ab, const float* nw, int lane) {
    u32x4 a[4][2], b[4][2], o[4][2];
#pragma unroll
    for (int q = 0; q < 4; ++q)
#pragma unroll
        for (int i = 0; i < 2; ++i) { const int p = lane + 64 * i;
            a[q][i] = *(const u32x4*)(h0 + (size_t)q * 1024 + 8 * p); b[q][i] = *(const u32x4*)(h1 + (size_t)q * 1024 + 8 * p); o[q][i] = *(const u32x4*)(ab + (size_t)q * 2048 + 8 * p); }
#pragma unroll
    for (int i = 0; i < 2; ++i) { const int p = lane + 64 * i;
        const f32x4 n0 = *(const f32x4*)(nw + 8 * p), n1 = *(const f32x4*)(nw + 8 * p + 4);
#pragma unroll
        for (int q = 0; q < 4; ++q) { const u32x4 aa = a[q][i], bb = b[q][i], oo = o[q][i];
            float s[8] = {bf_lo(aa.x) + bf_lo(bb.x), bf_hi(aa.x) + bf_hi(bb.x), bf_lo(aa.y) + bf_lo(bb.y), bf_hi(aa.y) + bf_hi(bb.y), bf_lo(aa.z) + bf_lo(bb.z), bf_hi(aa.z) + bf_hi(bb.z), bf_lo(aa.w) + bf_lo(bb.w), bf_hi(aa.w) + bf_hi(bb.w)};
            float ss = 0.f;
#pragma unroll
            for (int j = 0; j < 8; ++j) ss += s[j] * s[j];
            ss += dppf<0x121>(0.f, ss); ss += dppf<0x122>(0.f, ss); ss += dppf<0x124>(0.f, ss); ss += dppf<0x128>(0.f, ss);
            const float r = rsqrtf(ss * (1.f / 128.f) + EPS);
            const float og[8] = {bf_lo(oo.x), bf_hi(oo.x), bf_lo(oo.y), bf_hi(oo.y), bf_lo(oo.z), bf_hi(oo.z), bf_lo(oo.w), bf_hi(oo.w)};
            u32x4 qv;
            qv.x = cvt_pk_bf16(s[0] * r * n0[0] * og[0], s[1] * r * n0[1] * og[1]); qv.y = cvt_pk_bf16(s[2] * r * n0[2] * og[2], s[3] * r * n0[3] * og[3]);
            qv.z = cvt_pk_bf16(s[4] * r * n1[0] * og[4], s[5] * r * n1[1] * og[5]); qv.w = cvt_pk_bf16(s[6] * r * n1[2] * og[6], s[7] * r * n1[3] * og[7]);
            *(u32x4*)(ab + (size_t)q * 2048 + 8 * p) = qv; } }
}

#define XB_TMO      128
#define XB_XCNT(j)  (256  + 64 * (j))
#define XB_XSUB(j)  (1280 + 64 * (j))
#define XB_XGEN(j)  (2304 + 64 * (j))
#define XB_TOP      3328
#define XB_TOPGEN   3392
#define XCD_BAR_WORDS 3456
#define XB_SPIN_CAP (1u << 18)
__device__ __forceinline__ unsigned xb_ld(unsigned* p)              { return __hip_atomic_load(p, __ATOMIC_RELAXED, __HIP_MEMORY_SCOPE_AGENT); }
__device__ __forceinline__ unsigned xb_add(unsigned* p, unsigned v) { return __hip_atomic_fetch_add(p, v, __ATOMIC_RELAXED, __HIP_MEMORY_SCOPE_AGENT); }
__device__ __forceinline__ unsigned xb_xcc_id() { return (unsigned)__builtin_amdgcn_s_getreg((3 << 11) | 20) & 0xFu; }
#define XB_SPIN(cond, bar) do { unsigned _sp = 0; while (cond) { __builtin_amdgcn_s_sleep(1); \
    if ((++_sp & 255u) == 0u) { if (xb_ld(&(bar)[XB_TMO])) break; if (_sp > XB_SPIN_CAP) { atomicAdd(&(bar)[XB_TMO], 1u); break; } } } } while (0)
struct XcdBarrier { unsigned* bar; unsigned x; volatile LAS unsigned* st; };
__device__ __forceinline__ XcdBarrier xcd_barrier_post(unsigned* bar, volatile LAS unsigned* st) {
    XcdBarrier b; b.bar = bar; b.x = xb_xcc_id(); b.st = st;
    if (threadIdx.x == 0) (void)xb_add(&bar[XB_XCNT(b.x)], 1u);
    return b;
}
__device__ __forceinline__ void xcd_barrier_complete(unsigned* bar, unsigned x, unsigned& nloc, unsigned& nx) {
    const unsigned G = gridDim.x * gridDim.y * gridDim.z;
    unsigned sum, cnt, mine, sp = 0u;
    for (;;) {
        sum = 0u; cnt = 0u; mine = 0u;
#pragma unroll
        for (unsigned j = 0; j < 16; ++j) { const unsigned c = xb_ld(&bar[XB_XCNT(j)]); sum += c; cnt += (c > 0u) ? 1u : 0u; mine = (j == x) ? c : mine; }
        if (sum == G) break;
        __builtin_amdgcn_s_sleep(1);
        if ((++sp & 255u) == 0u) { if (xb_ld(&bar[XB_TMO])) break; if (sp > XB_SPIN_CAP) { atomicAdd(&bar[XB_TMO], 1u); break; } }
    }
    nloc = mine > 0u ? mine : 1u; nx = cnt > 0u ? cnt : 1u;
}
__device__ __forceinline__ void xcd_barrier(const XcdBarrier& b) {
    asm volatile("s_waitcnt vmcnt(0)" ::: "memory");
    __syncthreads();
    if (threadIdx.x == 0) {
        unsigned* bar = b.bar;
        __builtin_amdgcn_s_waitcnt(0);
        unsigned nloc = b.st[0], nx = b.st[1];
        if (nloc == 0u) { xcd_barrier_complete(bar, b.x, nloc, nx); b.st[0] = nloc; b.st[1] = nx; }
        const unsigned old = xb_add(&bar[XB_XSUB(b.x)], 1u);
        const unsigned gen = old / nloc;
        if (old + 1u == (gen + 1u) * nloc) {
            __builtin_amdgcn_fence(__ATOMIC_RELEASE, "agent");
            asm volatile("s_waitcnt vmcnt(0)" ::: "memory");
            const unsigned og = xb_add(&bar[XB_TOP], 1u);
            const unsigned tg = og / nx;
            if (og + 1u == (tg + 1u) * nx) xb_add(&bar[XB_TOPGEN], 1u);
            else XB_SPIN(xb_ld(&bar[XB_TOPGEN]) == tg, bar);
            __builtin_amdgcn_fence(__ATOMIC_ACQUIRE, "agent");
            xb_add(&bar[XB_XGEN(b.x)], 1u);
            asm volatile("s_waitcnt vmcnt(0)" ::: "memory");
        } else {
            XB_SPIN(xb_ld(&bar[XB_XGEN(b.x)]) == gen, bar);
            __builtin_amdgcn_fence(__ATOMIC_ACQUIRE, "agent");
            asm volatile("s_waitcnt vmcnt(0)" ::: "memory");
        }
    }
    __syncthreads();
}

constexpr int N_PHASES = 11;
__global__ void __launch_bounds__(512, 2) mk_fwd(Args A) {
    extern __shared__ __attribute__((aligned(16))) unsigned char lds_raw[];
    LAS unsigned char* lds = (LAS unsigned char*)lds_raw;
    cg::grid_group grid = cg::this_grid();
    const int tid = threadIdx.x, lane = tid & 63, wave = __builtin_amdgcn_readfirstlane(tid >> 6);
    const int G = gridDim.x, gw = blockIdx.x * 8 + wave, NGW = G * 8;
    unsigned char* ws = A.ws;
    const float* mod = (const float*)(ws + WS_MOD);
    bf16_t* H = (bf16_t*)(ws + WS_H);
    const int lo = A.ph_lo, hi = A.ph_hi;
#ifndef PHMASK
#define PHMASK 0x7ff
#endif
#ifndef REPMASK
#define REPMASK 0
#endif
#ifndef XSYNC
#define XSYNC 0
#endif
#ifndef TS_LO
#define TS_LO -2
#define TS_HI -2
#endif
#define REP(k) for (int rep_ = 0; rep_ < 1 + ((REPMASK >> (k)) & 1); ++rep_)
#define IN(k) (((PHMASK >> (k)) & 1) && lo <= (k) && (k) < hi)
    unsigned* barw = (unsigned*)(ws + WS_BAR);
    volatile LAS unsigned* bst = (volatile LAS unsigned*)(lds + LDS_BYTES - 16);
    if (tid < 4) bst[tid] = 0u;
    __syncthreads();
    if (hi < 0) grid.sync();
    XcdBarrier xbar = xcd_barrier_post(barw, bst);
    unsigned long long ts_a = 0, ts_b = 0;
    if (TS_LO == -1) ts_a = __builtin_amdgcn_s_memrealtime();
#define SEAM(k) do { if (IN(k) && IN((k) + 1)) xcd_barrier(xbar); if (TS_LO == (k)) ts_a = __builtin_amdgcn_s_memrealtime(); if (TS_HI == (k)) ts_b = __builtin_amdgcn_s_memrealtime(); } while (0)

    if (IN(0)) {
        unsigned* modcnt = (unsigned*)(ws + WS_MODCNT);
        p0_mod(A, lds, tid, lane, wave, modcnt);
        if (TS_LO == 20) ts_a = __builtin_amdgcn_s_memrealtime(); if (TS_HI == 20) ts_b = __builtin_amdgcn_s_memrealtime();
        __syncthreads();
        p0_weights(A, lds, tid, lane, wave);
        if (TS_LO == 21) ts_a = __builtin_amdgcn_s_memrealtime(); if (TS_HI == 21) ts_b = __builtin_amdgcn_s_memrealtime();
        if (tid == 0) { unsigned sp = 0; while (__hip_atomic_load(modcnt, __ATOMIC_RELAXED, __HIP_MEMORY_SCOPE_AGENT) < 6144u / 32u) { __builtin_amdgcn_s_sleep(2); if (++sp > (1u << 22)) break; }
            __builtin_amdgcn_fence(__ATOMIC_ACQUIRE, "agent"); asm volatile("s_waitcnt vmcnt(0)" ::: "memory"); }
        __syncthreads();
        for (int row = 4 * gw; row < MALL; row += 4 * NGW) {
            const bool isx = row < MTOK; const int bb = isx ? (row >> 11) : 16;
            const float* xr = isx ? A.in[I_X] + (size_t)row * DM : A.in[I_CTX] + (size_t)(row - MTOK) * DM;
            modulate_rows4(xr, A.in[I_N1W], mod + bb * 6144, mod + bb * 6144 + 1024, H + (size_t)row * DM, lane);
        }
    }
    if (TS_LO == 0) ts_a = __builtin_amdgcn_s_memrealtime(); if (TS_HI == 0) ts_b = __builtin_amdgcn_s_memrealtime();
    SEAM(1);
    if (IN(2)) REP(2) {
        pg8::Gemm g{H, (const bf16_t*)(ws + WS_WIN), 1024, 1024, 1024, 0}; pg8::InProjOrder S{G, (int)blockIdx.x};
        EpiInProj E{(bf16_t*)(ws + WS_K), (bf16_t*)(ws + WS_VT), (bf16_t*)(ws + WS_Q), (float*)(ws + WS_G), (bf16_t*)(ws + WS_AB), (bf16_t*)A.out, (const float*)(ws + WS_BIASP), A.in[I_CONVW]};
        pg8::gemm_phase<EpiInProj, pg8::InProjOrder>(lds, g, S, E);
    }
    SEAM(2);
    if (IN(3)) REP(3) {
        for (int seq = blockIdx.x; seq < 256; seq += G)
            mlstm_seq(lds, (const bf16_t*)(ws + WS_K), (const bf16_t*)(ws + WS_VT), (const bf16_t*)(ws + WS_Q), (const float*)(ws + WS_G), (bf16_t*)(ws + WS_H), (bf16_t*)(ws + WS_HD1), seq, tid, lane, wave);
    }
    SEAM(3);
    if (IN(4)) {
        for (int row = 4 * gw; row < MTOK; row += 4 * NGW)
            combine_rows4((const bf16_t*)(ws + WS_H) + (size_t)row * 1024, (const bf16_t*)(ws + WS_HD1) + (size_t)row * 1024, (bf16_t*)(ws + WS_AB) + (size_t)row * 2048 + 1024, A.in[I_MNW], lane);
    }
    SEAM(4);
    if (IN(5)) REP(5) {
        pg8::Gemm g{(const bf16_t*)(ws + WS_AB), (const bf16_t*)(ws + WS_BT2), 1024, 2048, 2048, 0}; pg8::SplitKOrder S; S.base.init(MTOK, 1024, G, (int)blockIdx.x);
        EpiG2 E{(const bf16_t*)A.out, (bf16_t*)(ws + WS_H)};
        pg8::gemm_phase<EpiG2, pg8::SplitKOrder>(lds, g, S, E);
    }
    SEAM(5);
    if (IN(6)) REP(6) {
        pg8::Gemm g{(const bf16_t*)(ws + WS_H), (const bf16_t*)(ws + WS_WO), 1024, 1024, 1024, 0}; pg8::StaticOrder S; S.init(MTOK, 1024, G, (int)blockIdx.x);
        EpiResNorm<0> E{A.in[I_X], A.out, mod + 2048, 0, H, A.in[I_N2W], mod, (bf16_t*)(ws + WS_HD1), (float*)(ws + WS_XBUF), (unsigned*)(ws + WS_CNT), lds + 131072};
        pg8::gemm_phase<EpiResNorm<0>, pg8::StaticOrder>(lds, g, S, E);
    }
    SEAM(6);
    if (IN(8)) REP(8) {
        pg8::Gemm g{H, (const bf16_t*)(ws + WS_W1), 1024, 1024, 1024, 0}; pg8::StaticOrder S; S.init(MTOK, DFF, G, (int)blockIdx.x);
        EpiRelu2 E{(bf16_t*)(ws + WS_F1), DFF};
        pg8::gemm_phase<EpiRelu2, pg8::StaticOrder>(lds, g, S, E);
    }
    SEAM(8);
    if (IN(9)) {
        pg8::Gemm g{(const bf16_t*)(ws + WS_F1), (const bf16_t*)(ws + WS_W2), DFF, DFF, F1P, 1}; pg8::StaticOrder S; S.init(MTOK, 1024, G, (int)blockIdx.x);
        EpiResNorm<1> E{A.out, A.out, mod + 5120, 1, nullptr, A.in[I_FNW], mod, (bf16_t*)(ws + WS_HD1), (float*)(ws + WS_XBUF) + (size_t)MTOK * 4, (unsigned*)(ws + WS_CNT) + 128 * 64, lds + 131072};
        pg8::gemm_phase<EpiResNorm<1>, pg8::StaticOrder>(lds, g, S, E);
    }
    if (TS_LO > -2) {
        xcd_barrier(xbar); if (TS_HI == 9) ts_b = __builtin_amdgcn_s_memrealtime();
        if (blockIdx.x == 0) { const int n = (int)((ts_b - ts_a) / 100ull); for (int i = tid; i < n; i += 512) A.out[(size_t)i * 4096 + 3] += 0.25f; }
    }
#undef IN
#undef SEAM
}

#ifndef MK_N_LAUNCHES
#define MK_N_LAUNCHES 1
#endif
extern "C" void kernel_launch(void* const* d_in, const int* in_sizes, int n_in, void* d_out, int out_size, void* d_ws, size_t ws_size, hipStream_t stream) {
    static int grid = 0;
    if (grid == 0) {
        if (n_in != 18 || out_size != MTOK * DM || ws_size < WS_END) { fprintf(stderr, "kernel_launch: unexpected shapes (n_in %d out %d ws %zu)\n", n_in, out_size, ws_size); grid = -1; return; }
        int dev = 0, cus = 0, per_cu = 0;
        hipGetDevice(&dev); hipDeviceGetAttribute(&cus, hipDeviceAttributeMultiprocessorCount, dev);
        hipFuncSetAttribute((const void*)mk_fwd, hipFuncAttributeMaxDynamicSharedMemorySize, LDS_BYTES);
        if (hipOccupancyMaxActiveBlocksPerMultiprocessor(&per_cu, (const void*)mk_fwd, 512, LDS_BYTES) != hipSuccess || per_cu < 1) { fprintf(stderr, "kernel_launch: occupancy query says %d\n", per_cu); per_cu = 1; }
        (void)hipGetLastError();
        grid = cus * per_cu;
        if (grid > 256) grid = 256;
    }
    if (grid < 0) return;
    Args a{};
    for (int i = 0; i < 18; ++i) a.in[i] = (const float*)d_in[i];
    a.out = (float*)d_out; a.ws = (unsigned char*)d_ws;
    (void)hipMemsetAsync((unsigned char*)d_ws + WS_BAR, 0, 256 * 1024, stream);
#if MK_N_LAUNCHES == 1
    a.ph_lo = 0; a.ph_hi = N_PHASES;
    void* args[] = {&a};
    hipError_t e = hipLaunchCooperativeKernel((const void*)mk_fwd, dim3(grid), dim3(512), args, LDS_BYTES, stream);
    if (e != hipSuccess) fprintf(stderr, "cooperative launch failed: %s (grid %d)\n", hipGetErrorString(e), grid);
#else
    for (int p = 0; p < N_PHASES; ++p) { a.ph_lo = p; a.ph_hi = p + 1; hipLaunchKernelGGL(mk_fwd, dim3(grid), dim3(512), LDS_BYTES, stream, a); }
#endif
}
```

```cpp
#include <hip/hip_runtime.h>
#include <hip/hip_cooperative_groups.h>
#include <cstdio>
#include <cstdint>
namespace cg = cooperative_groups;

#define LAS __attribute__((address_space(3)))
typedef unsigned short bf16_t;
typedef short bf16x8 __attribute__((ext_vector_type(8)));
typedef float f32x4 __attribute__((ext_vector_type(4)));
typedef unsigned u32x4 __attribute__((ext_vector_type(4)));
typedef unsigned u32x2 __attribute__((ext_vector_type(2)));

constexpr int DM = 1024, NB = 16, SEQ = 2048, CTXL = 256, NH = 8, DK = 64, DV = 128, DFF = 4096;
constexpr int MTOK = NB * SEQ;
constexpr int MCTX = NB * CTXL;
constexpr int MALL = MTOK + MCTX;
constexpr int DIN = 8224, NIN = 8448;
constexpr float EPS = 1e-6f;
constexpr int OFF_K = 0, OFF_V = 512, OFF_IG = 1536, OFF_Q = 1568, OFF_O = 2080, OFF_XIN = 3104, OFF_GC = 4128, OFF_GB = 5152, OFF_MRG = 6176;

constexpr size_t MiB = 1u << 20;
constexpr size_t WS_MOD = 0;
constexpr size_t WS_BIASP = 512 * 1024;
constexpr size_t WS_BAR = 768 * 1024;
constexpr size_t WS_MODCNT = 900 * 1024;
constexpr size_t WS_CNT = 800 * 1024;
constexpr size_t WS_XBUF = 450 * MiB;
constexpr size_t WS_WIN = 1 * MiB;
constexpr size_t WS_BT2 = 18 * MiB;
constexpr size_t WS_WO = 22 * MiB;
constexpr size_t WS_W1 = 24 * MiB;
constexpr int F1P = DFF + 64;
constexpr size_t WS_W2 = 452 * MiB;
constexpr size_t WS_H = 40 * MiB;
constexpr size_t WS_K = 112 * MiB;
constexpr size_t WS_VT = 148 * MiB;
constexpr size_t WS_Q = 220 * MiB;
constexpr size_t WS_G = 252 * MiB;
constexpr size_t WS_AB = 258 * MiB;
constexpr size_t WS_HD1 = 386 * MiB;
constexpr size_t WS_F1 = 112 * MiB;
constexpr size_t WS_END = 462 * MiB;

constexpr int LDS_BYTES = 155648;

typedef float f32x2_t __attribute__((ext_vector_type(2))); typedef __bf16 bf16x2_t __attribute__((ext_vector_type(2)));
__device__ __forceinline__ unsigned cvt_pk_bf16(float lo, float hi) { const f32x2_t v = {lo, hi}; const bf16x2_t b = __builtin_convertvector(v, bf16x2_t); return __builtin_bit_cast(unsigned, b); }
__device__ __forceinline__ float bf_lo(unsigned w) { return __uint_as_float(w << 16); }
__device__ __forceinline__ float bf_hi(unsigned w) { return __uint_as_float(w & 0xffff0000u); }
__device__ __forceinline__ float sigm(float x) { return __builtin_amdgcn_rcpf(1.f + __expf(-x)); }
__device__ __forceinline__ float wave_sum(float v) {
#pragma unroll
    for (int o = 1; o < 64; o <<= 1) v += __shfl_xor(v, o);
    return v;
}
__device__ __forceinline__ float wave_max(float v) {
#pragma unroll
    for (int o = 1; o < 64; o <<= 1) v = fmaxf(v, __shfl_xor(v, o));
    return v;
}
template <int CTRL, int RM = 0xf> __device__ __forceinline__ float dppf(float old, float src) {
    return __int_as_float(__builtin_amdgcn_update_dpp(__float_as_int(old), __float_as_int(src), CTRL, RM, 0xf, false));
}
__device__ __forceinline__ float wave_scan_add(float x) {
    x += dppf<0x111>(0.f, x); x += dppf<0x112>(0.f, x); x += dppf<0x114>(0.f, x); x += dppf<0x118>(0.f, x);
    x += dppf<0x142, 0xA>(0.f, x); x += dppf<0x143, 0xC>(0.f, x); return x;
}
__device__ __forceinline__ float wave_scan_max(float x) {
    const float ninf = -INFINITY;
    x = fmaxf(x, dppf<0x111>(ninf, x)); x = fmaxf(x, dppf<0x112>(ninf, x)); x = fmaxf(x, dppf<0x114>(ninf, x)); x = fmaxf(x, dppf<0x118>(ninf, x));
    x = fmaxf(x, dppf<0x142, 0xA>(ninf, x)); x = fmaxf(x, dppf<0x143, 0xC>(ninf, x)); return x;
}
__device__ __forceinline__ float lane63(float x) { return __int_as_float(__builtin_amdgcn_readlane(__float_as_int(x), 63)); }
__device__ __forceinline__ float logsig(float x) { return fminf(x, 0.f) - __logf(1.f + __expf(-fabsf(x))); }

namespace pg8 {
constexpr int BM = 256, BK = 64, HALF = 128, HTB = HALF * BK * 2, STAGE_BYTES = 8 * HTB, NXCD = 8, WGM = 8;
__host__ __device__ __forceinline__ int lds_byte(int r, int c) { const int st = (r >> 4) * 2 + (c >> 5), rr = r & 15, cc = c & 31, ob = rr * 64 + cc * 2; return st * 1024 + (ob ^ (((ob >> 9) & 1) << 5)); }
__host__ __device__ __forceinline__ void stage_rc(int b, int& R, int& C) { const int st = b / 1024, sb = b % 1024, swz = sb ^ (((sb >> 9) & 1) << 5); R = (st >> 1) * 16 + swz / 64; C = (st & 1) * 32 + (swz % 64) / 2; }
__host__ __device__ __forceinline__ int perm32(int rho) { const int n = rho >> 4, i = rho & 15; return 8 * (i >> 2) + 4 * n + (i & 3); }

struct Unit { int pm, pn, sw, h; };
struct Gemm { const bf16_t* A; const bf16_t* Bt; int K, lda, ldb, atile; };

__device__ __forceinline__ void rect_map(int l, int nM, int nN, int& pm, int& pn) {
    const int nig = WGM * nN, gid = l / nig, fm = gid * WGM, gsz = (nM - fm) < WGM ? (nM - fm) : WGM, rem = l % nig;
    pm = fm + rem % gsz; pn = rem / gsz;
}
struct StaticOrder {
    int nM, nN, nwg, G, c, rev = 0;
    __device__ void init(int M, int N, int G_, int c_) { nM = M / BM; nN = N / BM; nwg = nM * nN; G = G_; c = c_; }
    __device__ bool next(int i, Unit& u) const {
        const long L = (long)i * G + c; if (L >= nwg) return false;
        int wgid = (int)L; { const int q = nwg / NXCD, r = nwg % NXCD, xcd = wgid % NXCD, off = wgid / NXCD; wgid = (xcd < r ? xcd * (q + 1) : r * (q + 1) + (xcd - r) * q) + off; }
        rect_map(wgid, nM, nN, u.pm, u.pn); if (rev) u.pm = nM - 1 - u.pm; u.sw = 0; u.h = 0; return true;
    }
};
struct InProjOrder {
    int G, c;
    static constexpr int N_RC = 128 * 26, N_RB = 144 * 4, N_RA = 144 * 3, NWG = N_RC + N_RB + N_RA;
    __device__ bool next(int i, Unit& u) const {
        const long L = (long)i * G + c; if (L >= NWG) return false;
        int w = (int)L; w = (w % NXCD) * (NWG / NXCD) + w / NXCD;
        int a, b; u.h = 0;
        if (w < N_RC) { rect_map(w, 128, 26, a, b); u.pm = a; u.pn = 7 + b; u.sw = 0; }
        else if (w < N_RC + N_RB) { rect_map(w - N_RC, 144, 4, a, b); u.pm = 3 + b; u.pn = a; u.sw = 1; }
        else { rect_map(w - N_RC - N_RB, 144, 3, a, b); u.pm = a; u.pn = b; u.sw = 0; }
        return true;
    }
};
static_assert(InProjOrder::NWG % NXCD == 0, "in-proj unit count");
struct SplitKOrder {
    StaticOrder base;
    __device__ bool next(int i, Unit& u) const { if (!base.next(i >> 1, u)) return false; u.h = i & 1; return true; }
};

template <class Epi, class Sched>
__device__ __forceinline__ void gemm_phase(LAS unsigned char* lds, const Gemm g, const Sched& S, const Epi& E) {
    const int tid = threadIdx.x, wid = __builtin_amdgcn_readfirstlane(tid >> 6), lane = tid & 63, wr = wid >> 2, wc = wid & 3, fr = lane & 15, fq = lane >> 4;
    const int K = g.K, nt = K / BK;
    unsigned voffA[2], voffB[2];
#pragma unroll
    for (int i = 0; i < 2; ++i) { int R, C; stage_rc(tid * 16 + i * 8192, R, C); const int Rb = (R & ~31) + perm32(R & 31);
        voffA[i] = g.atile ? (unsigned)(R * BK + C) * 2u : (unsigned)(R * g.lda + C) * 2u; voffB[i] = (unsigned)(Rb * g.ldb + C) * 2u; }
    const size_t kstep = (size_t)(BK * 2), kstepA = g.atile ? (size_t)HTB : kstep;
    const size_t hstepA = g.atile ? (size_t)(g.lda / BK) * HTB : (size_t)HALF * g.lda * 2, hstepB = (size_t)HALF * g.ldb * 2;
    const unsigned ldsw = (unsigned)wid * 1024u;
    const int aoff = lds_byte(wr * 64 + fr, fq * 8), boff = lds_byte(wc * 32 + fr, fq * 8);
#define PG8_SA(b, h) (((b) * 2 + (h)) * HTB)
#define PG8_SB(b, h) ((4 + (b) * 2 + (h)) * HTB)
#define PG8_STAGE(bufoff, gbase, voff) do { _Pragma("unroll") for (int _i = 0; _i < 2; ++_i) \
        __builtin_amdgcn_global_load_lds((const unsigned*)((const char*)(gbase) + (voff)[_i]), (LAS unsigned*)(lds + (bufoff) + ldsw + _i * 8192), 16, 0, 0); } while (0)
#define PG8_LDA(dst, b, h) do { _Pragma("unroll") for (int m = 0; m < 4; ++m) _Pragma("unroll") for (int k = 0; k < 2; ++k) dst[m][k] = *(const LAS bf16x8*)(lds + PG8_SA(b, h) + aoff + m * 2048 + k * 1024); } while (0)
#define PG8_LDB(dst, b, h) do { _Pragma("unroll") for (int n = 0; n < 2; ++n) _Pragma("unroll") for (int k = 0; k < 2; ++k) dst[n][k] = *(const LAS bf16x8*)(lds + PG8_SB(b, h) + boff + n * 2048 + k * 1024); } while (0)
#define PG8_MMA(ai, bj, At, Bt) do { __builtin_amdgcn_s_setprio(1); _Pragma("unroll") for (int m = 0; m < 4; ++m) _Pragma("unroll") for (int n = 0; n < 2; ++n) _Pragma("unroll") for (int k = 0; k < 2; ++k) \
        acc[ai][bj][m][n] = __builtin_amdgcn_mfma_f32_16x16x32_bf16(Bt[n][k], At[m][k], acc[ai][bj][m][n], 0, 0, 0); __builtin_amdgcn_s_setprio(0); } while (0)
#define PG8_WAIT_V(n) asm volatile("s_waitcnt vmcnt(" #n ")" ::: "memory")
#define PG8_WAIT_L(n) asm volatile("s_waitcnt lgkmcnt(" #n ")" ::: "memory")
#define PG8_BAR __builtin_amdgcn_s_barrier()
#define PG8_SCHED __builtin_amdgcn_sched_barrier(0)
#define PG8_PA(u) ((const char*)((u).sw ? g.Bt : g.A) + (size_t)(u).pm * 2 * hstepA + (size_t)(u).h * K * 2)
#define PG8_PB(u) ((const char*)((u).sw ? g.A : g.Bt) + (size_t)(u).pn * 2 * hstepB + (size_t)(u).h * K * 2)
    Unit cur, nxt; int ui = 0;
    if (!S.next(0, cur)) return;
    f32x4 acc[2][2][4][2];
#pragma unroll
    for (int a = 0; a < 2; ++a)
#pragma unroll
        for (int b = 0; b < 2; ++b)
#pragma unroll
            for (int m = 0; m < 4; ++m)
#pragma unroll
                for (int n = 0; n < 2; ++n) acc[a][b][m][n] = (f32x4){0.f, 0.f, 0.f, 0.f};
    bf16x8 At[4][2], B0[2][2], B1[2][2];
    const char* cA = PG8_PA(cur); const char* cB = PG8_PB(cur);
    PG8_STAGE(PG8_SB(0, 0), cB, voffB); PG8_STAGE(PG8_SB(0, 1), cB + hstepB, voffB); PG8_STAGE(PG8_SA(0, 0), cA, voffA); PG8_STAGE(PG8_SA(0, 1), cA + hstepA, voffA);
    if (wr == 1) PG8_BAR;
    PG8_WAIT_V(2); PG8_BAR;
    PG8_STAGE(PG8_SB(1, 0), cB + kstep, voffB); PG8_STAGE(PG8_SA(1, 0), cA + kstepA, voffA); PG8_STAGE(PG8_SB(1, 1), cB + hstepB + kstep, voffB);
    PG8_WAIT_V(6); PG8_BAR;
    for (;;) {
        const bool has_next = S.next(ui + 1, nxt);
        const char* nA = has_next ? PG8_PA(nxt) : cA; const char* nB = has_next ? PG8_PB(nxt) : cB;
        for (int t = 0; t < nt; t += 2) {
            const bool last = (t == nt - 2);
            const char* a1 = cA + (size_t)(t + 1) * kstepA;
            const char* a2 = last ? nA : cA + (size_t)(t + 2) * kstepA; const char* b2 = last ? nB : cB + (size_t)(t + 2) * kstep;
            const char* a3 = a2 + kstepA; const char* b3 = b2 + kstep;
            PG8_LDB(B0, 0, 0); PG8_LDB(B1, 0, 1); PG8_SCHED; PG8_LDA(At, 0, 0); PG8_STAGE(PG8_SA(1, 1), a1 + hstepA, voffA);
            PG8_WAIT_V(8); PG8_WAIT_L(0); PG8_BAR; PG8_MMA(0, 0, At, B0); PG8_MMA(0, 1, At, B1); PG8_BAR; PG8_SCHED;
            PG8_LDA(At, 0, 1); PG8_STAGE(PG8_SB(0, 0), b2, voffB); PG8_STAGE(PG8_SB(0, 1), b2 + hstepB, voffB); PG8_STAGE(PG8_SA(0, 0), a2, voffA);
            PG8_WAIT_V(8); PG8_WAIT_L(0); PG8_BAR; PG8_MMA(1, 0, At, B0); PG8_MMA(1, 1, At, B1); PG8_BAR; PG8_SCHED;
            PG8_LDB(B0, 1, 0); PG8_LDB(B1, 1, 1); PG8_SCHED; PG8_LDA(At, 1, 0); PG8_STAGE(PG8_SA(0, 1), a2 + hstepA, voffA);
            PG8_WAIT_V(8); PG8_WAIT_L(0); PG8_BAR; PG8_MMA(0, 0, At, B0); PG8_MMA(0, 1, At, B1); PG8_BAR; PG8_SCHED;
            PG8_LDA(At, 1, 1); PG8_STAGE(PG8_SB(1, 0), b3, voffB); PG8_STAGE(PG8_SB(1, 1), b3 + hstepB, voffB); PG8_STAGE(PG8_SA(1, 0), a3, voffA);
            PG8_WAIT_V(8); PG8_WAIT_L(0); PG8_BAR; PG8_MMA(1, 0, At, B0); PG8_MMA(1, 1, At, B1); PG8_BAR; PG8_SCHED;
        }
        if (wr == 0) PG8_BAR;
        bool keep = false;
        if constexpr (Epi::HAS_MID) keep = (cur.h == 0);
        if constexpr (Epi::HAS_MID) { if (keep) E.mid(acc, cur, wr, wc, fr, fq); else E(acc, cur, wr, wc, fr, fq); }
        else E(acc, cur, wr, wc, fr, fq);
        if (!has_next) break;
        if (!keep)
#pragma unroll
        for (int a = 0; a < 2; ++a)
#pragma unroll
            for (int b = 0; b < 2; ++b)
#pragma unroll
                for (int m = 0; m < 4; ++m)
#pragma unroll
                    for (int n = 0; n < 2; ++n) acc[a][b][m][n] = (f32x4){0.f, 0.f, 0.f, 0.f};
        cur = nxt; cA = nA; cB = nB; ++ui;
        if (wr == 1) PG8_BAR;
    }
    PG8_WAIT_V(0);
    PG8_BAR;
#undef PG8_SA
#undef PG8_SB
#undef PG8_STAGE
#undef PG8_LDA
#undef PG8_LDB
#undef PG8_MMA
#undef PG8_WAIT_V
#undef PG8_WAIT_L
#undef PG8_BAR
#undef PG8_SCHED
#undef PG8_PA
#undef PG8_PB
}
}
using pg8::Unit;

typedef f32x4 Acc[2][2][4][2];

__device__ __forceinline__ u32x4 pack8(const f32x4 v0, const f32x4 v1) {
    u32x4 w; w.x = cvt_pk_bf16(v0[0], v0[1]); w.y = cvt_pk_bf16(v0[2], v0[3]); w.z = cvt_pk_bf16(v1[0], v1[1]); w.w = cvt_pk_bf16(v1[2], v1[3]); return w;
}

struct EpiInProj {
    static constexpr bool HAS_MID = false;
    bf16_t* Kb; bf16_t* VTb; bf16_t* Qb; float* Gb; bf16_t* AB; bf16_t* MG; const float* biasp; const float* convw;
    __device__ __forceinline__ void operator()(Acc& acc, const Unit& u, int wr, int wc, int fr, int fq) const {
        if (u.sw) {
            const int r0 = u.pm * 256 + wr * 64 + fr, t0 = u.pn * 256 + wc * 32 + 8 * fq;
#pragma unroll
            for (int ai = 0; ai < 2; ++ai)
#pragma unroll
                for (int m = 0; m < 4; ++m) { const int wrow = r0 + ai * 128 + m * 16; const float bs = biasp[wrow]; bf16_t* rowp = VTb + (size_t)(wrow - 768) * MALL + t0;
#pragma unroll
                    for (int bj = 0; bj < 2; ++bj) *(u32x4*)(rowp + bj * 128) = pack8(acc[ai][bj][m][0] + bs, acc[ai][bj][m][1] + bs); }
            return;
        }
        const int row0 = u.pm * 256 + wr * 64 + fr, pn = u.pn;
        const int cb = pn * 256 + wc * 32 + 8 * fq;
        if (pn == 2) {
            if (wc == 0) {
                const f32x4 b0 = *(const f32x4*)(biasp + cb), b1 = *(const f32x4*)(biasp + cb + 4);
#pragma unroll
                for (int ai = 0; ai < 2; ++ai)
#pragma unroll
                    for (int m = 0; m < 4; ++m) { float* gp = Gb + (size_t)(8 * fq) * MALL + (row0 + ai * 128 + m * 16);
                        f32x4 g0 = acc[ai][0][m][0] + b0, g1 = acc[ai][0][m][1] + b1;
                        if (fq >= 2) {
#pragma unroll
                            for (int j = 0; j < 4; ++j) { g0[j] = logsig(g0[j]); g1[j] = logsig(g1[j]); } }
#pragma unroll
                        for (int j = 0; j < 4; ++j) { gp[(size_t)j * MALL] = g0[j]; gp[(size_t)(4 + j) * MALL] = g1[j]; } }
            }
            return;
        }
        if (pn >= 9 && pn < 25) {
            const int ch = 64 * (pn - 9) + 16 * wc + 4 * fq;
            const f32x4 bX = *(const f32x4*)(biasp + cb), bC = *(const f32x4*)(biasp + cb + 4), bB = *(const f32x4*)(biasp + cb + 128), bO = *(const f32x4*)(biasp + cb + 132);
            const f32x4 w0 = *(const f32x4*)(convw + ch), w1 = *(const f32x4*)(convw + 1024 + ch), w2 = *(const f32x4*)(convw + 2048 + ch);
#pragma unroll
            for (int ai = 0; ai < 2; ++ai) {
                f32x4 uu[4];
#pragma unroll
                for (int m = 0; m < 4; ++m) uu[m] = (acc[ai][0][m][0] + bX) * (acc[ai][0][m][1] + bC);
#pragma unroll
                for (int m = 0; m < 4; ++m) {
                    f32x4 pv, nx;
#pragma unroll
                    for (int j = 0; j < 4; ++j) {
                        const float pold = (m > 0) ? dppf<0x121>(0.f, uu[m > 0 ? m - 1 : 0][j]) : 0.f;
                        pv[j] = dppf<0x111>(pold, uu[m][j]);
                        const float nold = (m < 3) ? dppf<0x12F>(0.f, uu[m < 3 ? m + 1 : 3][j]) : 0.f;
                        nx[j] = dppf<0x101>(nold, uu[m][j]);
                    }
                    const f32x4 cv = w0 * pv + w1 * uu[m] + w2 * nx;
                    const f32x4 aa = (acc[ai][1][m][0] + bB) * cv;
                    f32x4 os = acc[ai][1][m][1] + bO;
#pragma unroll
                    for (int j = 0; j < 4; ++j) os[j] = sigm(os[j]);
                    bf16_t* rp = AB + (size_t)(row0 + ai * 128 + m * 16) * 2048 + ch;
                    u32x2 wa, wo; wa.x = cvt_pk_bf16(aa[0], aa[1]); wa.y = cvt_pk_bf16(aa[2], aa[3]); wo.x = cvt_pk_bf16(os[0], os[1]); wo.y = cvt_pk_bf16(os[2], os[3]);
                    *(u32x2*)rp = wa; *(u32x2*)(rp + 1024) = wo;
                }
            }
            return;
        }
        if (pn >= 25) {
            const int ch = 128 * (pn - 25) + 32 * wc + 8 * fq;
            f32x4 ba[2], bb[2];
#pragma unroll
            for (int n = 0; n < 2; ++n) { ba[n] = *(const f32x4*)(biasp + cb + 4 * n); bb[n] = *(const f32x4*)(biasp + cb + 128 + 4 * n); }
#pragma unroll
            for (int ai = 0; ai < 2; ++ai)
#pragma unroll
                for (int m = 0; m < 4; ++m) { bf16_t* rp = MG + (size_t)(row0 + ai * 128 + m * 16) * 2048 + ch;
                    f32x4 rr[2], gg[2];
#pragma unroll
                    for (int n = 0; n < 2; ++n) { const f32x4 xa = acc[ai][0][m][n] + ba[n], xb = acc[ai][1][m][n] + bb[n];
#pragma unroll
                        for (int j = 0; j < 4; ++j) { const float ea = 1.f + __expf(-xa[j]), eb = 1.f + __expf(-xb[j]); rr[n][j] = eb * __builtin_amdgcn_rcpf(ea); gg[n][j] = __builtin_amdgcn_rcpf(eb); } }
                    *(u32x4*)rp = pack8(rr[0], rr[1]); *(u32x4*)(rp + 1024) = pack8(gg[0], gg[1]); }
            return;
        }
        bf16_t* base; int ldc, col0, mode;
        if (pn < 2) { base = Kb; ldc = 512; col0 = pn * 256; mode = 0; }
        else { base = Qb; ldc = 512; col0 = (pn - 7) * 256; mode = 1; }
        col0 += wc * 32 + 8 * fq;
        f32x4 bv[2][2];
#pragma unroll
        for (int bj = 0; bj < 2; ++bj)
#pragma unroll
            for (int n = 0; n < 2; ++n) bv[bj][n] = *(const f32x4*)(biasp + cb + bj * 128 + 4 * n);
#pragma unroll
        for (int ai = 0; ai < 2; ++ai)
#pragma unroll
            for (int m = 0; m < 4; ++m) { bf16_t* rowp = base + (size_t)(row0 + ai * 128 + m * 16) * ldc + col0;
#pragma unroll
                for (int bj = 0; bj < 2; ++bj) { f32x4 v0 = acc[ai][bj][m][0] + bv[bj][0], v1 = acc[ai][bj][m][1] + bv[bj][1];
                    if (mode == 0) { v0 = v0 * 0.125f; v1 = v1 * 0.125f; }
                    *(u32x4*)(rowp + bj * 128) = pack8(v0, v1); } }
    }
};

struct EpiG2 {
    static constexpr bool HAS_MID = true;
    const bf16_t* MG; bf16_t* MRG;
    __device__ __forceinline__ void mid(Acc& acc, const Unit& u, int wr, int wc, int fr, int fq) const {
        const int row0 = u.pm * 256 + wr * 64 + fr, col0 = u.pn * 256 + wc * 32 + 8 * fq;
#pragma unroll
        for (int ai = 0; ai < 2; ++ai) {
            u32x4 rr[4][2];
#pragma unroll
            for (int m = 0; m < 4; ++m)
#pragma unroll
                for (int bj = 0; bj < 2; ++bj) rr[m][bj] = *(const u32x4*)(MG + (size_t)(row0 + ai * 128 + m * 16) * 2048 + col0 + bj * 128);
#pragma unroll
            for (int m = 0; m < 4; ++m)
#pragma unroll
                for (int bj = 0; bj < 2; ++bj) { const u32x4 q = rr[m][bj];
                    const f32x4 r0 = {bf_lo(q.x), bf_hi(q.x), bf_lo(q.y), bf_hi(q.y)}, r1 = {bf_lo(q.z), bf_hi(q.z), bf_lo(q.w), bf_hi(q.w)};
                    acc[ai][bj][m][0] = acc[ai][bj][m][0] * r0; acc[ai][bj][m][1] = acc[ai][bj][m][1] * r1; }
            asm volatile("" ::: "memory");
        }
    }
    __device__ __forceinline__ void operator()(Acc& acc, const Unit& u, int wr, int wc, int fr, int fq) const {
        const int row0 = u.pm * 256 + wr * 64 + fr, col0 = u.pn * 256 + wc * 32 + 8 * fq;
#pragma unroll
        for (int ai = 0; ai < 2; ++ai) {
            u32x4 gg[4][2];
#pragma unroll
            for (int m = 0; m < 4; ++m)
#pragma unroll
                for (int bj = 0; bj < 2; ++bj) gg[m][bj] = *(const u32x4*)(MG + (size_t)(row0 + ai * 128 + m * 16) * 2048 + col0 + bj * 128 + 1024);
#pragma unroll
            for (int m = 0; m < 4; ++m)
#pragma unroll
                for (int bj = 0; bj < 2; ++bj) { const u32x4 gb = gg[m][bj];
                    const f32x4 g0 = {bf_lo(gb.x), bf_hi(gb.x), bf_lo(gb.y), bf_hi(gb.y)}, g1 = {bf_lo(gb.z), bf_hi(gb.z), bf_lo(gb.w), bf_hi(gb.w)};
                    *(u32x4*)(MRG + (size_t)(row0 + ai * 128 + m * 16) * 1024 + col0 + bj * 128) = pack8(acc[ai][bj][m][0] * g0, acc[ai][bj][m][1] * g1); }
            asm volatile("" ::: "memory");
        }
    }
};
struct EpiRes {
    static constexpr bool HAS_MID = false;
    const float* base; float* out; const float* gate;
    __device__ __forceinline__ void operator()(Acc& acc, const Unit& u, int wr, int wc, int fr, int fq) const {
        const int row0 = u.pm * 256 + wr * 64 + fr, col0 = u.pn * 256 + wc * 32 + 8 * fq;
        const float* gp = gate + (size_t)((u.pm * 256) >> 11) * 6144 + col0;
        f32x4 gv[2][2];
#pragma unroll
        for (int bj = 0; bj < 2; ++bj)
#pragma unroll
            for (int n = 0; n < 2; ++n) gv[bj][n] = *(const f32x4*)(gp + bj * 128 + 4 * n);
#pragma unroll
        for (int ai = 0; ai < 2; ++ai)
#pragma unroll
            for (int m = 0; m < 4; ++m) { const size_t off = (size_t)(row0 + ai * 128 + m * 16) * 1024 + col0;
#pragma unroll
                for (int bj = 0; bj < 2; ++bj)
#pragma unroll
                    for (int n = 0; n < 2; ++n) { const f32x4 bs = *(const f32x4*)(base + off + bj * 128 + 4 * n);
                        *(f32x4*)(out + off + bj * 128 + 4 * n) = bs + gv[bj][n] * acc[ai][bj][m][n]; } }
    }
};
template <int mode> struct EpiResNorm {
    static constexpr bool HAS_MID = false;
    const float* base; float* out; const float* gate; int mode_unused;
    bf16_t* h2; const float* nw; const float* mod;
    bf16_t* x1b;
    float* xbuf; unsigned* cnt; LAS unsigned char* xl;
    __device__ __forceinline__ void operator()(Acc& acc, const Unit& u, int wr, int wc, int fr, int fq) const {
        const int wid = wr * 4 + wc, lane = fq * 16 + fr;
        const int row0 = u.pm * 256 + wr * 64 + fr, col0 = u.pn * 256 + wc * 32 + 8 * fq, bb = (u.pm * 256) >> 11;
        {
            const float* gp = gate + (size_t)bb * 6144 + col0;
            f32x4 gv[2][2];
#pragma unroll
            for (int bj = 0; bj < 2; ++bj)
#pragma unroll
                for (int n = 0; n < 2; ++n) gv[bj][n] = *(const f32x4*)(gp + bj * 128 + 4 * n);
#pragma unroll
            for (int ai = 0; ai < 2; ++ai)
#pragma unroll
                for (int m = 0; m < 4; ++m) { const size_t off = (size_t)(row0 + ai * 128 + m * 16) * 1024 + col0;
#pragma unroll
                    for (int bj = 0; bj < 2; ++bj) {
                        if (mode == 1) { const u32x4 q = *(const u32x4*)(x1b + off + bj * 128);
                            const f32x4 b0 = {bf_lo(q.x), bf_hi(q.x), bf_lo(q.y), bf_hi(q.y)}, b1 = {bf_lo(q.z), bf_hi(q.z), bf_lo(q.w), bf_hi(q.w)};
                            acc[ai][bj][m][0] = b0 + gv[bj][0] * acc[ai][bj][m][0]; acc[ai][bj][m][1] = b1 + gv[bj][1] * acc[ai][bj][m][1]; }
                        else {
#pragma unroll
                            for (int n = 0; n < 2; ++n) { const f32x4 bs = *(const f32x4*)(base + off + bj * 128 + 4 * n); acc[ai][bj][m][n] = bs + gv[bj][n] * acc[ai][bj][m][n]; } }
                    }
                    asm volatile("" : "+v"(acc[ai][0][m][0]), "+v"(acc[ai][0][m][1]), "+v"(acc[ai][1][m][0]), "+v"(acc[ai][1][m][1]));
                    if (m & 1) asm volatile("" ::: "memory"); }
        }
        LAS float* P = (LAS float*)xl; LAS float* S = (LAS float*)(xl + 4096);
#pragma unroll
        for (int ai = 0; ai < 2; ++ai)
#pragma unroll
            for (int m = 0; m < 4; ++m) { float q = 0.f;
#pragma unroll
                for (int bj = 0; bj < 2; ++bj)
#pragma unroll
                    for (int n = 0; n < 2; ++n) { const f32x4 x = acc[ai][bj][m][n]; q += (x[0] * x[0] + x[1] * x[1]) + (x[2] * x[2] + x[3] * x[3]); }
                q += __shfl_xor(q, 16); q += __shfl_xor(q, 32);
                if (fq == 0) P[(ai * 128 + wr * 64 + m * 16 + fr) * 4 + wc] = q; }
        asm volatile("s_waitcnt lgkmcnt(0)\n\ts_barrier" ::: "memory");
        const int row = wid * 32 + (lane & 31);
        if (lane < 32) { const float tot = (P[row * 4 + 0] + P[row * 4 + 1]) + (P[row * 4 + 2] + P[row * 4 + 3]);
            __hip_atomic_store(xbuf + (size_t)(u.pm * 256 + row) * 4 + u.pn, tot, __ATOMIC_RELAXED, __HIP_MEMORY_SCOPE_AGENT); }
        asm volatile("s_waitcnt vmcnt(0)" ::: "memory");
        if (lane == 0) __hip_atomic_fetch_add(cnt + 64 * u.pm, 1u, __ATOMIC_RELAXED, __HIP_MEMORY_SCOPE_AGENT);
        if (wid == 0) {
            unsigned sp = 0;
            while ((unsigned)__builtin_amdgcn_readfirstlane(__hip_atomic_load(cnt + 64 * u.pm, __ATOMIC_RELAXED, __HIP_MEMORY_SCOPE_AGENT)) < 32u) { __builtin_amdgcn_s_sleep(2); if (++sp > (1u << 20)) break; }
            __builtin_amdgcn_fence(__ATOMIC_ACQUIRE, "agent");
        }
        asm volatile("s_waitcnt vmcnt(0) lgkmcnt(0)\n\ts_barrier" ::: "memory");
        if (lane < 32) { const float* sl = xbuf + (size_t)(u.pm * 256 + row) * 4; float t = 0.f;
#pragma unroll
            for (int k = 0; k < 4; ++k) t += __hip_atomic_load(sl + k, __ATOMIC_RELAXED, __HIP_MEMORY_SCOPE_AGENT);
            S[row] = rsqrtf(t * (1.f / 1024.f) + EPS); }
        asm volatile("s_waitcnt vmcnt(0) lgkmcnt(0)\n\ts_barrier" ::: "memory");
#pragma unroll
        for (int bj = 0; bj < 2; ++bj) {
            const int c = col0 + bj * 128;
            f32x4 w0 = *(const f32x4*)(nw + c), w1 = *(const f32x4*)(nw + c + 4), h0 = (f32x4){0.f, 0.f, 0.f, 0.f}, h1 = h0;
            if (mode == 0) { const float* mb = mod + (size_t)bb * 6144 + c; w0 = w0 * (*(const f32x4*)(mb + 4096) + 1.f); w1 = w1 * (*(const f32x4*)(mb + 4100) + 1.f); h0 = *(const f32x4*)(mb + 3072); h1 = *(const f32x4*)(mb + 3076); }
#pragma unroll
            for (int ai = 0; ai < 2; ++ai)
#pragma unroll
                for (int m = 0; m < 4; ++m) { asm volatile("" ::: "memory"); const int rl = ai * 128 + wr * 64 + m * 16 + fr; const float r = S[rl]; const size_t off = (size_t)(u.pm * 256 + rl) * 1024 + c;
                    const f32x4 v0 = acc[ai][bj][m][0], v1 = acc[ai][bj][m][1];
                    if (mode == 0) { *(u32x4*)(x1b + off) = pack8(v0, v1); *(u32x4*)(h2 + off) = pack8((v0 * r) * w0 + h0, (v1 * r) * w1 + h1); }
                    else { *(f32x4*)(out + off) = (v0 * r) * w0; *(f32x4*)(out + off + 4) = (v1 * r) * w1; } }
        }
    }
};
struct EpiRelu2 {
    static constexpr bool HAS_MID = false;
    bf16_t* O; int ldc;
    __device__ __forceinline__ void operator()(Acc& acc, const Unit& u, int wr, int wc, int fr, int fq) const {
        const int row0 = u.pm * 256 + wr * 64 + fr, col0 = u.pn * 256 + wc * 32 + 8 * fq;
#pragma unroll
        for (int ai = 0; ai < 2; ++ai)
#pragma unroll
            for (int m = 0; m < 4; ++m) { const int row = row0 + ai * 128 + m * 16;
#pragma unroll
                for (int bj = 0; bj < 2; ++bj) { f32x4 v0 = acc[ai][bj][m][0], v1 = acc[ai][bj][m][1]; const int col = col0 + bj * 128;
                    bf16_t* rowp = O + ((size_t)(row >> 7) * (ldc >> 6) + (col >> 6)) * 8192 + (row & 127) * 64 + (col & 63) - bj * 128;
#pragma unroll
                    for (int j = 0; j < 4; ++j) { const float a = fmaxf(v0[j], 0.f), b = fmaxf(v1[j], 0.f); v0[j] = a * a; v1[j] = b * b; }
                    *(u32x4*)(rowp + bj * 128) = pack8(v0, v1); } }
    }
};

__device__ __forceinline__ int inproj_colmap(int n) {
    if (n < 512) return OFF_K + n;
    if (n < 768) { const int j = n - 512; return j < 32 ? OFF_IG + j : -1; }
    if (n < 1792) return OFF_V + (n - 768);
    if (n < 2304) return OFF_Q + (n - 1792);
    if (n < 6400) { const int lc = (n - 2304) & 255, jt = (n - 2304) >> 8, bj = lc >> 7, wc = (lc >> 5) & 3, fq = (lc >> 3) & 3, nn = (lc >> 2) & 1, jj = lc & 3;
        const int seg = 2 * bj + nn, ch = 64 * jt + 16 * wc + 4 * fq + jj;
        return (seg == 0 ? OFF_XIN : seg == 1 ? OFF_GC : seg == 2 ? OFF_GB : OFF_O) + ch; }
    { const int lc = (n - 6400) & 255, jt = (n - 6400) >> 8; return OFF_MRG + (lc >> 7) * 1024 + 128 * jt + (lc & 127); }
}
struct TrItem { const float* W; bf16_t* out; int ldw, nblk, ldo, kofs, item, map; };
__device__ __forceinline__ void tr_load(const TrItem& t, int lane, f32x4 (&v)[8]) {
    const int kb = t.item / t.nblk, nb = t.item % t.nblk, k0 = 64 * kb, n0 = 32 * nb;
    const int n4 = lane & 7, kr = lane >> 3;
    const int nn = n0 + 4 * n4; const int src = t.map ? inproj_colmap(nn) : nn;
#pragma unroll
    for (int it = 0; it < 8; ++it) v[it] = (src >= 0) ? *(const f32x4*)(t.W + (size_t)(k0 + 8 * it + kr) * t.ldw + src) : (f32x4){0.f, 0.f, 0.f, 0.f};
}
__device__ __forceinline__ void tr_finish(const TrItem& t, int lane, const f32x4 (&v)[8], LAS float* scr) {
    const int kb = t.item / t.nblk, nb = t.item % t.nblk, k0 = 64 * kb, n0 = 32 * nb;
    const int n4 = lane & 7, kr = lane >> 3;
#pragma unroll
    for (int it = 0; it < 8; ++it) { LAS float* d = scr + (8 * it + kr) * 33 + 4 * n4; d[0] = v[it][0]; d[1] = v[it][1]; d[2] = v[it][2]; d[3] = v[it][3]; }
    asm volatile("s_waitcnt lgkmcnt(0)" ::: "memory");
    const int c = lane & 7;
#pragma unroll
    for (int j = 0; j < 4; ++j) { const int n = (lane >> 3) + 8 * j; const LAS float* s = scr + (8 * c) * 33 + n;
        u32x4 o; o.x = cvt_pk_bf16(s[0 * 33], s[1 * 33]); o.y = cvt_pk_bf16(s[2 * 33], s[3 * 33]); o.z = cvt_pk_bf16(s[4 * 33], s[5 * 33]); o.w = cvt_pk_bf16(s[6 * 33], s[7 * 33]);
        *(u32x4*)(t.out + (size_t)(n0 + n) * t.ldo + t.kofs + k0 + 8 * c) = o; }
    asm volatile("s_waitcnt lgkmcnt(0)" ::: "memory");
}

struct Args { const float* in[18]; float* out; unsigned char* ws; int ph_lo, ph_hi; };
enum { I_X = 0, I_C, I_CTX, I_CCTX, I_WMOD, I_BMOD, I_N1W, I_WIN, I_BIN, I_CONVW, I_MNW, I_WCO, I_WMO, I_WOUT, I_N2W, I_WFF1, I_WFF2, I_FNW };

__device__ __forceinline__ void p0_mod(const Args& A, LAS unsigned char* lds, int tid, int lane, int wave, unsigned* modcnt) {
    unsigned char* ws = A.ws;
    LAS float* sl = (LAS float*)lds;
    LAS float* red = (LAS float*)(lds + 17 * 4096);
    bool filled = false; unsigned done = 0;
    for (int item = blockIdx.x; item < 6144 / 32; item += gridDim.x) {
        if (!filled) {
            float cv[34];
#pragma unroll
            for (int j = 0; j < 34; ++j) { const int i = tid + 512 * j; cv[j] = i < 16 * 1024 ? A.in[I_C][i] : A.in[I_CCTX][i - 16 * 1024]; }
#pragma unroll
            for (int j = 0; j < 34; ++j) sl[tid + 512 * j] = cv[j] * sigm(cv[j]);
            __syncthreads(); filled = true;
        }
        const int col = lane & 31, kh = lane >> 5, n0 = item * 32, kbase = 128 * wave + 64 * kh;
        float a[17];
#pragma unroll
        for (int r = 0; r < 17; ++r) a[r] = 0.f;
        const float* wp = A.in[I_WMOD] + (size_t)kbase * 6144 + n0 + col;
        float wv[64];
#pragma unroll
        for (int j = 0; j < 64; ++j) wv[j] = wp[(size_t)j * 6144];
#pragma unroll
        for (int i = 0; i < 64; i += 8) {
#pragma unroll
            for (int r = 0; r < 17; ++r) { const f32x4 s4 = *(const LAS f32x4*)(sl + r * 1024 + kbase + i), s5 = *(const LAS f32x4*)(sl + r * 1024 + kbase + i + 4);
                a[r] += (s4[0] * wv[i + 0] + s4[1] * wv[i + 1]) + (s4[2] * wv[i + 2] + s4[3] * wv[i + 3]) + (s5[0] * wv[i + 4] + s5[1] * wv[i + 5]) + (s5[2] * wv[i + 6] + s5[3] * wv[i + 7]); }
        }
#pragma unroll
        for (int r = 0; r < 17; ++r) red[((wave * 2 + kh) * 17 + r) * 32 + col] = a[r];
        __syncthreads();
        for (int o = tid; o < 17 * 32; o += 512) { const int r = o >> 5, cc = o & 31; float s = A.in[I_BMOD][n0 + cc];
#pragma unroll
            for (int p = 0; p < 16; ++p) s += red[(p * 17 + r) * 32 + cc];
            ((float*)(ws + WS_MOD))[r * 6144 + n0 + cc] = s; }
        asm volatile("s_waitcnt vmcnt(0)" ::: "memory");
        __syncthreads();
        ++done;
    }
    if (done && tid == 0) { __builtin_amdgcn_fence(__ATOMIC_RELEASE, "agent"); asm volatile("s_waitcnt vmcnt(0)" ::: "memory"); __hip_atomic_fetch_add(modcnt, done, __ATOMIC_RELAXED, __HIP_MEMORY_SCOPE_AGENT); }
}
__device__ __forceinline__ void p0_weights(const Args& A, LAS unsigned char* lds, int tid, int lane, int wave) {
    unsigned char* ws = A.ws;
    LAS float* scr = (LAS float*)(lds + wave * 16384);
    const int gw = blockIdx.x * 8 + wave, NGW = gridDim.x * 8;
    constexpr int IT_WIN = 16 * (NIN / 32), IT_SQ = 16 * 32, IT_W1 = 16 * 128, IT_W2 = 64 * 32;
    constexpr int NITEMS = IT_WIN + 3 * IT_SQ + IT_W1 + IT_W2;
    auto mk = [&](int it) -> TrItem {
        int r = it;
        if (r < IT_WIN) return TrItem{A.in[I_WIN], (bf16_t*)(ws + WS_WIN), DIN, NIN / 32, 1024, 0, r, 1}; r -= IT_WIN;
        if (r < IT_SQ) return TrItem{A.in[I_WCO], (bf16_t*)(ws + WS_BT2), 1024, 32, 2048, 0, r, 0}; r -= IT_SQ;
        if (r < IT_SQ) return TrItem{A.in[I_WMO], (bf16_t*)(ws + WS_BT2), 1024, 32, 2048, 1024, r, 0}; r -= IT_SQ;
        if (r < IT_SQ) return TrItem{A.in[I_WOUT], (bf16_t*)(ws + WS_WO), 1024, 32, 1024, 0, r, 0}; r -= IT_SQ;
        if (r < IT_W1) return TrItem{A.in[I_WFF1], (bf16_t*)(ws + WS_W1), 4096, 128, 1024, 0, r, 0}; r -= IT_W1;
        return TrItem{A.in[I_WFF2], (bf16_t*)(ws + WS_W2), 1024, 32, F1P, 0, r, 0};
    };
    if (gw < NITEMS) {
        f32x4 va[8], vb[8];
        TrItem cur = mk(gw); tr_load(cur, lane, va);
        for (int it = gw; it < NITEMS; it += 2 * NGW) {
            const bool h1 = it + NGW < NITEMS, h2 = it + 2 * NGW < NITEMS;
            TrItem nx = cur; if (h1) { nx = mk(it + NGW); tr_load(nx, lane, vb); }
            tr_finish(cur, lane, va, scr);
            if (!h1) break;
            if (h2) { cur = mk(it + 2 * NGW); tr_load(cur, lane, va); }
            tr_finish(nx, lane, vb, scr);
        }
    }
    for (int i = blockIdx.x * 512 + tid; i < NIN; i += gridDim.x * 512) { const int s = inproj_colmap(i); ((float*)(ws + WS_BIASP))[i] = s >= 0 ? A.in[I_BIN][s] : 0.f; }
}

__device__ __forceinline__ float wave_allsum(float x) { return lane63(wave_scan_add(x)); }
__device__ __forceinline__ void modulate_rows4(const float* xrow, const float* w, const float* sh, const float* sc, bf16_t* orow, int lane) {
    f32x4 v[4][4]; float r[4];
#pragma unroll
    for (int q = 0; q < 4; ++q)
#pragma unroll
        for (int j = 0; j < 4; ++j) v[q][j] = ((const f32x4*)(xrow + (size_t)q * DM))[lane + 64 * j];
#pragma unroll
    for (int q = 0; q < 4; ++q) { float s = 0.f;
#pragma unroll
        for (int j = 0; j < 4; ++j) s += (v[q][j].x * v[q][j].x + v[q][j].y * v[q][j].y) + (v[q][j].z * v[q][j].z + v[q][j].w * v[q][j].w);
        r[q] = rsqrtf(wave_allsum(s) * (1.f / DM) + EPS); }
#pragma unroll
    for (int j = 0; j < 4; ++j) { const f32x4 ww = ((const f32x4*)w)[lane + 64 * j], hh = ((const f32x4*)sh)[lane + 64 * j], cc = ((const f32x4*)sc)[lane + 64 * j];
        const f32x4 wc = ww * (cc + 1.f);
#pragma unroll
        for (int q = 0; q < 4; ++q) { const f32x4 y = (v[q][j] * r[q]) * wc + hh;
            u32x2 p; p.x = cvt_pk_bf16(y[0], y[1]); p.y = cvt_pk_bf16(y[2], y[3]); ((u32x2*)(orow + (size_t)q * DM))[lane + 64 * j] = p; } }
}

constexpr int L_QS = 0, L_KS = 18432, L_KTS = 36864, L_VTS = 54272, L_SS = 93440, L_CS = 128256, L_GW = 148992;
static_assert(L_GW + 8 * 512 <= LDS_BYTES, "mlstm LDS map");
#define BAR_LDS() asm volatile("s_waitcnt lgkmcnt(0)\n\ts_barrier" ::: "memory")

__device__ __forceinline__ void mlstm_seq(LAS unsigned char* lds, const bf16_t* Kb, const bf16_t* VTb, const bf16_t* Qb, const float* Gb, bf16_t* HD0, bf16_t* HD1, int seq, int tid, int lane, int w) {
    const int dir = seq >> 7, b = (seq >> 3) & 15, head = seq & 7;
    const int g = lane >> 4, l15 = lane & 15;
    bf16_t* HD = dir ? HD1 : HD0;
    for (int i = tid; i < 16 * 136; i += 512) { const int r = i / 136, cidx = i % 136; *(LAS bf16_t*)(lds + L_VTS + (128 + r) * 272 + cidx * 2) = (r == 0) ? (bf16_t)0x3F80 : (bf16_t)0; }
    f32x4 st[4], nst;
#pragma unroll
    for (int i = 0; i < 4; ++i) st[i] = (f32x4){0.f, 0.f, 0.f, 0.f};
    nst = (f32x4){0.f, 0.f, 0.f, 0.f};
    float mstate = 0.f;
    u32x4 pq[2], pk[2], pv[4]; float gi0, gi1, gf0, gf1;
    unsigned offq[2], offv[4], offg0, offg1;
#pragma unroll
    for (int i = 0; i < 2; ++i) { const int p = tid + 512 * i, row = p >> 3, pc = p & 7; offq[i] = (unsigned)((dir ? 127 - row : row) * 512 + head * 64 + pc * 8); }
#pragma unroll
    for (int i = 0; i < 4; ++i) { const int p = tid + 512 * i, v = p >> 4, pc = p & 15; offv[i] = (unsigned)((head * 128 + v) * MALL + pc * 8); }
    offg0 = (unsigned)((dir * 8 + head) * MALL + (dir ? 127 - lane : lane)); offg1 = (unsigned)((dir * 8 + head) * MALL + (dir ? 63 - lane : lane + 64));
#define PREFETCH(cc) do { const int cc_ = (cc); const bool isctx_ = cc_ < 2; const int T_ = isctx_ ? CTXL : SEQ, c_ = isctx_ ? cc_ : cc_ - 2; \
        const int base_ = isctx_ ? MTOK + b * CTXL : b * SEQ; const int tok0_ = base_ + (dir ? T_ - 128 * (c_ + 1) : 128 * c_); \
        const bf16_t* qb_ = Qb + (size_t)tok0_ * 512; const bf16_t* kb_ = Kb + (size_t)tok0_ * 512; const bf16_t* vb_ = VTb + tok0_; const float* gb_ = Gb + tok0_; \
        if (!isctx_) { _Pragma("unroll") for (int i = 0; i < 2; ++i) pq[i] = *(const u32x4*)(qb_ + offq[i]); } \
        _Pragma("unroll") for (int i = 0; i < 2; ++i) pk[i] = *(const u32x4*)(kb_ + offq[i]); \
        _Pragma("unroll") for (int i = 0; i < 4; ++i) pv[i] = *(const u32x4*)(vb_ + offv[i]); \
        gi0 = gb_[offg0]; gf0 = gb_[offg0 + 16 * MALL]; gi1 = gb_[offg1]; gf1 = gb_[offg1 + 16 * MALL]; \
    } while (0)
    PREFETCH(0);
    for (int cc = 0; cc < 18; ++cc) {
        const bool isctx = cc < 2; const int T_ = isctx ? CTXL : SEQ, c_ = isctx ? cc : cc - 2;
        const int tok0 = (isctx ? MTOK + b * CTXL : b * SEQ) + (dir ? T_ - 128 * (c_ + 1) : 128 * c_);
        const float b0 = wave_scan_add(gf0), b1 = wave_scan_add(gf1) + lane63(b0);
        const float a0 = gi0 - b0, a1 = gi1 - b1;
        const float Mc = fmaxf(mstate, lane63(wave_scan_max(fmaxf(a0, a1))));
        const float e0 = __expf(a0 - Mc), e1 = __expf(a1 - Mc), th0 = __expf(-b0 - Mc), th1 = __expf(-b1 - Mc);
        const float decay = __expf(mstate - Mc);
        mstate = lane63(b1) + Mc;
#pragma unroll
        for (int db = 0; db < 4; ++db) { st[db] = st[db] * decay; u32x2 p; p.x = cvt_pk_bf16(st[db][0], st[db][1]); p.y = cvt_pk_bf16(st[db][2], st[db][3]);
            *(LAS u32x2*)(lds + L_CS + (16 * w + l15) * 144 + (16 * db + 4 * g) * 2) = p; }
        if (w < 4) { nst = nst * decay; u32x2 p; p.x = cvt_pk_bf16(nst[0], nst[1]); p.y = cvt_pk_bf16(nst[2], nst[3]);
            *(LAS u32x2*)(lds + L_CS + (128 + l15) * 144 + (16 * w + 4 * g) * 2) = p; }
        if (!isctx) {
#pragma unroll
            for (int i = 0; i < 2; ++i) { const int p = tid + 512 * i, row = p >> 3, pc = p & 7; *(LAS u32x4*)(lds + L_QS + row * 144 + pc * 16) = pq[i]; }
        }
        {
#pragma unroll
            for (int i = 0; i < 2; ++i) { const int p = tid + 512 * i, row = p >> 3, pc = p & 7, kidx = dir ? 127 - row : row;
                const float es = __shfl(i ? e1 : e0, 8 * w + (lane >> 3));
                const int kcol = (((kidx >> 3) ^ pc) << 3) | (kidx & 7);
                const unsigned ww[4] = {pk[i].x, pk[i].y, pk[i].z, pk[i].w}; unsigned sc4[4];
#pragma unroll
                for (int q2 = 0; q2 < 4; ++q2) { const unsigned pkd = cvt_pk_bf16(bf_lo(ww[q2]) * es, bf_hi(ww[q2]) * es); sc4[q2] = pkd;
                    *(LAS bf16_t*)(lds + L_KTS + (pc * 8 + 2 * q2) * 272 + kcol * 2) = (bf16_t)(pkd & 0xffffu);
                    *(LAS bf16_t*)(lds + L_KTS + (pc * 8 + 2 * q2 + 1) * 272 + kcol * 2) = (bf16_t)(pkd >> 16); }
                *(LAS u32x4*)(lds + L_KS + row * 144 + pc * 16) = (u32x4){sc4[0], sc4[1], sc4[2], sc4[3]}; }
#pragma unroll
            for (int i = 0; i < 4; ++i) { const int p = tid + 512 * i, v = p >> 4, pc = p & 15;
                const int rho = (v & ~31) | (((v >> 2) & 1) << 4) | (((v >> 3) & 3) << 2) | (v & 3);
                *(LAS u32x4*)(lds + L_VTS + rho * 272 + pc * 16) = pv[i]; }
        }
        BAR_LDS();
        if (cc + 1 < 18) PREFETCH(cc + 1);
        if (!isctx) {
            const int tb = (w < 4) ? 2 * w : 15 - 2 * w;
            const int trow = 16 * tb + l15;
            const int klo = dir ? ((7 - tb) >> 1) : 0, khi = dir ? 3 : (tb >> 1);
            bf16x8 qf[2];
#pragma unroll
            for (int kk = 0; kk < 2; ++kk) qf[kk] = *(const LAS bf16x8*)(lds + L_QS + trow * 144 + (kk * 32 + g * 8) * 2);
#pragma unroll
            for (int sb = 0; sb < 8; ++sb) {
                f32x4 sa = (f32x4){0.f, 0.f, 0.f, 0.f};
                if (sb <= tb) {
#pragma unroll
                    for (int kk = 0; kk < 2; ++kk) { const bf16x8 kf = *(const LAS bf16x8*)(lds + L_KS + (16 * sb + l15) * 144 + (kk * 32 + g * 8) * 2);
                        sa = __builtin_amdgcn_mfma_f32_16x16x32_bf16(kf, qf[kk], sa, 0, 0, 0); }
                    if (sb == tb) { const int s0 = 16 * sb + 4 * g;
#pragma unroll
                        for (int r = 0; r < 4; ++r) sa[r] = (s0 + r <= trow) ? sa[r] : 0.f; }
                }
                const int s0 = 16 * sb + 4 * g;
                u32x2 p;
                if (dir) { p.x = cvt_pk_bf16(sa[3], sa[2]); p.y = cvt_pk_bf16(sa[1], sa[0]); *(LAS u32x2*)(lds + L_SS + trow * 272 + (124 - s0) * 2) = p; }
                else { p.x = cvt_pk_bf16(sa[0], sa[1]); p.y = cvt_pk_bf16(sa[2], sa[3]); *(LAS u32x2*)(lds + L_SS + trow * 272 + s0 * 2) = p; }
            }
            f32x4 num[9];
#pragma unroll
            for (int vb = 0; vb < 9; ++vb) { num[vb] = (f32x4){0.f, 0.f, 0.f, 0.f};
#pragma unroll
                for (int kk = 0; kk < 2; ++kk) { const bf16x8 cf = *(const LAS bf16x8*)(lds + L_CS + (16 * vb + l15) * 144 + (kk * 32 + g * 8) * 2);
                    num[vb] = __builtin_amdgcn_mfma_f32_16x16x32_bf16(cf, qf[kk], num[vb], 0, 0, 0); } }
#pragma unroll
            for (int kk = 0; kk < 4; ++kk) {
                if (kk >= klo && kk <= khi) {
                    const bf16x8 sf = *(const LAS bf16x8*)(lds + L_SS + trow * 272 + (kk * 32 + g * 8) * 2);
#pragma unroll
                    for (int vb = 0; vb < 9; ++vb) { const bf16x8 vf = *(const LAS bf16x8*)(lds + L_VTS + (16 * vb + l15) * 272 + (kk * 32 + g * 8) * 2);
                        num[vb] = __builtin_amdgcn_mfma_f32_16x16x32_bf16(vf, sf, num[vb], 0, 0, 0); }
                }
            }
            const float den = __shfl(num[8][0], l15);
            const float thr = __shfl((tb < 4) ? th0 : th1, (16 * tb + l15) & 63);
            const float inv = 1.f / fmaxf(fabsf(den), thr);
            const int tok = tok0 + (dir ? 127 - trow : trow);
            bf16_t* hp = HD + (size_t)tok * 1024 + head * 128 + 8 * g;
#pragma unroll
            for (int vp = 0; vp < 4; ++vp) { u32x4 p; p.x = cvt_pk_bf16(num[2 * vp][0] * inv, num[2 * vp][1] * inv); p.y = cvt_pk_bf16(num[2 * vp][2] * inv, num[2 * vp][3] * inv);
                p.z = cvt_pk_bf16(num[2 * vp + 1][0] * inv, num[2 * vp + 1][1] * inv); p.w = cvt_pk_bf16(num[2 * vp + 1][2] * inv, num[2 * vp + 1][3] * inv); *(u32x4*)(hp + 32 * vp) = p; }
        }
        {
            bf16x8 vf[4];
#pragma unroll
            for (int kk = 0; kk < 4; ++kk) vf[kk] = *(const LAS bf16x8*)(lds + L_VTS + (16 * w + l15) * 272 + (kk * 32 + g * 8) * 2);
#pragma unroll
            for (int db = 0; db < 4; ++db)
#pragma unroll
                for (int kk = 0; kk < 4; ++kk) { const bf16x8 kf = *(const LAS bf16x8*)(lds + L_KTS + (16 * db + l15) * 272 + (((4 * kk + g) ^ ((2 * db + (l15 >> 3)) & 7)) << 4));
                    st[db] = __builtin_amdgcn_mfma_f32_16x16x32_bf16(kf, vf[kk], st[db], 0, 0, 0); }
            if (w < 4) {
#pragma unroll
                for (int kk = 0; kk < 4; ++kk) { const bf16x8 kf = *(const LAS bf16x8*)(lds + L_KTS + (16 * w + l15) * 272 + (((4 * kk + g) ^ ((2 * w + (l15 >> 3)) & 7)) << 4));
                    const bf16x8 of = *(const LAS bf16x8*)(lds + L_VTS + (128 + l15) * 272 + (kk * 32 + g * 8) * 2);
                    nst = __builtin_amdgcn_mfma_f32_16x16x32_bf16(kf, of, nst, 0, 0, 0); }
            }
        }
        BAR_LDS();
    }
#undef PREFETCH
}

__device__ __forceinline__ void combine_rows4(const bf16_t* h0, const bf16_t* h1, bf16_t* ab, const float* nw, int lane) {
    u32x4 a[4][2], b[4][2], o[4][2];
#pragma unroll
    for (int q = 0; q < 4; ++q)
#pragma unroll
        for (int i = 0; i < 2; ++i) { const int p = lane + 64 * i;
            a[q][i] = *(const u32x4*)(h0 + (size_t)q * 1024 + 8 * p); b[q][i] = *(const u32x4*)(h1 + (size_t)q * 1024 + 8 * p); o[q][i] = *(const u32x4*)(ab + (size_t)q * 2048 + 8 * p); }
#pragma unroll
    for (int i = 0; i < 2; ++i) { const int p = lane + 64 * i;
        const f32x4 n0 = *(const f32x4*)(nw + 8 * p), n1 = *(const f32x4*)(nw + 8 * p + 4);
#pragma unroll
        for (int q = 0; q < 4; ++q) { const u32x4 aa = a[q][i], bb = b[q][i], oo = o[q][i];
            float s[8] = {bf_lo(aa.x) + bf_lo(bb.x), bf_hi(aa.x) + bf_hi(bb.x), bf_lo(aa.y) + bf_lo(bb.y), bf_hi(aa.y) + bf_hi(bb.y), bf_lo(aa.z) + bf_lo(bb.z), bf_hi(aa.z) + bf_hi(bb.z), bf_lo(aa.w) + bf_lo(bb.w), bf_hi(aa.w) + bf_hi(bb.w)};
            float ss = 0.f;
#pragma unroll
            for (int j = 0; j < 8; ++j) ss += s[j] * s[j];
            ss += dppf<0x121>(0.f, ss); ss += dppf<0x122>(0.f, ss); ss += dppf<0x124>(0.f, ss); ss += dppf<0x128>(0.f, ss);
            const float r = rsqrtf(ss * (1.f / 128.f) + EPS);
            const float og[8] = {bf_lo(oo.x), bf_hi(oo.x), bf_lo(oo.y), bf_hi(oo.y), bf_lo(oo.z), bf_hi(oo.z), bf_lo(oo.w), bf_hi(oo.w)};
            u32x4 qv;
            qv.x = cvt_pk_bf16(s[0] * r * n0[0] * og[0], s[1] * r * n0[1] * og[1]); qv.y = cvt_pk_bf16(s[2] * r * n0[2] * og[2], s[3] * r * n0[3] * og[3]);
            qv.z = cvt_pk_bf16(s[4] * r * n1[0] * og[4], s[5] * r * n1[1] * og[5]); qv.w = cvt_pk_bf16(s[6] * r * n1[2] * og[6], s[7] * r * n1[3] * og[7]);
            *(u32x4*)(ab + (size_t)q * 2048 + 8 * p) = qv; } }
}

#define XB_TMO      128
#define XB_XCNT(j)  (256  + 64 * (j))
#define XB_XSUB(j)  (1280 + 64 * (j))
#define XB_XGEN(j)  (2304 + 64 * (j))
#define XB_TOP      3328
#define XB_TOPGEN   3392
#define XCD_BAR_WORDS 3456
#define XB_SPIN_CAP (1u << 18)
__device__ __forceinline__ unsigned xb_ld(unsigned* p)              { return __hip_atomic_load(p, __ATOMIC_RELAXED, __HIP_MEMORY_SCOPE_AGENT); }
__device__ __forceinline__ unsigned xb_add(unsigned* p, unsigned v) { return __hip_atomic_fetch_add(p, v, __ATOMIC_RELAXED, __HIP_MEMORY_SCOPE_AGENT); }
__device__ __forceinline__ unsigned xb_xcc_id() { return (unsigned)__builtin_amdgcn_s_getreg((3 << 11) | 20) & 0xFu; }
#define XB_SPIN(cond, bar) do { unsigned _sp = 0; while (cond) { __builtin_amdgcn_s_sleep(1); \
    if ((++_sp & 255u) == 0u) { if (xb_ld(&(bar)[XB_TMO])) break; if (_sp > XB_SPIN_CAP) { atomicAdd(&(bar)[XB_TMO], 1u); break; } } } } while (0)
struct XcdBarrier { unsigned* bar; unsigned x; volatile LAS unsigned* st; };
__device__ __forceinline__ XcdBarrier xcd_barrier_post(unsigned* bar, volatile LAS unsigned* st) {
    XcdBarrier b; b.bar = bar; b.x = xb_xcc_id(); b.st = st;
    if (threadIdx.x == 0) (void)xb_add(&bar[XB_XCNT(b.x)], 1u);
    return b;
}
__device__ __forceinline__ void xcd_barrier_complete(unsigned* bar, unsigned x, unsigned& nloc, unsigned& nx) {
    const unsigned G = gridDim.x * gridDim.y * gridDim.z;
    unsigned sum, cnt, mine, sp = 0u;
    for (;;) {
        sum = 0u; cnt = 0u; mine = 0u;
#pragma unroll
        for (unsigned j = 0; j < 16; ++j) { const unsigned c = xb_ld(&bar[XB_XCNT(j)]); sum += c; cnt += (c > 0u) ? 1u : 0u; mine = (j == x) ? c : mine; }
        if (sum == G) break;
        __builtin_amdgcn_s_sleep(1);
        if ((++sp & 255u) == 0u) { if (xb_ld(&bar[XB_TMO])) break; if (sp > XB_SPIN_CAP) { atomicAdd(&bar[XB_TMO], 1u); break; } }
    }
    nloc = mine > 0u ? mine : 1u; nx = cnt > 0u ? cnt : 1u;
}
__device__ __forceinline__ void xcd_barrier(const XcdBarrier& b) {
    asm volatile("s_waitcnt vmcnt(0)" ::: "memory");
    __syncthreads();
    if (threadIdx.x == 0) {
        unsigned* bar = b.bar;
        __builtin_amdgcn_s_waitcnt(0);
        unsigned nloc = b.st[0], nx = b.st[1];
        if (nloc == 0u) { xcd_barrier_complete(bar, b.x, nloc, nx); b.st[0] = nloc; b.st[1] = nx; }
        const unsigned old = xb_add(&bar[XB_XSUB(b.x)], 1u);
        const unsigned gen = old / nloc;
        if (old + 1u == (gen + 1u) * nloc) {
            __builtin_amdgcn_fence(__ATOMIC_RELEASE, "agent");
            asm volatile("s_waitcnt vmcnt(0)" ::: "memory");
            const unsigned og = xb_add(&bar[XB_TOP], 1u);
            const unsigned tg = og / nx;
            if (og + 1u == (tg + 1u) * nx) xb_add(&bar[XB_TOPGEN], 1u);
            else XB_SPIN(xb_ld(&bar[XB_TOPGEN]) == tg, bar);
            __builtin_amdgcn_fence(__ATOMIC_ACQUIRE, "agent");
            xb_add(&bar[XB_XGEN(b.x)], 1u);
            asm volatile("s_waitcnt vmcnt(0)" ::: "memory");
        } else {
            XB_SPIN(xb_ld(&bar[XB_XGEN(b.x)]) == gen, bar);
            __builtin_amdgcn_fence(__ATOMIC_ACQUIRE, "agent");
            asm volatile("s_waitcnt vmcnt(0)" ::: "memory");
        }
    }
    __syncthreads();
}

constexpr int N_PHASES = 11;
__global__ void __launch_bounds__(512, 2) mk_fwd(Args A) {
    extern __shared__ __attribute__((aligned(16))) unsigned char lds_raw[];
    LAS unsigned char* lds = (LAS unsigned char*)lds_raw;
    cg::grid_group grid = cg::this_grid();
    const int tid = threadIdx.x, lane = tid & 63, wave = __builtin_amdgcn_readfirstlane(tid >> 6);
    const int G = gridDim.x, gw = blockIdx.x * 8 + wave, NGW = G * 8;
    unsigned char* ws = A.ws;
    const float* mod = (const float*)(ws + WS_MOD);
    bf16_t* H = (bf16_t*)(ws + WS_H);
    const int lo = A.ph_lo, hi = A.ph_hi;
#ifndef PHMASK
#define PHMASK 0x7ff
#endif
#ifndef REPMASK
#define REPMASK 0
#endif
#ifndef XSYNC
#define XSYNC 0
#endif
#ifndef TS_LO
#define TS_LO -2
#define TS_HI -2
#endif
#define REP(k) for (int rep_ = 0; rep_ < 1 + ((REPMASK >> (k)) & 1); ++rep_)
#define IN(k) (((PHMASK >> (k)) & 1) && lo <= (k) && (k) < hi)
    unsigned* barw = (unsigned*)(ws + WS_BAR);
    volatile LAS unsigned* bst = (volatile LAS unsigned*)(lds + LDS_BYTES - 16);
    if (tid < 4) bst[tid] = 0u;
    __syncthreads();
    if (hi < 0) grid.sync();
    XcdBarrier xbar = xcd_barrier_post(barw, bst);
    unsigned long long ts_a = 0, ts_b = 0;
    if (TS_LO == -1) ts_a = __builtin_amdgcn_s_memrealtime();
#define SEAM(k) do { if (IN(k) && IN((k) + 1)) xcd_barrier(xbar); if (TS_LO == (k)) ts_a = __builtin_amdgcn_s_memrealtime(); if (TS_HI == (k)) ts_b = __builtin_amdgcn_s_memrealtime(); } while (0)

    if (IN(0)) {
        unsigned* modcnt = (unsigned*)(ws + WS_MODCNT);
        p0_mod(A, lds, tid, lane, wave, modcnt);
        if (TS_LO == 20) ts_a = __builtin_amdgcn_s_memrealtime(); if (TS_HI == 20) ts_b = __builtin_amdgcn_s_memrealtime();
        __syncthreads();
        p0_weights(A, lds, tid, lane, wave);
        if (TS_LO == 21) ts_a = __builtin_amdgcn_s_memrealtime(); if (TS_HI == 21) ts_b = __builtin_amdgcn_s_memrealtime();
        if (tid == 0) { unsigned sp = 0; while (__hip_atomic_load(modcnt, __ATOMIC_RELAXED, __HIP_MEMORY_SCOPE_AGENT) < 6144u / 32u) { __builtin_amdgcn_s_sleep(2); if (++sp > (1u << 22)) break; }
            __builtin_amdgcn_fence(__ATOMIC_ACQUIRE, "agent"); asm volatile("s_waitcnt vmcnt(0)" ::: "memory"); }
        __syncthreads();
        for (int row = 4 * gw; row < MALL; row += 4 * NGW) {
            const bool isx = row < MTOK; const int bb = isx ? (row >> 11) : 16;
            const float* xr = isx ? A.in[I_X] + (size_t)row * DM : A.in[I_CTX] + (size_t)(row - MTOK) * DM;
            modulate_rows4(xr, A.in[I_N1W], mod + bb * 6144, mod + bb * 6144 + 1024, H + (size_t)row * DM, lane);
        }
    }
    if (TS_LO == 0) ts_a = __builtin_amdgcn_s_memrealtime(); if (TS_HI == 0) ts_b = __builtin_amdgcn_s_memrealtime();
    SEAM(1);
    if (IN(2)) REP(2) {
        pg8::Gemm g{H, (const bf16_t*)(ws + WS_WIN), 1024, 1024, 1024, 0}; pg8::InProjOrder S{G, (int)blockIdx.x};
        EpiInProj E{(bf16_t*)(ws + WS_K), (bf16_t*)(ws + WS_VT), (bf16_t*)(ws + WS_Q), (float*)(ws + WS_G), (bf16_t*)(ws + WS_AB), (bf16_t*)A.out, (const float*)(ws + WS_BIASP), A.in[I_CONVW]};
        pg8::gemm_phase<EpiInProj, pg8::InProjOrder>(lds, g, S, E);
    }
    SEAM(2);
    if (IN(3)) REP(3) {
        for (int seq = blockIdx.x; seq < 256; seq += G)
            mlstm_seq(lds, (const bf16_t*)(ws + WS_K), (const bf16_t*)(ws + WS_VT), (const bf16_t*)(ws + WS_Q), (const float*)(ws + WS_G), (bf16_t*)(ws + WS_H), (bf16_t*)(ws + WS_HD1), seq, tid, lane, wave);
    }
    SEAM(3);
    if (IN(4)) {
        for (int row = 4 * gw; row < MTOK; row += 4 * NGW)
            combine_rows4((const bf16_t*)(ws + WS_H) + (size_t)row * 1024, (const bf16_t*)(ws + WS_HD1) + (size_t)row * 1024, (bf16_t*)(ws + WS_AB) + (size_t)row * 2048 + 1024, A.in[I_MNW], lane);
    }
    SEAM(4);
    if (IN(5)) REP(5) {
        pg8::Gemm g{(const bf16_t*)(ws + WS_AB), (const bf16_t*)(ws + WS_BT2), 1024, 2048, 2048, 0}; pg8::SplitKOrder S; S.base.init(MTOK, 1024, G, (int)blockIdx.x);
        EpiG2 E{(const bf16_t*)A.out, (bf16_t*)(ws + WS_H)};
        pg8::gemm_phase<EpiG2, pg8::SplitKOrder>(lds, g, S, E);
    }
    SEAM(5);
    if (IN(6)) REP(6) {
        pg8::Gemm g{(const bf16_t*)(ws + WS_H), (const bf16_t*)(ws + WS_WO), 1024, 1024, 1024, 0}; pg8::StaticOrder S; S.init(MTOK, 1024, G, (int)blockIdx.x);
        EpiResNorm<0> E{A.in[I_X], A.out, mod + 2048, 0, H, A.in[I_N2W], mod, (bf16_t*)(ws + WS_HD1), (float*)(ws + WS_XBUF), (unsigned*)(ws + WS_CNT), lds + 131072};
        pg8::gemm_phase<EpiResNorm<0>, pg8::StaticOrder>(lds, g, S, E);
    }
    SEAM(6);
    if (IN(8)) REP(8) {
        pg8::Gemm g{H, (const bf16_t*)(ws + WS_W1), 1024, 1024, 1024, 0}; pg8::StaticOrder S; S.init(MTOK, DFF, G, (int)blockIdx.x);
        EpiRelu2 E{(bf16_t*)(ws + WS_F1), DFF};
        pg8::gemm_phase<EpiRelu2, pg8::StaticOrder>(lds, g, S, E);
    }
    SEAM(8);
    if (IN(9)) {
        pg8::Gemm g{(const bf16_t*)(ws + WS_F1), (const bf16_t*)(ws + WS_W2), DFF, DFF, F1P, 1}; pg8::StaticOrder S; S.init(MTOK, 1024, G, (int)blockIdx.x);
        EpiResNorm<1> E{A.out, A.out, mod + 5120, 1, nullptr, A.in[I_FNW], mod, (bf16_t*)(ws + WS_HD1), (float*)(ws + WS_XBUF) + (size_t)MTOK * 4, (unsigned*)(ws + WS_CNT) + 128 * 64, lds + 131072};
        pg8::gemm_phase<EpiResNorm<1>, pg8::StaticOrder>(lds, g, S, E);
    }
    if (TS_LO > -2) {
        xcd_barrier(xbar); if (TS_HI == 9) ts_b = __builtin_amdgcn_s_memrealtime();
        if (blockIdx.x == 0) { const int n = (int)((ts_b - ts_a) / 100ull); for (int i = tid; i < n; i += 512) A.out[(size_t)i * 4096 + 3] += 0.25f; }
    }
#undef IN
#undef SEAM
}

#ifndef MK_N_LAUNCHES
#define MK_N_LAUNCHES 1
#endif
extern "C" void kernel_launch(void* const* d_in, const int* in_sizes, int n_in, void* d_out, int out_size, void* d_ws, size_t ws_size, hipStream_t stream) {
    static int grid = 0;
    if (grid == 0) {
        if (n_in != 18 || out_size != MTOK * DM || ws_size < WS_END) { fprintf(stderr, "kernel_launch: unexpected shapes (n_in %d out %d ws %zu)\n", n_in, out_size, ws_size); grid = -1; return; }
        int dev = 0, cus = 0, per_cu = 0;
        hipGetDevice(&dev); hipDeviceGetAttribute(&cus, hipDeviceAttributeMultiprocessorCount, dev);
        hipFuncSetAttribute((const void*)mk_fwd, hipFuncAttributeMaxDynamicSharedMemorySize, LDS_BYTES);
        if (hipOccupancyMaxActiveBlocksPerMultiprocessor(&per_cu, (const void*)mk_fwd, 512, LDS_BYTES) != hipSuccess || per_cu < 1) { fprintf(stderr, "kernel_launch: occupancy query says %d\n", per_cu); per_cu = 1; }
        (void)hipGetLastError();
        grid = cus * per_cu;
        if (grid > 256) grid = 256;
    }
    if (grid < 0) return;
    Args a{};
    for (int i = 0; i < 18; ++i) a.in[i] = (const float*)d_in[i];
    a.out = (float*)d_out; a.ws = (unsigned char*)d_ws;
    (void)hipMemsetAsync((unsigned char*)d_ws + WS_BAR, 0, 256 * 1024, stream);
#if MK_N_LAUNCHES == 1
    a.ph_lo = 0; a.ph_hi = N_PHASES;
    void* args[] = {&a};
    hipError_t e = hipLaunchCooperativeKernel((const void*)mk_fwd, dim3(grid), dim3(512), args, LDS_BYTES, stream);
    if (e != hipSuccess) fprintf(stderr, "cooperative launch failed: %s (grid %d)\n", hipGetErrorString(e), grid);
#else
    for (int p = 0; p < N_PHASES; ++p) { a.ph_lo = p; a.ph_hi = p + 1; hipLaunchKernelGGL(mk_fwd, dim3(grid), dim3(512), LDS_BYTES, stream, a); }
#endif
}
```

```cpp
#include <hip/hip_runtime.h>
#include <hip/hip_cooperative_groups.h>
#include <cstdio>
#include <cstdint>
namespace cg = cooperative_groups;

#define LAS __attribute__((address_space(3)))
typedef unsigned short bf16_t;
typedef short bf16x8 __attribute__((ext_vector_type(8)));
typedef float f32x4 __attribute__((ext_vector_type(4)));
typedef unsigned u32x4 __attribute__((ext_vector_type(4)));
typedef unsigned u32x2 __attribute__((ext_vector_type(2)));

constexpr int DM = 1024, NB = 16, SEQ = 2048, CTXL = 256, NH = 8, DK = 64, DV = 128, DFF = 4096;
constexpr int MTOK = NB * SEQ;
constexpr int MCTX = NB * CTXL;
constexpr int MALL = MTOK + MCTX;
constexpr int DIN = 8224, NIN = 8448;
constexpr float EPS = 1e-6f;
constexpr int OFF_K = 0, OFF_V = 512, OFF_IG = 1536, OFF_Q = 1568, OFF_O = 2080, OFF_XIN = 3104, OFF_GC = 4128, OFF_GB = 5152, OFF_MRG = 6176;

constexpr size_t MiB = 1u << 20;
constexpr size_t WS_MOD = 0;
constexpr size_t WS_BIASP = 512 * 1024;
constexpr size_t WS_BAR = 768 * 1024;
constexpr size_t WS_MODCNT = 900 * 1024;
constexpr size_t WS_CNT = 800 * 1024;
constexpr size_t WS_XBUF = 450 * MiB;
constexpr size_t WS_WIN = 1 * MiB;
constexpr size_t WS_BT2 = 18 * MiB;
constexpr size_t WS_WO = 22 * MiB;
constexpr size_t WS_W1 = 24 * MiB;
constexpr int F1P = DFF + 64;
constexpr size_t WS_W2 = 452 * MiB;
constexpr size_t WS_H = 40 * MiB;
constexpr size_t WS_K = 112 * MiB;
constexpr size_t WS_VT = 148 * MiB;
constexpr size_t WS_Q = 220 * MiB;
constexpr size_t WS_G = 252 * MiB;
constexpr size_t WS_AB = 258 * MiB;
constexpr size_t WS_HD1 = 386 * MiB;
constexpr size_t WS_F1 = 112 * MiB;
constexpr size_t WS_END = 462 * MiB;

constexpr int LDS_BYTES = 155648;

typedef float f32x2_t __attribute__((ext_vector_type(2))); typedef __bf16 bf16x2_t __attribute__((ext_vector_type(2)));
__device__ __forceinline__ unsigned cvt_pk_bf16(float lo, float hi) { const f32x2_t v = {lo, hi}; const bf16x2_t b = __builtin_convertvector(v, bf16x2_t); return __builtin_bit_cast(unsigned, b); }
__device__ __forceinline__ float bf_lo(unsigned w) { return __uint_as_float(w << 16); }
__device__ __forceinline__ float bf_hi(unsigned w) { return __uint_as_float(w & 0xffff0000u); }
__device__ __forceinline__ float sigm(float x) { return __builtin_amdgcn_rcpf(1.f + __expf(-x)); }
__device__ __forceinline__ float wave_sum(float v) {
#pragma unroll
    for (int o = 1; o < 64; o <<= 1) v += __shfl_xor(v, o);
    return v;
}
__device__ __forceinline__ float wave_max(float v) {
#pragma unroll
    for (int o = 1; o < 64; o <<= 1) v = fmaxf(v, __shfl_xor(v, o));
    return v;
}
template <int CTRL, int RM = 0xf> __device__ __forceinline__ float dppf(float old, float src) {
    return __int_as_float(__builtin_amdgcn_update_dpp(__float_as_int(old), __float_as_int(src), CTRL, RM, 0xf, false));
}
__device__ __forceinline__ float wave_scan_add(float x) {
    x += dppf<0x111>(0.f, x); x += dppf<0x112>(0.f, x); x += dppf<0x114>(0.f, x); x += dppf<0x118>(0.f, x);
    x += dppf<0x142, 0xA>(0.f, x); x += dppf<0x143, 0xC>(0.f, x); return x;
}
__device__ __forceinline__ float wave_scan_max(float x) {
    const float ninf = -INFINITY;
    x = fmaxf(x, dppf<0x111>(ninf, x)); x = fmaxf(x, dppf<0x112>(ninf, x)); x = fmaxf(x, dppf<0x114>(ninf, x)); x = fmaxf(x, dppf<0x118>(ninf, x));
    x = fmaxf(x, dppf<0x142, 0xA>(ninf, x)); x = fmaxf(x, dppf<0x143, 0xC>(ninf, x)); return x;
}
__device__ __forceinline__ float lane63(float x) { return __int_as_float(__builtin_amdgcn_readlane(__float_as_int(x), 63)); }
__device__ __forceinline__ float logsig(float x) { return fminf(x, 0.f) - __logf(1.f + __expf(-fabsf(x))); }

namespace pg8 {
constexpr int BM = 256, BK = 64, HALF = 128, HTB = HALF * BK * 2, STAGE_BYTES = 8 * HTB, NXCD = 8, WGM = 8;
__host__ __device__ __forceinline__ int lds_byte(int r, int c) { const int st = (r >> 4) * 2 + (c >> 5), rr = r & 15, cc = c & 31, ob = rr * 64 + cc * 2; return st * 1024 + (ob ^ (((ob >> 9) & 1) << 5)); }
__host__ __device__ __forceinline__ void stage_rc(int b, int& R, int& C) { const int st = b / 1024, sb = b % 1024, swz = sb ^ (((sb >> 9) & 1) << 5); R = (st >> 1) * 16 + swz / 64; C = (st & 1) * 32 + (swz % 64) / 2; }
__host__ __device__ __forceinline__ int perm32(int rho) { const int n = rho >> 4, i = rho & 15; return 8 * (i >> 2) + 4 * n + (i & 3); }

struct Unit { int pm, pn, sw, h; };
struct Gemm { const bf16_t* A; const bf16_t* Bt; int K, lda, ldb, atile; };

__device__ __forceinline__ void rect_map(int l, int nM, int nN, int& pm, int& pn) {
    const int nig = WGM * nN, gid = l / nig, fm = gid * WGM, gsz = (nM - fm) < WGM ? (nM - fm) : WGM, rem = l % nig;
    pm = fm + rem % gsz; pn = rem / gsz;
}
struct StaticOrder {
    int nM, nN, nwg, G, c, rev = 0;
    __device__ void init(int M, int N, int G_, int c_) { nM = M / BM; nN = N / BM; nwg = nM * nN; G = G_; c = c_; }
    __device__ bool next(int i, Unit& u) const {
        const long L = (long)i * G + c; if (L >= nwg) return false;
        int wgid = (int)L; { const int q = nwg / NXCD, r = nwg % NXCD, xcd = wgid % NXCD, off = wgid / NXCD; wgid = (xcd < r ? xcd * (q + 1) : r * (q + 1) + (xcd - r) * q) + off; }
        rect_map(wgid, nM, nN, u.pm, u.pn); if (rev) u.pm = nM - 1 - u.pm; u.sw = 0; u.h = 0; return true;
    }
};
struct InProjOrder {
    int G, c;
    static constexpr int N_RC = 128 * 26, N_RB = 144 * 4, N_RA = 144 * 3, NWG = N_RC + N_RB + N_RA;
    __device__ bool next(int i, Unit& u) const {
        const long L = (long)i * G + c; if (L >= NWG) return false;
        int w = (int)L; w = (w % NXCD) * (NWG / NXCD) + w / NXCD;
        int a, b; u.h = 0;
        if (w < N_RC) { rect_map(w, 128, 26, a, b); u.pm = a; u.pn = 7 + b; u.sw = 0; }
        else if (w < N_RC + N_RB) { rect_map(w - N_RC, 144, 4, a, b); u.pm = 3 + b; u.pn = a; u.sw = 1; }
        else { rect_map(w - N_RC - N_RB, 144, 3, a, b); u.pm = a; u.pn = b; u.sw = 0; }
        return true;
    }
};
static_assert(InProjOrder::NWG % NXCD == 0, "in-proj unit count");
struct SplitKOrder {
    StaticOrder base;
    __device__ bool next(int i, Unit& u) const { if (!base.next(i >> 1, u)) return false; u.h = i & 1; return true; }
};

template <class Epi, class Sched>
__device__ __forceinline__ void gemm_phase(LAS unsigned char* lds, const Gemm g, const Sched& S, const Epi& E) {
    const int tid = threadIdx.x, wid = __builtin_amdgcn_readfirstlane(tid >> 6), lane = tid & 63, wr = wid >> 2, wc = wid & 3, fr = lane & 15, fq = lane >> 4;
    const int K = g.K, nt = K / BK;
    unsigned voffA[2], voffB[2];
#pragma unroll
    for (int i = 0; i < 2; ++i) { int R, C; stage_rc(tid * 16 + i * 8192, R, C); const int Rb = (R & ~31) + perm32(R & 31);
        voffA[i] = g.atile ? (unsigned)(R * BK + C) * 2u : (unsigned)(R * g.lda + C) * 2u; voffB[i] = (unsigned)(Rb * g.ldb + C) * 2u; }
    const size_t kstep = (size_t)(BK * 2), kstepA = g.atile ? (size_t)HTB : kstep;
    const size_t hstepA = g.atile ? (size_t)(g.lda / BK) * HTB : (size_t)HALF * g.lda * 2, hstepB = (size_t)HALF * g.ldb * 2;
    const unsigned ldsw = (unsigned)wid * 1024u;
    const int aoff = lds_byte(wr * 64 + fr, fq * 8), boff = lds_byte(wc * 32 + fr, fq * 8);
#define PG8_SA(b, h) (((b) * 2 + (h)) * HTB)
#define PG8_SB(b, h) ((4 + (b) * 2 + (h)) * HTB)
#define PG8_STAGE(bufoff, gbase, voff) do { _Pragma("unroll") for (int _i = 0; _i < 2; ++_i) \
        __builtin_amdgcn_global_load_lds((const unsigned*)((const char*)(gbase) + (voff)[_i]), (LAS unsigned*)(lds + (bufoff) + ldsw + _i * 8192), 16, 0, 0); } while (0)
#define PG8_LDA(dst, b, h) do { _Pragma("unroll") for (int m = 0; m < 4; ++m) _Pragma("unroll") for (int k = 0; k < 2; ++k) dst[m][k] = *(const LAS bf16x8*)(lds + PG8_SA(b, h) + aoff + m * 2048 + k * 1024); } while (0)
#define PG8_LDB(dst, b, h) do { _Pragma("unroll") for (int n = 0; n < 2; ++n) _Pragma("unroll") for (int k = 0; k < 2; ++k) dst[n][k] = *(const LAS bf16x8*)(lds + PG8_SB(b, h) + boff + n * 2048 + k * 1024); } while (0)
#define PG8_MMA(ai, bj, At, Bt) do { __builtin_amdgcn_s_setprio(1); _Pragma("unroll") for (int m = 0; m < 4; ++m) _Pragma("unroll") for (int n = 0; n < 2; ++n) _Pragma("unroll") for (int k = 0; k < 2; ++k) \
        acc[ai][bj][m][n] = __builtin_amdgcn_mfma_f32_16x16x32_bf16(Bt[n][k], At[m][k], acc[ai][bj][m][n], 0, 0, 0); __builtin_amdgcn_s_setprio(0); } while (0)
#define PG8_WAIT_V(n) asm volatile("s_waitcnt vmcnt(" #n ")" ::: "memory")
#define PG8_WAIT_L(n) asm volatile("s_waitcnt lgkmcnt(" #n ")" ::: "memory")
#define PG8_BAR __builtin_amdgcn_s_barrier()
#define PG8_SCHED __builtin_amdgcn_sched_barrier(0)
#define PG8_PA(u) ((const char*)((u).sw ? g.Bt : g.A) + (size_t)(u).pm * 2 * hstepA + (size_t)(u).h * K * 2)
#define PG8_PB(u) ((const char*)((u).sw ? g.A : g.Bt) + (size_t)(u).pn * 2 * hstepB + (size_t)(u).h * K * 2)
    Unit cur, nxt; int ui = 0;
    if (!S.next(0, cur)) return;
    f32x4 acc[2][2][4][2];
#pragma unroll
    for (int a = 0; a < 2; ++a)
#pragma unroll
        for (int b = 0; b < 2; ++b)
#pragma unroll
            for (int m = 0; m < 4; ++m)
#pragma unroll
                for (int n = 0; n < 2; ++n) acc[a][b][m][n] = (f32x4){0.f, 0.f, 0.f, 0.f};
    bf16x8 At[4][2], B0[2][2], B1[2][2];
    const char* cA = PG8_PA(cur); const char* cB = PG8_PB(cur);
    PG8_STAGE(PG8_SB(0, 0), cB, voffB); PG8_STAGE(PG8_SB(0, 1), cB + hstepB, voffB); PG8_STAGE(PG8_SA(0, 0), cA, voffA); PG8_STAGE(PG8_SA(0, 1), cA + hstepA, voffA);
    if (wr == 1) PG8_BAR;
    PG8_WAIT_V(2); PG8_BAR;
    PG8_STAGE(PG8_SB(1, 0), cB + kstep, voffB); PG8_STAGE(PG8_SA(1, 0), cA + kstepA, voffA); PG8_STAGE(PG8_SB(1, 1), cB + hstepB + kstep, voffB);
    PG8_WAIT_V(6); PG8_BAR;
    for (;;) {
        const bool has_next = S.next(ui + 1, nxt);
        const char* nA = has_next ? PG8_PA(nxt) : cA; const char* nB = has_next ? PG8_PB(nxt) : cB;
        for (int t = 0; t < nt; t += 2) {
            const bool last = (t == nt - 2);
            const char* a1 = cA + (size_t)(t + 1) * kstepA;
            const char* a2 = last ? nA : cA + (size_t)(t + 2) * kstepA; const char* b2 = last ? nB : cB + (size_t)(t + 2) * kstep;
            const char* a3 = a2 + kstepA; const char* b3 = b2 + kstep;
            PG8_LDB(B0, 0, 0); PG8_LDB(B1, 0, 1); PG8_SCHED; PG8_LDA(At, 0, 0); PG8_STAGE(PG8_SA(1, 1), a1 + hstepA, voffA);
            PG8_WAIT_V(8); PG8_WAIT_L(0); PG8_BAR; PG8_MMA(0, 0, At, B0); PG8_MMA(0, 1, At, B1); PG8_BAR; PG8_SCHED;
            PG8_LDA(At, 0, 1); PG8_STAGE(PG8_SB(0, 0), b2, voffB); PG8_STAGE(PG8_SB(0, 1), b2 + hstepB, voffB); PG8_STAGE(PG8_SA(0, 0), a2, voffA);
            PG8_WAIT_V(8); PG8_WAIT_L(0); PG8_BAR; PG8_MMA(1, 0, At, B0); PG8_MMA(1, 1, At, B1); PG8_BAR; PG8_SCHED;
            PG8_LDB(B0, 1, 0); PG8_LDB(B1, 1, 1); PG8_SCHED; PG8_LDA(At, 1, 0); PG8_STAGE(PG8_SA(0, 1), a2 + hstepA, voffA);
            PG8_WAIT_V(8); PG8_WAIT_L(0); PG8_BAR; PG8_MMA(0, 0, At, B0); PG8_MMA(0, 1, At, B1); PG8_BAR; PG8_SCHED;
            PG8_LDA(At, 1, 1); PG8_STAGE(PG8_SB(1, 0), b3, voffB); PG8_STAGE(PG8_SB(1, 1), b3 + hstepB, voffB); PG8_STAGE(PG8_SA(1, 0), a3, voffA);
            PG8_WAIT_V(8); PG8_WAIT_L(0); PG8_BAR; PG8_MMA(1, 0, At, B0); PG8_MMA(1, 1, At, B1); PG8_BAR; PG8_SCHED;
        }
        if (wr == 0) PG8_BAR;
        bool keep = false;
        if constexpr (Epi::HAS_MID) keep = (cur.h == 0);
        if constexpr (Epi::HAS_MID) { if (keep) E.mid(acc, cur, wr, wc, fr, fq); else E(acc, cur, wr, wc, fr, fq); }
        else E(acc, cur, wr, wc, fr, fq);
        if (!has_next) break;
        if (!keep)
#pragma unroll
        for (int a = 0; a < 2; ++a)
#pragma unroll
            for (int b = 0; b < 2; ++b)
#pragma unroll
                for (int m = 0; m < 4; ++m)
#pragma unroll
                    for (int n = 0; n < 2; ++n) acc[a][b][m][n] = (f32x4){0.f, 0.f, 0.f, 0.f};
        cur = nxt; cA = nA; cB = nB; ++ui;
        if (wr == 1) PG8_BAR;
    }
    PG8_WAIT_V(0);
    PG8_BAR;
#undef PG8_SA
#undef PG8_SB
#undef PG8_STAGE
#undef PG8_LDA
#undef PG8_LDB
#undef PG8_MMA
#undef PG8_WAIT_V
#undef PG8_WAIT_L
#undef PG8_BAR
#undef PG8_SCHED
#undef PG8_PA
#undef PG8_PB
}
}
using pg8::Unit;

typedef f32x4 Acc[2][2][4][2];

__device__ __forceinline__ u32x4 pack8(const f32x4 v0, const f32x4 v1) {
    u32x4 w; w.x = cvt_pk_bf16(v0[0], v0[1]); w.y = cvt_pk_bf16(v0[2], v0[3]); w.z = cvt_pk_bf16(v1[0], v1[1]); w.w = cvt_pk_bf16(v1[2], v1[3]); return w;
}

struct EpiInProj {
    static constexpr bool HAS_MID = false;
    bf16_t* Kb; bf16_t* VTb; bf16_t* Qb; float* Gb; bf16_t* AB; bf16_t* MG; const float* biasp; const float* convw;
    __device__ __forceinline__ void operator()(Acc& acc, const Unit& u, int wr, int wc, int fr, int fq) const {
        if (u.sw) {
            const int r0 = u.pm * 256 + wr * 64 + fr, t0 = u.pn * 256 + wc * 32 + 8 * fq;
#pragma unroll
            for (int ai = 0; ai < 2; ++ai)
#pragma unroll
                for (int m = 0; m < 4; ++m) { const int wrow = r0 + ai * 128 + m * 16; const float bs = biasp[wrow]; bf16_t* rowp = VTb + (size_t)(wrow - 768) * MALL + t0;
#pragma unroll
                    for (int bj = 0; bj < 2; ++bj) *(u32x4*)(rowp + bj * 128) = pack8(acc[ai][bj][m][0] + bs, acc[ai][bj][m][1] + bs); }
            return;
        }
        const int row0 = u.pm * 256 + wr * 64 + fr, pn = u.pn;
        const int cb = pn * 256 + wc * 32 + 8 * fq;
        if (pn == 2) {
            if (wc == 0) {
                const f32x4 b0 = *(const f32x4*)(biasp + cb), b1 = *(const f32x4*)(biasp + cb + 4);
#pragma unroll
                for (int ai = 0; ai < 2; ++ai)
#pragma unroll
                    for (int m = 0; m < 4; ++m) { float* gp = Gb + (size_t)(8 * fq) * MALL + (row0 + ai * 128 + m * 16);
                        f32x4 g0 = acc[ai][0][m][0] + b0, g1 = acc[ai][0][m][1] + b1;
                        if (fq >= 2) {
#pragma unroll
                            for (int j = 0; j < 4; ++j) { g0[j] = logsig(g0[j]); g1[j] = logsig(g1[j]); } }
#pragma unroll
                        for (int j = 0; j < 4; ++j) { gp[(size_t)j * MALL] = g0[j]; gp[(size_t)(4 + j) * MALL] = g1[j]; } }
            }
            return;
        }
        if (pn >= 9 && pn < 25) {
            const int ch = 64 * (pn - 9) + 16 * wc + 4 * fq;
            const f32x4 bX = *(const f32x4*)(biasp + cb), bC = *(const f32x4*)(biasp + cb + 4), bB = *(const f32x4*)(biasp + cb + 128), bO = *(const f32x4*)(biasp + cb + 132);
            const f32x4 w0 = *(const f32x4*)(convw + ch), w1 = *(const f32x4*)(convw + 1024 + ch), w2 = *(const f32x4*)(convw + 2048 + ch);
#pragma unroll
            for (int ai = 0; ai < 2; ++ai) {
                f32x4 uu[4];
#pragma unroll
                for (int m = 0; m < 4; ++m) uu[m] = (acc[ai][0][m][0] + bX) * (acc[ai][0][m][1] + bC);
#pragma unroll
                for (int m = 0; m < 4; ++m) {
                    f32x4 pv, nx;
#pragma unroll
                    for (int j = 0; j < 4; ++j) {
                        const float pold = (m > 0) ? dppf<0x121>(0.f, uu[m > 0 ? m - 1 : 0][j]) : 0.f;
                        pv[j] = dppf<0x111>(pold, uu[m][j]);
                        const float nold = (m < 3) ? dppf<0x12F>(0.f, uu[m < 3 ? m + 1 : 3][j]) : 0.f;
                        nx[j] = dppf<0x101>(nold, uu[m][j]);
                    }
                    const f32x4 cv = w0 * pv + w1 * uu[m] + w2 * nx;
                    const f32x4 aa = (acc[ai][1][m][0] + bB) * cv;
                    f32x4 os = acc[ai][1][m][1] + bO;
#pragma unroll
                    for (int j = 0; j < 4; ++j) os[j] = sigm(os[j]);
                    bf16_t* rp = AB + (size_t)(row0 + ai * 128 + m * 16) * 2048 + ch;
                    u32x2 wa, wo; wa.x = cvt_pk_bf16(aa[0], aa[1]); wa.y = cvt_pk_bf16(aa[2], aa[3]); wo.x = cvt_pk_bf16(os[0], os[1]); wo.y = cvt_pk_bf16(os[2], os[3]);
                    *(u32x2*)rp = wa; *(u32x2*)(rp + 1024) = wo;
                }
            }
            return;
        }
        if (pn >= 25) {
            const int ch = 128 * (pn - 25) + 32 * wc + 8 * fq;
            f32x4 ba[2], bb[2];
#pragma unroll
            for (int n = 0; n < 2; ++n) { ba[n] = *(const f32x4*)(biasp + cb + 4 * n); bb[n] = *(const f32x4*)(biasp + cb + 128 + 4 * n); }
#pragma unroll
            for (int ai = 0; ai < 2; ++ai)
#pragma unroll
                for (int m = 0; m < 4; ++m) { bf16_t* rp = MG + (size_t)(row0 + ai * 128 + m * 16) * 2048 + ch;
                    f32x4 rr[2], gg[2];
#pragma unroll
                    for (int n = 0; n < 2; ++n) { const f32x4 xa = acc[ai][0][m][n] + ba[n], xb = acc[ai][1][m][n] + bb[n];
#pragma unroll
                        for (int j = 0; j < 4; ++j) { const float ea = 1.f + __expf(-xa[j]), eb = 1.f + __expf(-xb[j]); rr[n][j] = eb * __builtin_amdgcn_rcpf(ea); gg[n][j] = __builtin_amdgcn_rcpf(eb); } }
                    *(u32x4*)rp = pack8(rr[0], rr[1]); *(u32x4*)(rp + 1024) = pack8(gg[0], gg[1]); }
            return;
        }
        bf16_t* base; int ldc, col0, mode;
        if (pn < 2) { base = Kb; ldc = 512; col0 = pn * 256; mode = 0; }
        else { base = Qb; ldc = 512; col0 = (pn - 7) * 256; mode = 1; }
        col0 += wc * 32 + 8 * fq;
        f32x4 bv[2][2];
#pragma unroll
        for (int bj = 0; bj < 2; ++bj)
#pragma unroll
            for (int n = 0; n < 2; ++n) bv[bj][n] = *(const f32x4*)(biasp + cb + bj * 128 + 4 * n);
#pragma unroll
        for (int ai = 0; ai < 2; ++ai)
#pragma unroll
            for (int m = 0; m < 4; ++m) { bf16_t* rowp = base + (size_t)(row0 + ai * 128 + m * 16) * ldc + col0;
#pragma unroll
                for (int bj = 0; bj < 2; ++bj) { f32x4 v0 = acc[ai][bj][m][0] + bv[bj][0], v1 = acc[ai][bj][m][1] + bv[bj][1];
                    if (mode == 0) { v0 = v0 * 0.125f; v1 = v1 * 0.125f; }
                    *(u32x4*)(rowp + bj * 128) = pack8(v0, v1); } }
    }
};

struct EpiG2 {
    static constexpr bool HAS_MID = true;
    const bf16_t* MG; bf16_t* MRG;
    __device__ __forceinline__ void mid(Acc& acc, const Unit& u, int wr, int wc, int fr, int fq) const {
        const int row0 = u.pm * 256 + wr * 64 + fr, col0 = u.pn * 256 + wc * 32 + 8 * fq;
#pragma unroll
        for (int ai = 0; ai < 2; ++ai) {
            u32x4 rr[4][2];
#pragma unroll
            for (int m = 0; m < 4; ++m)
#pragma unroll
                for (int bj = 0; bj < 2; ++bj) rr[m][bj] = *(const u32x4*)(MG + (size_t)(row0 + ai * 128 + m * 16) * 2048 + col0 + bj * 128);
#pragma unroll
            for (int m = 0; m < 4; ++m)
#pragma unroll
                for (int bj = 0; bj < 2; ++bj) { const u32x4 q = rr[m][bj];
                    const f32x4 r0 = {bf_lo(q.x), bf_hi(q.x), bf_lo(q.y), bf_hi(q.y)}, r1 = {bf_lo(q.z), bf_hi(q.z), bf_lo(q.w), bf_hi(q.w)};
                    acc[ai][bj][m][0] = acc[ai][bj][m][0] * r0; acc[ai][bj][m][1] = acc[ai][bj][m][1] * r1; }
            asm volatile("" ::: "memory");
        }
    }
    __device__ __forceinline__ void operator()(Acc& acc, const Unit& u, int wr, int wc, int fr, int fq) const {
        const int row0 = u.pm * 256 + wr * 64 + fr, col0 = u.pn * 256 + wc * 32 + 8 * fq;
#pragma unroll
        for (int ai = 0; ai < 2; ++ai) {
            u32x4 gg[4][2];
#pragma unroll
            for (int m = 0; m < 4; ++m)
#pragma unroll
                for (int bj = 0; bj < 2; ++bj) gg[m][bj] = *(const u32x4*)(MG + (size_t)(row0 + ai * 128 + m * 16) * 2048 + col0 + bj * 128 + 1024);
#pragma unroll
            for (int m = 0; m < 4; ++m)
#pragma unroll
                for (int bj = 0; bj < 2; ++bj) { const u32x4 gb = gg[m][bj];
                    const f32x4 g0 = {bf_lo(gb.x), bf_hi(gb.x), bf_lo(gb.y), bf_hi(gb.y)}, g1 = {bf_lo(gb.z), bf_hi(gb.z), bf_lo(gb.w), bf_hi(gb.w)};
                    *(u32x4*)(MRG + (size_t)(row0 + ai * 128 + m * 16) * 1024 + col0 + bj * 128) = pack8(acc[ai][bj][m][0] * g0, acc[ai][bj][m][1] * g1); }
            asm volatile("" ::: "memory");
        }
    }
};
struct EpiRes {
    static constexpr bool HAS_MID = false;
    const float* base; float* out; const float* gate;
    __device__ __forceinline__ void operator()(Acc& acc, const Unit& u, int wr, int wc, int fr, int fq) const {
        const int row0 = u.pm * 256 + wr * 64 + fr, col0 = u.pn * 256 + wc * 32 + 8 * fq;
        const float* gp = gate + (size_t)((u.pm * 256) >> 11) * 6144 + col0;
        f32x4 gv[2][2];
#pragma unroll
        for (int bj = 0; bj < 2; ++bj)
#pragma unroll
            for (int n = 0; n < 2; ++n) gv[bj][n] = *(const f32x4*)(gp + bj * 128 + 4 * n);
#pragma unroll
        for (int ai = 0; ai < 2; ++ai)
#pragma unroll
            for (int m = 0; m < 4; ++m) { const size_t off = (size_t)(row0 + ai * 128 + m * 16) * 1024 + col0;
#pragma unroll
                for (int bj = 0; bj < 2; ++bj)
#pragma unroll
                    for (int n = 0; n < 2; ++n) { const f32x4 bs = *(const f32x4*)(base + off + bj * 128 + 4 * n);
                        *(f32x4*)(out + off + bj * 128 + 4 * n) = bs + gv[bj][n] * acc[ai][bj][m][n]; } }
    }
};
template <int mode> struct EpiResNorm {
    static constexpr bool HAS_MID = false;
    const float* base; float* out; const float* gate; int mode_unused;
    bf16_t* h2; const float* nw; const float* mod;
    bf16_t* x1b;
    float* xbuf; unsigned* cnt; LAS unsigned char* xl;
    __device__ __forceinline__ void operator()(Acc& acc, const Unit& u, int wr, int wc, int fr, int fq) const {
        const int wid = wr * 4 + wc, lane = fq * 16 + fr;
        const int row0 = u.pm * 256 + wr * 64 + fr, col0 = u.pn * 256 + wc * 32 + 8 * fq, bb = (u.pm * 256) >> 11;
        {
            const float* gp = gate + (size_t)bb * 6144 + col0;
            f32x4 gv[2][2];
#pragma unroll
            for (int bj = 0; bj < 2; ++bj)
#pragma unroll
                for (int n = 0; n < 2; ++n) gv[bj][n] = *(const f32x4*)(gp + bj * 128 + 4 * n);
#pragma unroll
            for (int ai = 0; ai < 2; ++ai)
#pragma unroll
                for (int m = 0; m < 4; ++m) { const size_t off = (size_t)(row0 + ai * 128 + m * 16) * 1024 + col0;
#pragma unroll
                    for (int bj = 0; bj < 2; ++bj) {
                        if (mode == 1) { const u32x4 q = *(const u32x4*)(x1b + off + bj * 128);
                            const f32x4 b0 = {bf_lo(q.x), bf_hi(q.x), bf_lo(q.y), bf_hi(q.y)}, b1 = {bf_lo(q.z), bf_hi(q.z), bf_lo(q.w), bf_hi(q.w)};
                            acc[ai][bj][m][0] = b0 + gv[bj][0] * acc[ai][bj][m][0]; acc[ai][bj][m][1] = b1 + gv[bj][1] * acc[ai][bj][m][1]; }
                        else {
#pragma unroll
                            for (int n = 0; n < 2; ++n) { const f32x4 bs = *(const f32x4*)(base + off + bj * 128 + 4 * n); acc[ai][bj][m][n] = bs + gv[bj][n] * acc[ai][bj][m][n]; } }
                    }
                    asm volatile("" : "+v"(acc[ai][0][m][0]), "+v"(acc[ai][0][m][1]), "+v"(acc[ai][1][m][0]), "+v"(acc[ai][1][m][1]));
                    if (m & 1) asm volatile("" ::: "memory"); }
        }
        LAS float* P = (LAS float*)xl; LAS float* S = (LAS float*)(xl + 4096);
#pragma unroll
        for (int ai = 0; ai < 2; ++ai)
#pragma unroll
            for (int m = 0; m < 4; ++m) { float q = 0.f;
#pragma unroll
                for (int bj = 0; bj < 2; ++bj)
#pragma unroll
                    for (int n = 0; n < 2; ++n) { const f32x4 x = acc[ai][bj][m][n]; q += (x[0] * x[0] + x[1] * x[1]) + (x[2] * x[2] + x[3] * x[3]); }
                q += __shfl_xor(q, 16); q += __shfl_xor(q, 32);
                if (fq == 0) P[(ai * 128 + wr * 64 + m * 16 + fr) * 4 + wc] = q; }
        asm volatile("s_waitcnt lgkmcnt(0)\n\ts_barrier" ::: "memory");
        const int row = wid * 32 + (lane & 31);
        if (lane < 32) { const float tot = (P[row * 4 + 0] + P[row * 4 + 1]) + (P[row * 4 + 2] + P[row * 4 + 3]);
            __hip_atomic_store(xbuf + (size_t)(u.pm * 256 + row) * 4 + u.pn, tot, __ATOMIC_RELAXED, __HIP_MEMORY_SCOPE_AGENT); }
        asm volatile("s_waitcnt vmcnt(0)" ::: "memory");
        if (lane == 0) __hip_atomic_fetch_add(cnt + 64 * u.pm, 1u, __ATOMIC_RELAXED, __HIP_MEMORY_SCOPE_AGENT);
        if (wid == 0) {
            unsigned sp = 0;
            while ((unsigned)__builtin_amdgcn_readfirstlane(__hip_atomic_load(cnt + 64 * u.pm, __ATOMIC_RELAXED, __HIP_MEMORY_SCOPE_AGENT)) < 32u) { __builtin_amdgcn_s_sleep(2); if (++sp > (1u << 20)) break; }
            __builtin_amdgcn_fence(__ATOMIC_ACQUIRE, "agent");
        }
        asm volatile("s_waitcnt vmcnt(0) lgkmcnt(0)\n\ts_barrier" ::: "memory");
        if (lane < 32) { const float* sl = xbuf + (size_t)(u.pm * 256 + row) * 4; float t = 0.f;
#pragma unroll
            for (int k = 0; k < 4; ++k) t += __hip_atomic_load(sl + k, __ATOMIC_RELAXED, __HIP_MEMORY_SCOPE_AGENT);
            S[row] = rsqrtf(t * (1.f / 1024.f) + EPS); }
        asm volatile("s_waitcnt vmcnt(0) lgkmcnt(0)\n\ts_barrier" ::: "memory");
#pragma unroll
        for (int bj = 0; bj < 2; ++bj) {
            const int c = col0 + bj * 128;
            f32x4 w0 = *(const f32x4*)(nw + c), w1 = *(const f32x4*)(nw + c + 4), h0 = (f32x4){0.f, 0.f, 0.f, 0.f}, h1 = h0;
            if (mode == 0) { const float* mb = mod + (size_t)bb * 6144 + c; w0 = w0 * (*(const f32x4*)(mb + 4096) + 1.f); w1 = w1 * (*(const f32x4*)(mb + 4100) + 1.f); h0 = *(const f32x4*)(mb + 3072); h1 = *(const f32x4*)(mb + 3076); }
#pragma unroll
            for (int ai = 0; ai < 2; ++ai)
#pragma unroll
                for (int m = 0; m < 4; ++m) { asm volatile("" ::: "memory"); const int rl = ai * 128 + wr * 64 + m * 16 + fr; const float r = S[rl]; const size_t off = (size_t)(u.pm * 256 + rl) * 1024 + c;
                    const f32x4 v0 = acc[ai][bj][m][0], v1 = acc[ai][bj][m][1];
                    if (mode == 0) { *(u32x4*)(x1b + off) = pack8(v0, v1); *(u32x4*)(h2 + off) = pack8((v0 * r) * w0 + h0, (v1 * r) * w1 + h1); }
                    else { *(f32x4*)(out + off) = (v0 * r) * w0; *(f32x4*)(out + off + 4) = (v1 * r) * w1; } }
        }
    }
};
struct EpiRelu2 {
    static constexpr bool HAS_MID = false;
    bf16_t* O; int ldc;
    __device__ __forceinline__ void operator()(Acc& acc, const Unit& u, int wr, int wc, int fr, int fq) const {
        const int row0 = u.pm * 256 + wr * 64 + fr, col0 = u.pn * 256 + wc * 32 + 8 * fq;
#pragma unroll
        for (int ai = 0; ai < 2; ++ai)
#pragma unroll
            for (int m = 0; m < 4; ++m) { const int row = row0 + ai * 128 + m * 16;
#pragma unroll
                for (int bj = 0; bj < 2; ++bj) { f32x4 v0 = acc[ai][bj][m][0], v1 = acc[ai][bj][m][1]; const int col = col0 + bj * 128;
                    bf16_t* rowp = O + ((size_t)(row >> 7) * (ldc >> 6) + (col >> 6)) * 8192 + (row & 127) * 64 + (col & 63) - bj * 128;
#pragma unroll
                    for (int j = 0; j < 4; ++j) { const float a = fmaxf(v0[j], 0.f), b = fmaxf(v1[j], 0.f); v0[j] = a * a; v1[j] = b * b; }
                    __builtin_nontemporal_store(pack8(v0, v1), (u32x4*)(rowp + bj * 128)); } }
    }
};

__device__ __forceinline__ int inproj_colmap(int n) {
    if (n < 512) return OFF_K + n;
    if (n < 768) { const int j = n - 512; return j < 32 ? OFF_IG + j : -1; }
    if (n < 1792) return OFF_V + (n - 768);
    if (n < 2304) return OFF_Q + (n - 1792);
    if (n < 6400) { const int lc = (n - 2304) & 255, jt = (n - 2304) >> 8, bj = lc >> 7, wc = (lc >> 5) & 3, fq = (lc >> 3) & 3, nn = (lc >> 2) & 1, jj = lc & 3;
        const int seg = 2 * bj + nn, ch = 64 * jt + 16 * wc + 4 * fq + jj;
        return (seg == 0 ? OFF_XIN : seg == 1 ? OFF_GC : seg == 2 ? OFF_GB : OFF_O) + ch; }
    { const int lc = (n - 6400) & 255, jt = (n - 6400) >> 8; return OFF_MRG + (lc >> 7) * 1024 + 128 * jt + (lc & 127); }
}
struct TrItem { const float* W; bf16_t* out; int ldw, nblk, ldo, kofs, item, map; };
__device__ __forceinline__ void tr_load(const TrItem& t, int lane, f32x4 (&v)[8]) {
    const int kb = t.item / t.nblk, nb = t.item % t.nblk, k0 = 64 * kb, n0 = 32 * nb;
    const int n4 = lane & 7, kr = lane >> 3;
    const int nn = n0 + 4 * n4; const int src = t.map ? inproj_colmap(nn) : nn;
#pragma unroll
    for (int it = 0; it < 8; ++it) v[it] = (src >= 0) ? *(const f32x4*)(t.W + (size_t)(k0 + 8 * it + kr) * t.ldw + src) : (f32x4){0.f, 0.f, 0.f, 0.f};
}
__device__ __forceinline__ void tr_finish(const TrItem& t, int lane, const f32x4 (&v)[8], LAS float* scr) {
    const int kb = t.item / t.nblk, nb = t.item % t.nblk, k0 = 64 * kb, n0 = 32 * nb;
    const int n4 = lane & 7, kr = lane >> 3;
#pragma unroll
    for (int it = 0; it < 8; ++it) { LAS float* d = scr + (8 * it + kr) * 33 + 4 * n4; d[0] = v[it][0]; d[1] = v[it][1]; d[2] = v[it][2]; d[3] = v[it][3]; }
    asm volatile("s_waitcnt lgkmcnt(0)" ::: "memory");
    const int c = lane & 7;
#pragma unroll
    for (int j = 0; j < 4; ++j) { const int n = (lane >> 3) + 8 * j; const LAS float* s = scr + (8 * c) * 33 + n;
        u32x4 o; o.x = cvt_pk_bf16(s[0 * 33], s[1 * 33]); o.y = cvt_pk_bf16(s[2 * 33], s[3 * 33]); o.z = cvt_pk_bf16(s[4 * 33], s[5 * 33]); o.w = cvt_pk_bf16(s[6 * 33], s[7 * 33]);
        *(u32x4*)(t.out + (size_t)(n0 + n) * t.ldo + t.kofs + k0 + 8 * c) = o; }
    asm volatile("s_waitcnt lgkmcnt(0)" ::: "memory");
}

struct Args { const float* in[18]; float* out; unsigned char* ws; int ph_lo, ph_hi; };
enum { I_X = 0, I_C, I_CTX, I_CCTX, I_WMOD, I_BMOD, I_N1W, I_WIN, I_BIN, I_CONVW, I_MNW, I_WCO, I_WMO, I_WOUT, I_N2W, I_WFF1, I_WFF2, I_FNW };

__device__ __forceinline__ void p0_mod(const Args& A, LAS unsigned char* lds, int tid, int lane, int wave, unsigned* modcnt) {
    unsigned char* ws = A.ws;
    LAS float* sl = (LAS float*)lds;
    LAS float* red = (LAS float*)(lds + 17 * 4096);
    bool filled = false; unsigned done = 0;
    for (int item = blockIdx.x; item < 6144 / 32; item += gridDim.x) {
        if (!filled) {
            float cv[34];
#pragma unroll
            for (int j = 0; j < 34; ++j) { const int i = tid + 512 * j; cv[j] = i < 16 * 1024 ? A.in[I_C][i] : A.in[I_CCTX][i - 16 * 1024]; }
#pragma unroll
            for (int j = 0; j < 34; ++j) sl[tid + 512 * j] = cv[j] * sigm(cv[j]);
            __syncthreads(); filled = true;
        }
        const int col = lane & 31, kh = lane >> 5, n0 = item * 32, kbase = 128 * wave + 64 * kh;
        float a[17];
#pragma unroll
        for (int r = 0; r < 17; ++r) a[r] = 0.f;
        const float* wp = A.in[I_WMOD] + (size_t)kbase * 6144 + n0 + col;
        float wv[64];
#pragma unroll
        for (int j = 0; j < 64; ++j) wv[j] = wp[(size_t)j * 6144];
#pragma unroll
        for (int i = 0; i < 64; i += 8) {
#pragma unroll
            for (int r = 0; r < 17; ++r) { const f32x4 s4 = *(const LAS f32x4*)(sl + r * 1024 + kbase + i), s5 = *(const LAS f32x4*)(sl + r * 1024 + kbase + i + 4);
                a[r] += (s4[0] * wv[i + 0] + s4[1] * wv[i + 1]) + (s4[2] * wv[i + 2] + s4[3] * wv[i + 3]) + (s5[0] * wv[i + 4] + s5[1] * wv[i + 5]) + (s5[2] * wv[i + 6] + s5[3] * wv[i + 7]); }
        }
#pragma unroll
        for (int r = 0; r < 17; ++r) red[((wave * 2 + kh) * 17 + r) * 32 + col] = a[r];
        __syncthreads();
        for (int o = tid; o < 17 * 32; o += 512) { const int r = o >> 5, cc = o & 31; float s = A.in[I_BMOD][n0 + cc];
#pragma unroll
            for (int p = 0; p < 16; ++p) s += red[(p * 17 + r) * 32 + cc];
            ((float*)(ws + WS_MOD))[r * 6144 + n0 + cc] = s; }
        asm volatile("s_waitcnt vmcnt(0)" ::: "memory");
        __syncthreads();
        ++done;
    }
    if (done && tid == 0) { __builtin_amdgcn_fence(__ATOMIC_RELEASE, "agent"); asm volatile("s_waitcnt vmcnt(0)" ::: "memory"); __hip_atomic_fetch_add(modcnt, done, __ATOMIC_RELAXED, __HIP_MEMORY_SCOPE_AGENT); }
}
__device__ __forceinline__ void p0_weights(const Args& A, LAS unsigned char* lds, int tid, int lane, int wave) {
    unsigned char* ws = A.ws;
    LAS float* scr = (LAS float*)(lds + wave * 16384);
    const int gw = blockIdx.x * 8 + wave, NGW = gridDim.x * 8;
    constexpr int IT_WIN = 16 * (NIN / 32), IT_SQ = 16 * 32, IT_W1 = 16 * 128, IT_W2 = 64 * 32;
    constexpr int NITEMS = IT_WIN + 3 * IT_SQ + IT_W1 + IT_W2;
    auto mk = [&](int it) -> TrItem {
        int r = it;
        if (r < IT_WIN) return TrItem{A.in[I_WIN], (bf16_t*)(ws + WS_WIN), DIN, NIN / 32, 1024, 0, r, 1}; r -= IT_WIN;
        if (r < IT_SQ) return TrItem{A.in[I_WCO], (bf16_t*)(ws + WS_BT2), 1024, 32, 2048, 0, r, 0}; r -= IT_SQ;
        if (r < IT_SQ) return TrItem{A.in[I_WMO], (bf16_t*)(ws + WS_BT2), 1024, 32, 2048, 1024, r, 0}; r -= IT_SQ;
        if (r < IT_SQ) return TrItem{A.in[I_WOUT], (bf16_t*)(ws + WS_WO), 1024, 32, 1024, 0, r, 0}; r -= IT_SQ;
        if (r < IT_W1) return TrItem{A.in[I_WFF1], (bf16_t*)(ws + WS_W1), 4096, 128, 1024, 0, r, 0}; r -= IT_W1;
        return TrItem{A.in[I_WFF2], (bf16_t*)(ws + WS_W2), 1024, 32, F1P, 0, r, 0};
    };
    if (gw < NITEMS) {
        f32x4 va[8], vb[8];
        TrItem cur = mk(gw); tr_load(cur, lane, va);
        for (int it = gw; it < NITEMS; it += 2 * NGW) {
            const bool h1 = it + NGW < NITEMS, h2 = it + 2 * NGW < NITEMS;
            TrItem nx = cur; if (h1) { nx = mk(it + NGW); tr_load(nx, lane, vb); }
            tr_finish(cur, lane, va, scr);
            if (!h1) break;
            if (h2) { cur = mk(it + 2 * NGW); tr_load(cur, lane, va); }
            tr_finish(nx, lane, vb, scr);
        }
    }
    for (int i = blockIdx.x * 512 + tid; i < NIN; i += gridDim.x * 512) { const int s = inproj_colmap(i); ((float*)(ws + WS_BIASP))[i] = s >= 0 ? A.in[I_BIN][s] : 0.f; }
}

__device__ __forceinline__ float wave_allsum(float x) { return lane63(wave_scan_add(x)); }
__device__ __forceinline__ void modulate_rows4(const float* xrow, const float* w, const float* sh, const float* sc, bf16_t* orow, int lane) {
    f32x4 v[4][4]; float r[4];
#pragma unroll
    for (int q = 0; q < 4; ++q)
#pragma unroll
        for (int j = 0; j < 4; ++j) v[q][j] = ((const f32x4*)(xrow + (size_t)q * DM))[lane + 64 * j];
#pragma unroll
    for (int q = 0; q < 4; ++q) { float s = 0.f;
#pragma unroll
        for (int j = 0; j < 4; ++j) s += (v[q][j].x * v[q][j].x + v[q][j].y * v[q][j].y) + (v[q][j].z * v[q][j].z + v[q][j].w * v[q][j].w);
        r[q] = rsqrtf(wave_allsum(s) * (1.f / DM) + EPS); }
#pragma unroll
    for (int j = 0; j < 4; ++j) { const f32x4 ww = ((const f32x4*)w)[lane + 64 * j], hh = ((const f32x4*)sh)[lane + 64 * j], cc = ((const f32x4*)sc)[lane + 64 * j];
        const f32x4 wc = ww * (cc + 1.f);
#pragma unroll
        for (int q = 0; q < 4; ++q) { const f32x4 y = (v[q][j] * r[q]) * wc + hh;
            u32x2 p; p.x = cvt_pk_bf16(y[0], y[1]); p.y = cvt_pk_bf16(y[2], y[3]); ((u32x2*)(orow + (size_t)q * DM))[lane + 64 * j] = p; } }
}

constexpr int L_QS = 0, L_KS = 18432, L_KTS = 36864, L_VTS = 54272, L_SS = 93440, L_CS = 128256, L_GW = 148992;
static_assert(L_GW + 8 * 512 <= LDS_BYTES, "mlstm LDS map");
#define BAR_LDS() asm volatile("s_waitcnt lgkmcnt(0)\n\ts_barrier" ::: "memory")

__device__ __forceinline__ void mlstm_seq(LAS unsigned char* lds, const bf16_t* Kb, const bf16_t* VTb, const bf16_t* Qb, const float* Gb, bf16_t* HD0, bf16_t* HD1, int seq, int tid, int lane, int w) {
    const int dir = seq >> 7, b = (seq >> 3) & 15, head = seq & 7;
    const int g = lane >> 4, l15 = lane & 15;
    bf16_t* HD = dir ? HD1 : HD0;
    for (int i = tid; i < 16 * 136; i += 512) { const int r = i / 136, cidx = i % 136; *(LAS bf16_t*)(lds + L_VTS + (128 + r) * 272 + cidx * 2) = (r == 0) ? (bf16_t)0x3F80 : (bf16_t)0; }
    const int tb = (w < 4) ? 2 * w : 15 - 2 * w;
    const int nvb = tb <= 2 ? 2 : (tb <= 5 ? 1 : 0), vst = tb <= 2 ? 2 * tb : tb + 3;
    f32x4 st[2][4];
#pragma unroll
    for (int i = 0; i < 2; ++i)
#pragma unroll
        for (int j = 0; j < 4; ++j) st[i][j] = (f32x4){0.f, 0.f, 0.f, 0.f};
    float mstate = 0.f;
    u32x4 pq[2], pk[2], pv[4]; float gi0, gi1, gf0, gf1;
    unsigned offq[2], offv[4], offg0, offg1;
#pragma unroll
    for (int i = 0; i < 2; ++i) { const int p = tid + 512 * i, row = p >> 3, pc = p & 7; offq[i] = (unsigned)((dir ? 127 - row : row) * 512 + head * 64 + pc * 8); }
#pragma unroll
    for (int i = 0; i < 4; ++i) { const int p = tid + 512 * i, v = p >> 4, pc = p & 15; offv[i] = (unsigned)((head * 128 + v) * MALL + pc * 8); }
    offg0 = (unsigned)((dir * 8 + head) * MALL + (dir ? 127 - lane : lane)); offg1 = (unsigned)((dir * 8 + head) * MALL + (dir ? 63 - lane : lane + 64));
#define PREFETCH(cc) do { const int cc_ = (cc); const bool isctx_ = cc_ < 2; const int T_ = isctx_ ? CTXL : SEQ, c_ = isctx_ ? cc_ : cc_ - 2; \
        const int base_ = isctx_ ? MTOK + b * CTXL : b * SEQ; const int tok0_ = base_ + (dir ? T_ - 128 * (c_ + 1) : 128 * c_); \
        const bf16_t* qb_ = Qb + (size_t)tok0_ * 512; const bf16_t* kb_ = Kb + (size_t)tok0_ * 512; const bf16_t* vb_ = VTb + tok0_; const float* gb_ = Gb + tok0_; \
        if (!isctx_) { _Pragma("unroll") for (int i = 0; i < 2; ++i) pq[i] = *(const u32x4*)(qb_ + offq[i]); } \
        _Pragma("unroll") for (int i = 0; i < 2; ++i) pk[i] = *(const u32x4*)(kb_ + offq[i]); \
        _Pragma("unroll") for (int i = 0; i < 4; ++i) pv[i] = *(const u32x4*)(vb_ + offv[i]); \
        gi0 = gb_[offg0]; gf0 = gb_[offg0 + 16 * MALL]; gi1 = gb_[offg1]; gf1 = gb_[offg1 + 16 * MALL]; \
    } while (0)
    PREFETCH(0);
    for (int cc = 0; cc < 18; ++cc) {
        const bool isctx = cc < 2; const int T_ = isctx ? CTXL : SEQ, c_ = isctx ? cc : cc - 2;
        const int tok0 = (isctx ? MTOK + b * CTXL : b * SEQ) + (dir ? T_ - 128 * (c_ + 1) : 128 * c_);
        const float b0 = wave_scan_add(gf0), b1 = wave_scan_add(gf1) + lane63(b0);
        const float a0 = gi0 - b0, a1 = gi1 - b1;
        const float Mc = fmaxf(mstate, lane63(wave_scan_max(fmaxf(a0, a1))));
        const float e0 = __expf(a0 - Mc), e1 = __expf(a1 - Mc), th0 = __expf(-b0 - Mc), th1 = __expf(-b1 - Mc);
        const float decay = __expf(mstate - Mc);
        mstate = lane63(b1) + Mc;
#pragma unroll
        for (int sl = 0; sl < 2; ++sl) if (sl < nvb) {
#pragma unroll
            for (int db = 0; db < 4; ++db) { st[sl][db] = st[sl][db] * decay; u32x2 p; p.x = cvt_pk_bf16(st[sl][db][0], st[sl][db][1]); p.y = cvt_pk_bf16(st[sl][db][2], st[sl][db][3]);
                *(LAS u32x2*)(lds + L_CS + (16 * (vst + sl) + l15) * 144 + (16 * db + 4 * g) * 2) = p; } }
        if (!isctx) {
#pragma unroll
            for (int i = 0; i < 2; ++i) { const int p = tid + 512 * i, row = p >> 3, pc = p & 7; *(LAS u32x4*)(lds + L_QS + row * 144 + pc * 16) = pq[i]; }
        }
        {
#pragma unroll
            for (int i = 0; i < 2; ++i) { const int p = tid + 512 * i, row = p >> 3, pc = p & 7, kidx = dir ? 127 - row : row;
                const float es = __shfl(i ? e1 : e0, 8 * w + (lane >> 3));
                const int kcol = (((kidx >> 3) ^ pc) << 3) | (kidx & 7);
                const unsigned ww[4] = {pk[i].x, pk[i].y, pk[i].z, pk[i].w}; unsigned sc4[4];
#pragma unroll
                for (int q2 = 0; q2 < 4; ++q2) { const unsigned pkd = cvt_pk_bf16(bf_lo(ww[q2]) * es, bf_hi(ww[q2]) * es); sc4[q2] = pkd;
                    *(LAS bf16_t*)(lds + L_KTS + (pc * 8 + 2 * q2) * 272 + kcol * 2) = (bf16_t)(pkd & 0xffffu);
                    *(LAS bf16_t*)(lds + L_KTS + (pc * 8 + 2 * q2 + 1) * 272 + kcol * 2) = (bf16_t)(pkd >> 16); }
                *(LAS u32x4*)(lds + L_KS + row * 144 + pc * 16) = (u32x4){sc4[0], sc4[1], sc4[2], sc4[3]}; }
#pragma unroll
            for (int i = 0; i < 4; ++i) { const int p = tid + 512 * i, v = p >> 4, pc = p & 15;
                const int rho = (v & ~31) | (((v >> 2) & 1) << 4) | (((v >> 3) & 3) << 2) | (v & 3);
                *(LAS u32x4*)(lds + L_VTS + rho * 272 + pc * 16) = pv[i]; }
        }
        BAR_LDS();
        if (cc + 1 < 18) PREFETCH(cc + 1);
        if (!isctx) {
            const int trow = 16 * tb + l15;
            const int klo = dir ? ((7 - tb) >> 1) : 0, khi = dir ? 3 : (tb >> 1);
            bf16x8 qf[2];
#pragma unroll
            for (int kk = 0; kk < 2; ++kk) qf[kk] = *(const LAS bf16x8*)(lds + L_QS + trow * 144 + (kk * 32 + g * 8) * 2);
#pragma unroll
            for (int sb = 0; sb < 8; ++sb) {
                f32x4 sa = (f32x4){0.f, 0.f, 0.f, 0.f};
                if (sb <= tb) {
#pragma unroll
                    for (int kk = 0; kk < 2; ++kk) { const bf16x8 kf = *(const LAS bf16x8*)(lds + L_KS + (16 * sb + l15) * 144 + (kk * 32 + g * 8) * 2);
                        sa = __builtin_amdgcn_mfma_f32_16x16x32_bf16(kf, qf[kk], sa, 0, 0, 0); }
                    if (sb == tb) { const int s0 = 16 * sb + 4 * g;
#pragma unroll
                        for (int r = 0; r < 4; ++r) sa[r] = (s0 + r <= trow) ? sa[r] : 0.f; }
                }
                const int s0 = 16 * sb + 4 * g;
                u32x2 p;
                if (dir) { p.x = cvt_pk_bf16(sa[3], sa[2]); p.y = cvt_pk_bf16(sa[1], sa[0]); *(LAS u32x2*)(lds + L_SS + trow * 272 + (124 - s0) * 2) = p; }
                else { p.x = cvt_pk_bf16(sa[0], sa[1]); p.y = cvt_pk_bf16(sa[2], sa[3]); *(LAS u32x2*)(lds + L_SS + trow * 272 + s0 * 2) = p; }
            }
            f32x4 num[9];
#pragma unroll
            for (int vb = 0; vb < 9; ++vb) { num[vb] = (f32x4){0.f, 0.f, 0.f, 0.f};
#pragma unroll
                for (int kk = 0; kk < 2; ++kk) { const bf16x8 cf = *(const LAS bf16x8*)(lds + L_CS + (16 * vb + l15) * 144 + (kk * 32 + g * 8) * 2);
                    num[vb] = __builtin_amdgcn_mfma_f32_16x16x32_bf16(cf, qf[kk], num[vb], 0, 0, 0); } }
#pragma unroll
            for (int kk = 0; kk < 4; ++kk) {
                if (kk >= klo && kk <= khi) {
                    const bf16x8 sf = *(const LAS bf16x8*)(lds + L_SS + trow * 272 + (kk * 32 + g * 8) * 2);
#pragma unroll
                    for (int vb = 0; vb < 9; ++vb) { const bf16x8 vf = *(const LAS bf16x8*)(lds + L_VTS + (16 * vb + l15) * 272 + (kk * 32 + g * 8) * 2);
                        num[vb] = __builtin_amdgcn_mfma_f32_16x16x32_bf16(vf, sf, num[vb], 0, 0, 0); }
                }
            }
            const float den = __shfl(num[8][0], l15);
            const float thr = __shfl((tb < 4) ? th0 : th1, (16 * tb + l15) & 63);
            const float inv = 1.f / fmaxf(fabsf(den), thr);
            const int tok = tok0 + (dir ? 127 - trow : trow);
            bf16_t* hp = HD + (size_t)tok * 1024 + head * 128 + 8 * g;
#pragma unroll
            for (int vp = 0; vp < 4; ++vp) { u32x4 p; p.x = cvt_pk_bf16(num[2 * vp][0] * inv, num[2 * vp][1] * inv); p.y = cvt_pk_bf16(num[2 * vp][2] * inv, num[2 * vp][3] * inv);
                p.z = cvt_pk_bf16(num[2 * vp + 1][0] * inv, num[2 * vp + 1][1] * inv); p.w = cvt_pk_bf16(num[2 * vp + 1][2] * inv, num[2 * vp + 1][3] * inv); *(u32x4*)(hp + 32 * vp) = p; }
        }
        if (nvb > 0) {
            bf16x8 vf0[4], vf1[4];
#pragma unroll
            for (int kk = 0; kk < 4; ++kk) { vf0[kk] = *(const LAS bf16x8*)(lds + L_VTS + (16 * vst + l15) * 272 + (kk * 32 + g * 8) * 2);
                vf1[kk] = *(const LAS bf16x8*)(lds + L_VTS + (16 * (vst + nvb - 1) + l15) * 272 + (kk * 32 + g * 8) * 2); }
            if (nvb == 2) {
#pragma unroll
                for (int db = 0; db < 4; ++db)
#pragma unroll
                    for (int kk = 0; kk < 4; ++kk) { const bf16x8 kf = *(const LAS bf16x8*)(lds + L_KTS + (16 * db + l15) * 272 + (((4 * kk + g) ^ ((2 * db + (l15 >> 3)) & 7)) << 4));
                        st[0][db] = __builtin_amdgcn_mfma_f32_16x16x32_bf16(kf, vf0[kk], st[0][db], 0, 0, 0);
                        st[1][db] = __builtin_amdgcn_mfma_f32_16x16x32_bf16(kf, vf1[kk], st[1][db], 0, 0, 0); }
            } else {
#pragma unroll
                for (int db = 0; db < 4; ++db)
#pragma unroll
                    for (int kk = 0; kk < 4; ++kk) { const bf16x8 kf = *(const LAS bf16x8*)(lds + L_KTS + (16 * db + l15) * 272 + (((4 * kk + g) ^ ((2 * db + (l15 >> 3)) & 7)) << 4));
                        st[0][db] = __builtin_amdgcn_mfma_f32_16x16x32_bf16(kf, vf0[kk], st[0][db], 0, 0, 0); }
            }
        }
        BAR_LDS();
    }
#undef PREFETCH
}

__device__ __forceinline__ void combine_rows4(const bf16_t* h0, const bf16_t* h1, bf16_t* ab, const float* nw, int lane) {
    u32x4 a[4][2], b[4][2], o[4][2];
#pragma unroll
    for (int q = 0; q < 4; ++q)
#pragma unroll
        for (int i = 0; i < 2; ++i) { const int p = lane + 64 * i;
            a[q][i] = *(const u32x4*)(h0 + (size_t)q * 1024 + 8 * p); b[q][i] = *(const u32x4*)(h1 + (size_t)q * 1024 + 8 * p); o[q][i] = *(const u32x4*)(ab + (size_t)q * 2048 + 8 * p); }
#pragma unroll
    for (int i = 0; i < 2; ++i) { const int p = lane + 64 * i;
        const f32x4 n0 = *(const f32x4*)(nw + 8 * p), n1 = *(const f32x4*)(nw + 8 * p + 4);
#pragma unroll
        for (int q = 0; q < 4; ++q) { const u32x4 aa = a[q][i], bb = b[q][i], oo = o[q][i];
            float s[8] = {bf_lo(aa.x) + bf_lo(bb.x), bf_hi(aa.x) + bf_hi(bb.x), bf_lo(aa.y) + bf_lo(bb.y), bf_hi(aa.y) + bf_hi(bb.y), bf_lo(aa.z) + bf_lo(bb.z), bf_hi(aa.z) + bf_hi(bb.z), bf_lo(aa.w) + bf_lo(bb.w), bf_hi(aa.w) + bf_hi(bb.w)};
            float ss = 0.f;
#pragma unroll
            for (int j = 0; j < 8; ++j) ss += s[j] * s[j];
            ss += dppf<0x121>(0.f, ss); ss += dppf<0x122>(0.f, ss); ss += dppf<0x124>(0.f, ss); ss += dppf<0x128>(0.f, ss);
            const float r = rsqrtf(ss * (1.f / 128.f) + EPS);
            const float og[8] = {bf_lo(oo.x), bf_hi(oo.x), bf_lo(oo.y), bf_hi(oo.y), bf_lo(oo.z), bf_hi(oo.z), bf_lo(oo.w), bf_hi(oo.w)};
            u32x4 qv;
            qv.x = cvt_pk_bf16(s[0] * r * n0[0] * og[0], s[1] * r * n0[1] * og[1]); qv.y = cvt_pk_bf16(s[2] * r * n0[2] * og[2], s[3] * r * n0[3] * og[3]);
            qv.z = cvt_pk_bf16(s[4] * r * n1[0] * og[4], s[5] * r * n1[1] * og[5]); qv.w = cvt_pk_bf16(s[6] * r * n1[2] * og[6], s[7] * r * n1[3] * og[7]);
            *(u32x4*)(ab + (size_t)q * 2048 + 8 * p) = qv; } }
}

#define XB_TMO      128
#define XB_XCNT(j)  (256  + 64 * (j))
#define XB_XSUB(j)  (1280 + 64 * (j))
#define XB_XGEN(j)  (2304 + 64 * (j))
#define XB_TOP      3328
#define XB_TOPGEN   3392
#define XCD_BAR_WORDS 3456
#define XB_SPIN_CAP (1u << 18)
__device__ __forceinline__ unsigned xb_ld(unsigned* p)              { return __hip_atomic_load(p, __ATOMIC_RELAXED, __HIP_MEMORY_SCOPE_AGENT); }
__device__ __forceinline__ unsigned xb_add(unsigned* p, unsigned v) { return __hip_atomic_fetch_add(p, v, __ATOMIC_RELAXED, __HIP_MEMORY_SCOPE_AGENT); }
__device__ __forceinline__ unsigned xb_xcc_id() { return (unsigned)__builtin_amdgcn_s_getreg((3 << 11) | 20) & 0xFu; }
#define XB_SPIN(cond, bar) do { unsigned _sp = 0; while (cond) { __builtin_amdgcn_s_sleep(1); \
    if ((++_sp & 255u) == 0u) { if (xb_ld(&(bar)[XB_TMO])) break; if (_sp > XB_SPIN_CAP) { atomicAdd(&(bar)[XB_TMO], 1u); break; } } } } while (0)
struct XcdBarrier { unsigned* bar; unsigned x; volatile LAS unsigned* st; };
__device__ __forceinline__ XcdBarrier xcd_barrier_post(unsigned* bar, volatile LAS unsigned* st) {
    XcdBarrier b; b.bar = bar; b.x = xb_xcc_id(); b.st = st;
    if (threadIdx.x == 0) (void)xb_add(&bar[XB_XCNT(b.x)], 1u);
    return b;
}
__device__ __forceinline__ void xcd_barrier_complete(unsigned* bar, unsigned x, unsigned& nloc, unsigned& nx) {
    const unsigned G = gridDim.x * gridDim.y * gridDim.z;
    unsigned sum, cnt, mine, sp = 0u;
    for (;;) {
        sum = 0u; cnt = 0u; mine = 0u;
#pragma unroll
        for (unsigned j = 0; j < 16; ++j) { const unsigned c = xb_ld(&bar[XB_XCNT(j)]); sum += c; cnt += (c > 0u) ? 1u : 0u; mine = (j == x) ? c : mine; }
        if (sum == G) break;
        __builtin_amdgcn_s_sleep(1);
        if ((++sp & 255u) == 0u) { if (xb_ld(&bar[XB_TMO])) break; if (sp > XB_SPIN_CAP) { atomicAdd(&bar[XB_TMO], 1u); break; } }
    }
    nloc = mine > 0u ? mine : 1u; nx = cnt > 0u ? cnt : 1u;
}
__device__ __forceinline__ void xcd_barrier(const XcdBarrier& b) {
    asm volatile("s_waitcnt vmcnt(0)" ::: "memory");
    __syncthreads();
    if (threadIdx.x == 0) {
        unsigned* bar = b.bar;
        __builtin_amdgcn_s_waitcnt(0);
        unsigned nloc = b.st[0], nx = b.st[1];
        if (nloc == 0u) { xcd_barrier_complete(bar, b.x, nloc, nx); b.st[0] = nloc; b.st[1] = nx; }
        const unsigned old = xb_add(&bar[XB_XSUB(b.x)], 1u);
        const unsigned gen = old / nloc;
        if (old + 1u == (gen + 1u) * nloc) {
            __builtin_amdgcn_fence(__ATOMIC_RELEASE, "agent");
            asm volatile("s_waitcnt vmcnt(0)" ::: "memory");
            const unsigned og = xb_add(&bar[XB_TOP], 1u);
            const unsigned tg = og / nx;
            if (og + 1u == (tg + 1u) * nx) xb_add(&bar[XB_TOPGEN], 1u);
            else XB_SPIN(xb_ld(&bar[XB_TOPGEN]) == tg, bar);
            __builtin_amdgcn_fence(__ATOMIC_ACQUIRE, "agent");
            xb_add(&bar[XB_XGEN(b.x)], 1u);
            asm volatile("s_waitcnt vmcnt(0)" ::: "memory");
        } else {
            XB_SPIN(xb_ld(&bar[XB_XGEN(b.x)]) == gen, bar);
            __builtin_amdgcn_fence(__ATOMIC_ACQUIRE, "agent");
            asm volatile("s_waitcnt vmcnt(0)" ::: "memory");
        }
    }
    __syncthreads();
}

constexpr int N_PHASES = 11;
__global__ void __launch_bounds__(512, 2) mk_fwd(Args A) {
    extern __shared__ __attribute__((aligned(16))) unsigned char lds_raw[];
    LAS unsigned char* lds = (LAS unsigned char*)lds_raw;
    cg::grid_group grid = cg::this_grid();
    const int tid = threadIdx.x, lane = tid & 63, wave = __builtin_amdgcn_readfirstlane(tid >> 6);
    const int G = gridDim.x, gw = blockIdx.x * 8 + wave, NGW = G * 8;
    unsigned char* ws = A.ws;
    const float* mod = (const float*)(ws + WS_MOD);
    bf16_t* H = (bf16_t*)(ws + WS_H);
    const int lo = A.ph_lo, hi = A.ph_hi;
#ifndef PHMASK
#define PHMASK 0x7ff
#endif
#ifndef REPMASK
#define REPMASK 0
#endif
#ifndef XSYNC
#define XSYNC 0
#endif
#ifndef TS_LO
#define TS_LO -2
#define TS_HI -2
#endif
#define REP(k) for (int rep_ = 0; rep_ < 1 + ((REPMASK >> (k)) & 1); ++rep_)
#define IN(k) (((PHMASK >> (k)) & 1) && lo <= (k) && (k) < hi)
    unsigned* barw = (unsigned*)(ws + WS_BAR);
    volatile LAS unsigned* bst = (volatile LAS unsigned*)(lds + LDS_BYTES - 16);
    if (tid < 4) bst[tid] = 0u;
    __syncthreads();
    if (hi < 0) grid.sync();
    XcdBarrier xbar = xcd_barrier_post(barw, bst);
    unsigned long long ts_a = 0, ts_b = 0;
    if (TS_LO == -1) ts_a = __builtin_amdgcn_s_memrealtime();
#define SEAM(k) do { if (IN(k) && IN((k) + 1)) xcd_barrier(xbar); if (TS_LO == (k)) ts_a = __builtin_amdgcn_s_memrealtime(); if (TS_HI == (k)) ts_b = __builtin_amdgcn_s_memrealtime(); } while (0)

    if (IN(0)) {
        unsigned* modcnt = (unsigned*)(ws + WS_MODCNT);
        p0_mod(A, lds, tid, lane, wave, modcnt);
        if (TS_LO == 20) ts_a = __builtin_amdgcn_s_memrealtime(); if (TS_HI == 20) ts_b = __builtin_amdgcn_s_memrealtime();
        __syncthreads();
        p0_weights(A, lds, tid, lane, wave);
        if (TS_LO == 21) ts_a = __builtin_amdgcn_s_memrealtime(); if (TS_HI == 21) ts_b = __builtin_amdgcn_s_memrealtime();
        if (tid == 0) { unsigned sp = 0; while (__hip_atomic_load(modcnt, __ATOMIC_RELAXED, __HIP_MEMORY_SCOPE_AGENT) < 6144u / 32u) { __builtin_amdgcn_s_sleep(2); if (++sp > (1u << 22)) break; }
            __builtin_amdgcn_fence(__ATOMIC_ACQUIRE, "agent"); asm volatile("s_waitcnt vmcnt(0)" ::: "memory"); }
        __syncthreads();
        for (int row = 4 * gw; row < MALL; row += 4 * NGW) {
            const bool isx = row < MTOK; const int bb = isx ? (row >> 11) : 16;
            const float* xr = isx ? A.in[I_X] + (size_t)row * DM : A.in[I_CTX] + (size_t)(row - MTOK) * DM;
            modulate_rows4(xr, A.in[I_N1W], mod + bb * 6144, mod + bb * 6144 + 1024, H + (size_t)row * DM, lane);
        }
    }
    if (TS_LO == 0) ts_a = __builtin_amdgcn_s_memrealtime(); if (TS_HI == 0) ts_b = __builtin_amdgcn_s_memrealtime();
    SEAM(1);
    if (IN(2)) REP(2) {
        pg8::Gemm g{H, (const bf16_t*)(ws + WS_WIN), 1024, 1024, 1024, 0}; pg8::InProjOrder S{G, (int)blockIdx.x};
        EpiInProj E{(bf16_t*)(ws + WS_K), (bf16_t*)(ws + WS_VT), (bf16_t*)(ws + WS_Q), (float*)(ws + WS_G), (bf16_t*)(ws + WS_AB), (bf16_t*)A.out, (const float*)(ws + WS_BIASP), A.in[I_CONVW]};
        pg8::gemm_phase<EpiInProj, pg8::InProjOrder>(lds, g, S, E);
    }
    SEAM(2);
    if (IN(3)) REP(3) {
        for (int seq = blockIdx.x; seq < 256; seq += G)
            mlstm_seq(lds, (const bf16_t*)(ws + WS_K), (const bf16_t*)(ws + WS_VT), (const bf16_t*)(ws + WS_Q), (const float*)(ws + WS_G), (bf16_t*)(ws + WS_H), (bf16_t*)(ws + WS_HD1), seq, tid, lane, wave);
    }
    SEAM(3);
    if (IN(4)) {
        for (int row = 4 * gw; row < MTOK; row += 4 * NGW)
            combine_rows4((const bf16_t*)(ws + WS_H) + (size_t)row * 1024, (const bf16_t*)(ws + WS_HD1) + (size_t)row * 1024, (bf16_t*)(ws + WS_AB) + (size_t)row * 2048 + 1024, A.in[I_MNW], lane);
    }
    SEAM(4);
    if (IN(5)) REP(5) {
        pg8::Gemm g{(const bf16_t*)(ws + WS_AB), (const bf16_t*)(ws + WS_BT2), 1024, 2048, 2048, 0}; pg8::SplitKOrder S; S.base.init(MTOK, 1024, G, (int)blockIdx.x);
        EpiG2 E{(const bf16_t*)A.out, (bf16_t*)(ws + WS_H)};
        pg8::gemm_phase<EpiG2, pg8::SplitKOrder>(lds, g, S, E);
    }
    SEAM(5);
    if (IN(6)) REP(6) {
        pg8::Gemm g{(const bf16_t*)(ws + WS_H), (const bf16_t*)(ws + WS_WO), 1024, 1024, 1024, 0}; pg8::StaticOrder S; S.init(MTOK, 1024, G, (int)blockIdx.x);
        EpiResNorm<0> E{A.in[I_X], A.out, mod + 2048, 0, H, A.in[I_N2W], mod, (bf16_t*)(ws + WS_HD1), (float*)(ws + WS_XBUF), (unsigned*)(ws + WS_CNT), lds + 131072};
        pg8::gemm_phase<EpiResNorm<0>, pg8::StaticOrder>(lds, g, S, E);
    }
    SEAM(6);
    if (IN(8)) REP(8) {
        pg8::Gemm g{H, (const bf16_t*)(ws + WS_W1), 1024, 1024, 1024, 0}; pg8::StaticOrder S; S.init(MTOK, DFF, G, (int)blockIdx.x);
        EpiRelu2 E{(bf16_t*)(ws + WS_F1), DFF};
        pg8::gemm_phase<EpiRelu2, pg8::StaticOrder>(lds, g, S, E);
    }
    SEAM(8);
    if (IN(9)) {
        pg8::Gemm g{(const bf16_t*)(ws + WS_F1), (const bf16_t*)(ws + WS_W2), DFF, DFF, F1P, 1}; pg8::StaticOrder S; S.init(MTOK, 1024, G, (int)blockIdx.x);
        EpiResNorm<1> E{A.out, A.out, mod + 5120, 1, nullptr, A.in[I_FNW], mod, (bf16_t*)(ws + WS_HD1), (float*)(ws + WS_XBUF) + (size_t)MTOK * 4, (unsigned*)(ws + WS_CNT) + 128 * 64, lds + 131072};
        pg8::gemm_phase<EpiResNorm<1>, pg8::StaticOrder>(lds, g, S, E);
    }
    if (TS_LO > -2) {
        xcd_barrier(xbar); if (TS_HI == 9) ts_b = __builtin_amdgcn_s_memrealtime();
        if (blockIdx.x == 0) { const int n = (int)((ts_b - ts_a) / 100ull); for (int i = tid; i < n; i += 512) A.out[(size_t)i * 4096 + 3] += 0.25f; }
    }
#undef IN
#undef SEAM
}

#ifndef MK_N_LAUNCHES
#define MK_N_LAUNCHES 1
#endif
extern "C" void kernel_launch(void* const* d_in, const int* in_sizes, int n_in, void* d_out, int out_size, void* d_ws, size_t ws_size, hipStream_t stream) {
    static int grid = 0;
    if (grid == 0) {
        if (n_in != 18 || out_size != MTOK * DM || ws_size < WS_END) { fprintf(stderr, "kernel_launch: unexpected shapes (n_in %d out %d ws %zu)\n", n_in, out_size, ws_size); grid = -1; return; }
        int dev = 0, cus = 0, per_cu = 0;
        hipGetDevice(&dev); hipDeviceGetAttribute(&cus, hipDeviceAttributeMultiprocessorCount, dev);
        hipFuncSetAttribute((const void*)mk_fwd, hipFuncAttributeMaxDynamicSharedMemorySize, LDS_BYTES);
        if (hipOccupancyMaxActiveBlocksPerMultiprocessor(&per_cu, (const void*)mk_fwd, 512, LDS_BYTES) != hipSuccess || per_cu < 1) { fprintf(stderr, "kernel_launch: occupancy query says %d\n", per_cu); per_cu = 1; }
        (void)hipGetLastError();
        grid = cus * per_cu;
        if (grid > 256) grid = 256;
    }
    if (grid < 0) return;
    Args a{};
    for (int i = 0; i < 18; ++i) a.in[i] = (const float*)d_in[i];
    a.out = (float*)d_out; a.ws = (unsigned char*)d_ws;
    (void)hipMemsetAsync((unsigned char*)d_ws + WS_BAR, 0, 256 * 1024, stream);
#if MK_N_LAUNCHES == 1
    a.ph_lo = 0; a.ph_hi = N_PHASES;
    void* args[] = {&a};
    hipError_t e = hipLaunchCooperativeKernel((const void*)mk_fwd, dim3(grid), dim3(512), args, LDS_BYTES, stream);
    if (e != hipSuccess) fprintf(stderr, "cooperative launch failed: %s (grid %d)\n", hipGetErrorString(e), grid);
#else
    for (int p = 0; p < N_PHASES; ++p) { a.ph_lo = p; a.ph_hi = p + 1; hipLaunchKernelGGL(mk_fwd, dim3(grid), dim3(512), LDS_BYTES, stream, a); }
#endif
}
```

```cpp
#include <hip/hip_runtime.h>
#include <hip/hip_cooperative_groups.h>
#include <cstdio>
#include <cstdint>
namespace cg = cooperative_groups;

#define LAS __attribute__((address_space(3)))
typedef unsigned short bf16_t;
typedef short bf16x8 __attribute__((ext_vector_type(8)));
typedef float f32x4 __attribute__((ext_vector_type(4)));
typedef unsigned u32x4 __attribute__((ext_vector_type(4)));
typedef unsigned u32x2 __attribute__((ext_vector_type(2)));

constexpr int DM = 1024, NB = 16, SEQ = 2048, CTXL = 256, NH = 8, DK = 64, DV = 128, DFF = 4096;
constexpr int MTOK = NB * SEQ;
constexpr int MCTX = NB * CTXL;
constexpr int MALL = MTOK + MCTX;
constexpr int DIN = 8224, NIN = 8448;
constexpr float EPS = 1e-6f;
constexpr int OFF_K = 0, OFF_V = 512, OFF_IG = 1536, OFF_Q = 1568, OFF_O = 2080, OFF_XIN = 3104, OFF_GC = 4128, OFF_GB = 5152, OFF_MRG = 6176;

constexpr size_t MiB = 1u << 20;
constexpr size_t WS_MOD = 0;
constexpr size_t WS_BIASP = 512 * 1024;
constexpr size_t WS_BAR = 768 * 1024;
constexpr size_t WS_MODCNT = 900 * 1024;
constexpr size_t WS_CNT = 800 * 1024;
constexpr size_t WS_XBUF = 450 * MiB;
constexpr size_t WS_WIN = 1 * MiB;
constexpr size_t WS_BT2 = 18 * MiB;
constexpr size_t WS_WO = 22 * MiB;
constexpr size_t WS_W1 = 24 * MiB;
constexpr int F1P = DFF + 64;
constexpr size_t WS_W2 = 452 * MiB;
constexpr size_t WS_H = 40 * MiB;
constexpr size_t WS_K = 112 * MiB;
constexpr size_t WS_VT = 148 * MiB;
constexpr size_t WS_Q = 220 * MiB;
constexpr size_t WS_G = 252 * MiB;
constexpr size_t WS_AB = 258 * MiB;
constexpr size_t WS_HD1 = 386 * MiB;
constexpr size_t WS_F1 = 112 * MiB;
constexpr size_t WS_END = 462 * MiB;

constexpr int LDS_BYTES = 155648;

typedef float f32x2_t __attribute__((ext_vector_type(2))); typedef __bf16 bf16x2_t __attribute__((ext_vector_type(2)));
__device__ __forceinline__ unsigned cvt_pk_bf16(float lo, float hi) { const f32x2_t v = {lo, hi}; const bf16x2_t b = __builtin_convertvector(v, bf16x2_t); return __builtin_bit_cast(unsigned, b); }
__device__ __forceinline__ float bf_lo(unsigned w) { return __uint_as_float(w << 16); }
__device__ __forceinline__ float bf_hi(unsigned w) { return __uint_as_float(w & 0xffff0000u); }
__device__ __forceinline__ float sigm(float x) { return __builtin_amdgcn_rcpf(1.f + __expf(-x)); }
__device__ __forceinline__ float wave_sum(float v) {
#pragma unroll
    for (int o = 1; o < 64; o <<= 1) v += __shfl_xor(v, o);
    return v;
}
__device__ __forceinline__ float wave_max(float v) {
#pragma unroll
    for (int o = 1; o < 64; o <<= 1) v = fmaxf(v, __shfl_xor(v, o));
    return v;
}
template <int CTRL, int RM = 0xf> __device__ __forceinline__ float dppf(float old, float src) {
    return __int_as_float(__builtin_amdgcn_update_dpp(__float_as_int(old), __float_as_int(src), CTRL, RM, 0xf, false));
}
__device__ __forceinline__ float wave_scan_add(float x) {
    x += dppf<0x111>(0.f, x); x += dppf<0x112>(0.f, x); x += dppf<0x114>(0.f, x); x += dppf<0x118>(0.f, x);
    x += dppf<0x142, 0xA>(0.f, x); x += dppf<0x143, 0xC>(0.f, x); return x;
}
__device__ __forceinline__ float wave_scan_max(float x) {
    const float ninf = -INFINITY;
    x = fmaxf(x, dppf<0x111>(ninf, x)); x = fmaxf(x, dppf<0x112>(ninf, x)); x = fmaxf(x, dppf<0x114>(ninf, x)); x = fmaxf(x, dppf<0x118>(ninf, x));
    x = fmaxf(x, dppf<0x142, 0xA>(ninf, x)); x = fmaxf(x, dppf<0x143, 0xC>(ninf, x)); return x;
}
__device__ __forceinline__ float lane63(float x) { return __int_as_float(__builtin_amdgcn_readlane(__float_as_int(x), 63)); }
__device__ __forceinline__ float logsig(float x) { return fminf(x, 0.f) - __logf(1.f + __expf(-fabsf(x))); }

namespace pg8 {
constexpr int BM = 256, BK = 64, HALF = 128, HTB = HALF * BK * 2, STAGE_BYTES = 8 * HTB, NXCD = 8, WGM = 8;
__host__ __device__ __forceinline__ int lds_byte(int r, int c) { const int st = (r >> 4) * 2 + (c >> 5), rr = r & 15, cc = c & 31, ob = rr * 64 + cc * 2; return st * 1024 + (ob ^ (((ob >> 9) & 1) << 5)); }
__host__ __device__ __forceinline__ void stage_rc(int b, int& R, int& C) { const int st = b / 1024, sb = b % 1024, swz = sb ^ (((sb >> 9) & 1) << 5); R = (st >> 1) * 16 + swz / 64; C = (st & 1) * 32 + (swz % 64) / 2; }
__host__ __device__ __forceinline__ int perm32(int rho) { const int n = rho >> 4, i = rho & 15; return 8 * (i >> 2) + 4 * n + (i & 3); }

struct Unit { int pm, pn, sw, h; };
struct Gemm { const bf16_t* A; const bf16_t* Bt; int K, lda, ldb, atile; };

__device__ __forceinline__ void rect_map(int l, int nM, int nN, int& pm, int& pn) {
    const int nig = WGM * nN, gid = l / nig, fm = gid * WGM, gsz = (nM - fm) < WGM ? (nM - fm) : WGM, rem = l % nig;
    pm = fm + rem % gsz; pn = rem / gsz;
}
struct StaticOrder {
    int nM, nN, nwg, G, c, rev = 0;
    __device__ void init(int M, int N, int G_, int c_) { nM = M / BM; nN = N / BM; nwg = nM * nN; G = G_; c = c_; }
    __device__ bool next(int i, Unit& u) const {
        const long L = (long)i * G + c; if (L >= nwg) return false;
        int wgid = (int)L; { const int q = nwg / NXCD, r = nwg % NXCD, xcd = wgid % NXCD, off = wgid / NXCD; wgid = (xcd < r ? xcd * (q + 1) : r * (q + 1) + (xcd - r) * q) + off; }
        rect_map(wgid, nM, nN, u.pm, u.pn); if (rev) u.pm = nM - 1 - u.pm; u.sw = 0; u.h = 0; return true;
    }
};
struct InProjOrder {
    int G, c;
    static constexpr int N_RC = 128 * 26, N_RB = 144 * 4, N_RA = 144 * 3, NWG = N_RC + N_RB + N_RA;
    __device__ bool next(int i, Unit& u) const {
        const long L = (long)i * G + c; if (L >= NWG) return false;
        int w = (int)L; w = (w % NXCD) * (NWG / NXCD) + w / NXCD;
        int a, b; u.h = 0;
        if (w < N_RC) { rect_map(w, 128, 26, a, b); u.pm = a; u.pn = 7 + b; u.sw = 0; }
        else if (w < N_RC + N_RB) { rect_map(w - N_RC, 144, 4, a, b); u.pm = 3 + b; u.pn = a; u.sw = 1; }
        else { rect_map(w - N_RC - N_RB, 144, 3, a, b); u.pm = a; u.pn = b; u.sw = 0; }
        return true;
    }
};
static_assert(InProjOrder::NWG % NXCD == 0, "in-proj unit count");
struct SplitKOrder {
    StaticOrder base;
    __device__ bool next(int i, Unit& u) const { if (!base.next(i >> 1, u)) return false; u.h = i & 1; return true; }
};

template <class Epi, class Sched>
__device__ __forceinline__ void gemm_phase(LAS unsigned char* lds, const Gemm g, const Sched& S, const Epi& E) {
    const int tid = threadIdx.x, wid = __builtin_amdgcn_readfirstlane(tid >> 6), lane = tid & 63, wr = wid >> 2, wc = wid & 3, fr = lane & 15, fq = lane >> 4;
    const int K = g.K, nt = K / BK;
    unsigned voffA[2], voffB[2];
#pragma unroll
    for (int i = 0; i < 2; ++i) { int R, C; stage_rc(tid * 16 + i * 8192, R, C); const int Rb = (R & ~31) + perm32(R & 31);
        voffA[i] = g.atile ? (unsigned)(R * BK + C) * 2u : (unsigned)(R * g.lda + C) * 2u; voffB[i] = (unsigned)(Rb * g.ldb + C) * 2u; }
    const size_t kstep = (size_t)(BK * 2), kstepA = g.atile ? (size_t)HTB : kstep;
    const size_t hstepA = g.atile ? (size_t)(g.lda / BK) * HTB : (size_t)HALF * g.lda * 2, hstepB = (size_t)HALF * g.ldb * 2;
    const unsigned ldsw = (unsigned)wid * 1024u;
    const int aoff = lds_byte(wr * 64 + fr, fq * 8), boff = lds_byte(wc * 32 + fr, fq * 8);
#define PG8_SA(b, h) (((b) * 2 + (h)) * HTB)
#define PG8_SB(b, h) ((4 + (b) * 2 + (h)) * HTB)
#define PG8_STAGE(bufoff, gbase, voff) do { _Pragma("unroll") for (int _i = 0; _i < 2; ++_i) \
        __builtin_amdgcn_global_load_lds((const unsigned*)((const char*)(gbase) + (voff)[_i]), (LAS unsigned*)(lds + (bufoff) + ldsw + _i * 8192), 16, 0, 0); } while (0)
#define PG8_LDA(dst, b, h) do { _Pragma("unroll") for (int m = 0; m < 4; ++m) _Pragma("unroll") for (int k = 0; k < 2; ++k) dst[m][k] = *(const LAS bf16x8*)(lds + PG8_SA(b, h) + aoff + m * 2048 + k * 1024); } while (0)
#define PG8_LDB(dst, b, h) do { _Pragma("unroll") for (int n = 0; n < 2; ++n) _Pragma("unroll") for (int k = 0; k < 2; ++k) dst[n][k] = *(const LAS bf16x8*)(lds + PG8_SB(b, h) + boff + n * 2048 + k * 1024); } while (0)
#define PG8_MMA(ai, bj, At, Bt) do { __builtin_amdgcn_s_setprio(1); _Pragma("unroll") for (int m = 0; m < 4; ++m) _Pragma("unroll") for (int n = 0; n < 2; ++n) _Pragma("unroll") for (int k = 0; k < 2; ++k) \
        acc[ai][bj][m][n] = __builtin_amdgcn_mfma_f32_16x16x32_bf16(Bt[n][k], At[m][k], acc[ai][bj][m][n], 0, 0, 0); __builtin_amdgcn_s_setprio(0); } while (0)
#define PG8_WAIT_V(n) asm volatile("s_waitcnt vmcnt(" #n ")" ::: "memory")
#define PG8_WAIT_L(n) asm volatile("s_waitcnt lgkmcnt(" #n ")" ::: "memory")
#define PG8_BAR __builtin_amdgcn_s_barrier()
#define PG8_SCHED __builtin_amdgcn_sched_barrier(0)
#define PG8_PA(u) ((const char*)((u).sw ? g.Bt : g.A) + (size_t)(u).pm * 2 * hstepA + (size_t)(u).h * K * 2)
#define PG8_PB(u) ((const char*)((u).sw ? g.A : g.Bt) + (size_t)(u).pn * 2 * hstepB + (size_t)(u).h * K * 2)
    Unit cur, nxt; int ui = 0;
    if (!S.next(0, cur)) return;
    f32x4 acc[2][2][4][2];
#pragma unroll
    for (int a = 0; a < 2; ++a)
#pragma unroll
        for (int b = 0; b < 2; ++b)
#pragma unroll
            for (int m = 0; m < 4; ++m)
#pragma unroll
                for (int n = 0; n < 2; ++n) acc[a][b][m][n] = (f32x4){0.f, 0.f, 0.f, 0.f};
    bf16x8 At[4][2], B0[2][2], B1[2][2];
    const char* cA = PG8_PA(cur); const char* cB = PG8_PB(cur);
    PG8_STAGE(PG8_SB(0, 0), cB, voffB); PG8_STAGE(PG8_SB(0, 1), cB + hstepB, voffB); PG8_STAGE(PG8_SA(0, 0), cA, voffA); PG8_STAGE(PG8_SA(0, 1), cA + hstepA, voffA);
    if (wr == 1) PG8_BAR;
    PG8_WAIT_V(2); PG8_BAR;
    PG8_STAGE(PG8_SB(1, 0), cB + kstep, voffB); PG8_STAGE(PG8_SA(1, 0), cA + kstepA, voffA); PG8_STAGE(PG8_SB(1, 1), cB + hstepB + kstep, voffB);
    PG8_WAIT_V(6); PG8_BAR;
    for (;;) {
        const bool has_next = S.next(ui + 1, nxt);
        const char* nA = has_next ? PG8_PA(nxt) : cA; const char* nB = has_next ? PG8_PB(nxt) : cB;
        for (int t = 0; t < nt; t += 2) {
            const bool last = (t == nt - 2);
            const char* a1 = cA + (size_t)(t + 1) * kstepA;
            const char* a2 = last ? nA : cA + (size_t)(t + 2) * kstepA; const char* b2 = last ? nB : cB + (size_t)(t + 2) * kstep;
            const char* a3 = a2 + kstepA; const char* b3 = b2 + kstep;
            PG8_LDB(B0, 0, 0); PG8_LDB(B1, 0, 1); PG8_SCHED; PG8_LDA(At, 0, 0); PG8_STAGE(PG8_SA(1, 1), a1 + hstepA, voffA);
            PG8_WAIT_V(8); PG8_WAIT_L(0); PG8_BAR; PG8_MMA(0, 0, At, B0); PG8_MMA(0, 1, At, B1); PG8_BAR; PG8_SCHED;
            PG8_LDA(At, 0, 1); PG8_STAGE(PG8_SB(0, 0), b2, voffB); PG8_STAGE(PG8_SB(0, 1), b2 + hstepB, voffB); PG8_STAGE(PG8_SA(0, 0), a2, voffA);
            PG8_WAIT_V(8); PG8_WAIT_L(0); PG8_BAR; PG8_MMA(1, 0, At, B0); PG8_MMA(1, 1, At, B1); PG8_BAR; PG8_SCHED;
            PG8_LDB(B0, 1, 0); PG8_LDB(B1, 1, 1); PG8_SCHED; PG8_LDA(At, 1, 0); PG8_STAGE(PG8_SA(0, 1), a2 + hstepA, voffA);
            PG8_WAIT_V(8); PG8_WAIT_L(0); PG8_BAR; PG8_MMA(0, 0, At, B0); PG8_MMA(0, 1, At, B1); PG8_BAR; PG8_SCHED;
            PG8_LDA(At, 1, 1); PG8_STAGE(PG8_SB(1, 0), b3, voffB); PG8_STAGE(PG8_SB(1, 1), b3 + hstepB, voffB); PG8_STAGE(PG8_SA(1, 0), a3, voffA);
            PG8_WAIT_V(8); PG8_WAIT_L(0); PG8_BAR; PG8_MMA(1, 0, At, B0); PG8_MMA(1, 1, At, B1); PG8_BAR; PG8_SCHED;
        }
        if (wr == 0) PG8_BAR;
        bool keep = false;
        if constexpr (Epi::HAS_MID) keep = (cur.h == 0);
        if constexpr (Epi::HAS_MID) { if (keep) E.mid(acc, cur, wr, wc, fr, fq); else E(acc, cur, wr, wc, fr, fq); }
        else E(acc, cur, wr, wc, fr, fq);
        if (!has_next) break;
        if (!keep)
#pragma unroll
        for (int a = 0; a < 2; ++a)
#pragma unroll
            for (int b = 0; b < 2; ++b)
#pragma unroll
                for (int m = 0; m < 4; ++m)
#pragma unroll
                    for (int n = 0; n < 2; ++n) acc[a][b][m][n] = (f32x4){0.f, 0.f, 0.f, 0.f};
        cur = nxt; cA = nA; cB = nB; ++ui;
        if (wr == 1) PG8_BAR;
    }
    PG8_WAIT_V(0);
    PG8_BAR;
#undef PG8_SA
#undef PG8_SB
#undef PG8_STAGE
#undef PG8_LDA
#undef PG8_LDB
#undef PG8_MMA
#undef PG8_WAIT_V
#undef PG8_WAIT_L
#undef PG8_BAR
#undef PG8_SCHED
#undef PG8_PA
#undef PG8_PB
}
}
using pg8::Unit;

typedef f32x4 Acc[2][2][4][2];

__device__ __forceinline__ u32x4 pack8(const f32x4 v0, const f32x4 v1) {
    u32x4 w; w.x = cvt_pk_bf16(v0[0], v0[1]); w.y = cvt_pk_bf16(v0[2], v0[3]); w.z = cvt_pk_bf16(v1[0], v1[1]); w.w = cvt_pk_bf16(v1[2], v1[3]); return w;
}

struct EpiInProj {
    static constexpr bool HAS_MID = false;
    bf16_t* Kb; bf16_t* VTb; bf16_t* Qb; float* Gb; bf16_t* AB; bf16_t* MG; const float* biasp; const float* convw;
    __device__ __forceinline__ void operator()(Acc& acc, const Unit& u, int wr, int wc, int fr, int fq) const {
        if (u.sw) {
            const int r0 = u.pm * 256 + wr * 64 + fr, t0 = u.pn * 256 + wc * 32 + 8 * fq;
#pragma unroll
            for (int ai = 0; ai < 2; ++ai)
#pragma unroll
                for (int m = 0; m < 4; ++m) { const int wrow = r0 + ai * 128 + m * 16; const float bs = biasp[wrow]; bf16_t* rowp = VTb + (size_t)(wrow - 768) * MALL + t0;
#pragma unroll
                    for (int bj = 0; bj < 2; ++bj) *(u32x4*)(rowp + bj * 128) = pack8(acc[ai][bj][m][0] + bs, acc[ai][bj][m][1] + bs); }
            return;
        }
        const int row0 = u.pm * 256 + wr * 64 + fr, pn = u.pn;
        const int cb = pn * 256 + wc * 32 + 8 * fq;
        if (pn == 2) {
            if (wc == 0) {
                const f32x4 b0 = *(const f32x4*)(biasp + cb), b1 = *(const f32x4*)(biasp + cb + 4);
#pragma unroll
                for (int ai = 0; ai < 2; ++ai)
#pragma unroll
                    for (int m = 0; m < 4; ++m) { float* gp = Gb + (size_t)(8 * fq) * MALL + (row0 + ai * 128 + m * 16);
                        f32x4 g0 = acc[ai][0][m][0] + b0, g1 = acc[ai][0][m][1] + b1;
                        if (fq >= 2) {
#pragma unroll
                            for (int j = 0; j < 4; ++j) { g0[j] = logsig(g0[j]); g1[j] = logsig(g1[j]); } }
#pragma unroll
                        for (int j = 0; j < 4; ++j) { gp[(size_t)j * MALL] = g0[j]; gp[(size_t)(4 + j) * MALL] = g1[j]; } }
            }
            return;
        }
        if (pn >= 9 && pn < 25) {
            const int ch = 64 * (pn - 9) + 16 * wc + 4 * fq;
            const f32x4 bX = *(const f32x4*)(biasp + cb), bC = *(const f32x4*)(biasp + cb + 4), bB = *(const f32x4*)(biasp + cb + 128), bO = *(const f32x4*)(biasp + cb + 132);
            const f32x4 w0 = *(const f32x4*)(convw + ch), w1 = *(const f32x4*)(convw + 1024 + ch), w2 = *(const f32x4*)(convw + 2048 + ch);
#pragma unroll
            for (int ai = 0; ai < 2; ++ai) {
                f32x4 uu[4];
#pragma unroll
                for (int m = 0; m < 4; ++m) uu[m] = (acc[ai][0][m][0] + bX) * (acc[ai][0][m][1] + bC);
#pragma unroll
                for (int m = 0; m < 4; ++m) {
                    f32x4 pv, nx;
#pragma unroll
                    for (int j = 0; j < 4; ++j) {
                        const float pold = (m > 0) ? dppf<0x121>(0.f, uu[m > 0 ? m - 1 : 0][j]) : 0.f;
                        pv[j] = dppf<0x111>(pold, uu[m][j]);
                        const float nold = (m < 3) ? dppf<0x12F>(0.f, uu[m < 3 ? m + 1 : 3][j]) : 0.f;
                        nx[j] = dppf<0x101>(nold, uu[m][j]);
                    }
                    const f32x4 cv = w0 * pv + w1 * uu[m] + w2 * nx;
                    const f32x4 aa = (acc[ai][1][m][0] + bB) * cv;
                    f32x4 os = acc[ai][1][m][1] + bO;
#pragma unroll
                    for (int j = 0; j < 4; ++j) os[j] = sigm(os[j]);
                    bf16_t* rp = AB + (size_t)(row0 + ai * 128 + m * 16) * 2048 + ch;
                    u32x2 wa, wo; wa.x = cvt_pk_bf16(aa[0], aa[1]); wa.y = cvt_pk_bf16(aa[2], aa[3]); wo.x = cvt_pk_bf16(os[0], os[1]); wo.y = cvt_pk_bf16(os[2], os[3]);
                    *(u32x2*)rp = wa; *(u32x2*)(rp + 1024) = wo;
                }
            }
            return;
        }
        if (pn >= 25) {
            const int ch = 128 * (pn - 25) + 32 * wc + 8 * fq;
            f32x4 ba[2], bb[2];
#pragma unroll
            for (int n = 0; n < 2; ++n) { ba[n] = *(const f32x4*)(biasp + cb + 4 * n); bb[n] = *(const f32x4*)(biasp + cb + 128 + 4 * n); }
#pragma unroll
            for (int ai = 0; ai < 2; ++ai)
#pragma unroll
                for (int m = 0; m < 4; ++m) { bf16_t* rp = MG + (size_t)(row0 + ai * 128 + m * 16) * 2048 + ch;
                    f32x4 rr[2], gg[2];
#pragma unroll
                    for (int n = 0; n < 2; ++n) { const f32x4 xa = acc[ai][0][m][n] + ba[n], xb = acc[ai][1][m][n] + bb[n];
#pragma unroll
                        for (int j = 0; j < 4; ++j) { const float ea = 1.f + __expf(-xa[j]), eb = 1.f + __expf(-xb[j]); rr[n][j] = eb * __builtin_amdgcn_rcpf(ea); gg[n][j] = __builtin_amdgcn_rcpf(eb); } }
                    *(u32x4*)rp = pack8(rr[0], rr[1]); *(u32x4*)(rp + 1024) = pack8(gg[0], gg[1]); }
            return;
        }
        bf16_t* base; int ldc, col0, mode;
        if (pn < 2) { base = Kb; ldc = 512; col0 = pn * 256; mode = 0; }
        else { base = Qb; ldc = 512; col0 = (pn - 7) * 256; mode = 1; }
        col0 += wc * 32 + 8 * fq;
        f32x4 bv[2][2];
#pragma unroll
        for (int bj = 0; bj < 2; ++bj)
#pragma unroll
            for (int n = 0; n < 2; ++n) bv[bj][n] = *(const f32x4*)(biasp + cb + bj * 128 + 4 * n);
#pragma unroll
        for (int ai = 0; ai < 2; ++ai)
#pragma unroll
            for (int m = 0; m < 4; ++m) { bf16_t* rowp = base + (size_t)(row0 + ai * 128 + m * 16) * ldc + col0;
#pragma unroll
                for (int bj = 0; bj < 2; ++bj) { f32x4 v0 = acc[ai][bj][m][0] + bv[bj][0], v1 = acc[ai][bj][m][1] + bv[bj][1];
                    if (mode == 0) { v0 = v0 * 0.125f; v1 = v1 * 0.125f; }
                    *(u32x4*)(rowp + bj * 128) = pack8(v0, v1); } }
    }
};

struct EpiG2 {
    static constexpr bool HAS_MID = true;
    const bf16_t* MG; bf16_t* MRG;
    __device__ __forceinline__ void mid(Acc& acc, const Unit& u, int wr, int wc, int fr, int fq) const {
        const int row0 = u.pm * 256 + wr * 64 + fr, col0 = u.pn * 256 + wc * 32 + 8 * fq;
#pragma unroll
        for (int ai = 0; ai < 2; ++ai) {
            u32x4 rr[4][2];
#pragma unroll
            for (int m = 0; m < 4; ++m)
#pragma unroll
                for (int bj = 0; bj < 2; ++bj) rr[m][bj] = __builtin_nontemporal_load((const u32x4*)(MG + (size_t)(row0 + ai * 128 + m * 16) * 2048 + col0 + bj * 128));
#pragma unroll
            for (int m = 0; m < 4; ++m)
#pragma unroll
                for (int bj = 0; bj < 2; ++bj) { const u32x4 q = rr[m][bj];
                    const f32x4 r0 = {bf_lo(q.x), bf_hi(q.x), bf_lo(q.y), bf_hi(q.y)}, r1 = {bf_lo(q.z), bf_hi(q.z), bf_lo(q.w), bf_hi(q.w)};
                    acc[ai][bj][m][0] = acc[ai][bj][m][0] * r0; acc[ai][bj][m][1] = acc[ai][bj][m][1] * r1; }
            asm volatile("" ::: "memory");
        }
    }
    __device__ __forceinline__ void operator()(Acc& acc, const Unit& u, int wr, int wc, int fr, int fq) const {
        const int row0 = u.pm * 256 + wr * 64 + fr, col0 = u.pn * 256 + wc * 32 + 8 * fq;
#pragma unroll
        for (int ai = 0; ai < 2; ++ai) {
            u32x4 gg[4][2];
#pragma unroll
            for (int m = 0; m < 4; ++m)
#pragma unroll
                for (int bj = 0; bj < 2; ++bj) gg[m][bj] = __builtin_nontemporal_load((const u32x4*)(MG + (size_t)(row0 + ai * 128 + m * 16) * 2048 + col0 + bj * 128 + 1024));
#pragma unroll
            for (int m = 0; m < 4; ++m)
#pragma unroll
                for (int bj = 0; bj < 2; ++bj) { const u32x4 gb = gg[m][bj];
                    const f32x4 g0 = {bf_lo(gb.x), bf_hi(gb.x), bf_lo(gb.y), bf_hi(gb.y)}, g1 = {bf_lo(gb.z), bf_hi(gb.z), bf_lo(gb.w), bf_hi(gb.w)};
                    *(u32x4*)(MRG + (size_t)(row0 + ai * 128 + m * 16) * 1024 + col0 + bj * 128) = pack8(acc[ai][bj][m][0] * g0, acc[ai][bj][m][1] * g1); }
            asm volatile("" ::: "memory");
        }
    }
};
struct EpiRes {
    static constexpr bool HAS_MID = false;
    const float* base; float* out; const float* gate;
    __device__ __forceinline__ void operator()(Acc& acc, const Unit& u, int wr, int wc, int fr, int fq) const {
        const int row0 = u.pm * 256 + wr * 64 + fr, col0 = u.pn * 256 + wc * 32 + 8 * fq;
        const float* gp = gate + (size_t)((u.pm * 256) >> 11) * 6144 + col0;
        f32x4 gv[2][2];
#pragma unroll
        for (int bj = 0; bj < 2; ++bj)
#pragma unroll
            for (int n = 0; n < 2; ++n) gv[bj][n] = *(const f32x4*)(gp + bj * 128 + 4 * n);
#pragma unroll
        for (int ai = 0; ai < 2; ++ai)
#pragma unroll
            for (int m = 0; m < 4; ++m) { const size_t off = (size_t)(row0 + ai * 128 + m * 16) * 1024 + col0;
#pragma unroll
                for (int bj = 0; bj < 2; ++bj)
#pragma unroll
                    for (int n = 0; n < 2; ++n) { const f32x4 bs = *(const f32x4*)(base + off + bj * 128 + 4 * n);
                        *(f32x4*)(out + off + bj * 128 + 4 * n) = bs + gv[bj][n] * acc[ai][bj][m][n]; } }
    }
};
template <int mode> struct EpiResNorm {
    static constexpr bool HAS_MID = false;
    const float* base; float* out; const float* gate; int mode_unused;
    bf16_t* h2; const float* nw; const float* mod;
    bf16_t* x1b;
    float* xbuf; unsigned* cnt; LAS unsigned char* xl;
    __device__ __forceinline__ void operator()(Acc& acc, const Unit& u, int wr, int wc, int fr, int fq) const {
        const int wid = wr * 4 + wc, lane = fq * 16 + fr;
        const int row0 = u.pm * 256 + wr * 64 + fr, col0 = u.pn * 256 + wc * 32 + 8 * fq, bb = (u.pm * 256) >> 11;
        {
            const float* gp = gate + (size_t)bb * 6144 + col0;
            f32x4 gv[2][2];
#pragma unroll
            for (int bj = 0; bj < 2; ++bj)
#pragma unroll
                for (int n = 0; n < 2; ++n) gv[bj][n] = *(const f32x4*)(gp + bj * 128 + 4 * n);
#pragma unroll
            for (int ai = 0; ai < 2; ++ai)
#pragma unroll
                for (int m = 0; m < 4; ++m) { const size_t off = (size_t)(row0 + ai * 128 + m * 16) * 1024 + col0;
#pragma unroll
                    for (int bj = 0; bj < 2; ++bj) {
                        if (mode == 1) { const u32x4 q = __builtin_nontemporal_load((const u32x4*)(x1b + off + bj * 128));
                            const f32x4 b0 = {bf_lo(q.x), bf_hi(q.x), bf_lo(q.y), bf_hi(q.y)}, b1 = {bf_lo(q.z), bf_hi(q.z), bf_lo(q.w), bf_hi(q.w)};
                            acc[ai][bj][m][0] = b0 + gv[bj][0] * acc[ai][bj][m][0]; acc[ai][bj][m][1] = b1 + gv[bj][1] * acc[ai][bj][m][1]; }
                        else {
#pragma unroll
                            for (int n = 0; n < 2; ++n) { const f32x4 bs = __builtin_nontemporal_load((const f32x4*)(base + off + bj * 128 + 4 * n)); acc[ai][bj][m][n] = bs + gv[bj][n] * acc[ai][bj][m][n]; } }
                    }
                    asm volatile("" : "+v"(acc[ai][0][m][0]), "+v"(acc[ai][0][m][1]), "+v"(acc[ai][1][m][0]), "+v"(acc[ai][1][m][1]));
                    if (m & 1) asm volatile("" ::: "memory"); }
        }
        LAS float* P = (LAS float*)xl; LAS float* S = (LAS float*)(xl + 4096);
#pragma unroll
        for (int ai = 0; ai < 2; ++ai)
#pragma unroll
            for (int m = 0; m < 4; ++m) { float q = 0.f;
#pragma unroll
                for (int bj = 0; bj < 2; ++bj)
#pragma unroll
                    for (int n = 0; n < 2; ++n) { const f32x4 x = acc[ai][bj][m][n]; q += (x[0] * x[0] + x[1] * x[1]) + (x[2] * x[2] + x[3] * x[3]); }
                q += __shfl_xor(q, 16); q += __shfl_xor(q, 32);
                if (fq == 0) P[(ai * 128 + wr * 64 + m * 16 + fr) * 4 + wc] = q; }
        asm volatile("s_waitcnt lgkmcnt(0)\n\ts_barrier" ::: "memory");
        const int row = wid * 32 + (lane & 31);
        if (lane < 32) { const float tot = (P[row * 4 + 0] + P[row * 4 + 1]) + (P[row * 4 + 2] + P[row * 4 + 3]);
            __hip_atomic_store(xbuf + (size_t)(u.pm * 256 + row) * 4 + u.pn, tot, __ATOMIC_RELAXED, __HIP_MEMORY_SCOPE_AGENT); }
        asm volatile("s_waitcnt vmcnt(0)" ::: "memory");
        if (lane == 0) __hip_atomic_fetch_add(cnt + 64 * u.pm, 1u, __ATOMIC_RELAXED, __HIP_MEMORY_SCOPE_AGENT);
        if (wid == 0) {
            unsigned sp = 0;
            while ((unsigned)__builtin_amdgcn_readfirstlane(__hip_atomic_load(cnt + 64 * u.pm, __ATOMIC_RELAXED, __HIP_MEMORY_SCOPE_AGENT)) < 32u) { __builtin_amdgcn_s_sleep(2); if (++sp > (1u << 20)) break; }
            __builtin_amdgcn_fence(__ATOMIC_ACQUIRE, "agent");
        }
        asm volatile("s_waitcnt vmcnt(0) lgkmcnt(0)\n\ts_barrier" ::: "memory");
        if (lane < 32) { const float* sl = xbuf + (size_t)(u.pm * 256 + row) * 4; float t = 0.f;
#pragma unroll
            for (int k = 0; k < 4; ++k) t += __hip_atomic_load(sl + k, __ATOMIC_RELAXED, __HIP_MEMORY_SCOPE_AGENT);
            S[row] = rsqrtf(t * (1.f / 1024.f) + EPS); }
        asm volatile("s_waitcnt vmcnt(0) lgkmcnt(0)\n\ts_barrier" ::: "memory");
#pragma unroll
        for (int bj = 0; bj < 2; ++bj) {
            const int c = col0 + bj * 128;
            f32x4 w0 = *(const f32x4*)(nw + c), w1 = *(const f32x4*)(nw + c + 4), h0 = (f32x4){0.f, 0.f, 0.f, 0.f}, h1 = h0;
            if (mode == 0) { const float* mb = mod + (size_t)bb * 6144 + c; w0 = w0 * (*(const f32x4*)(mb + 4096) + 1.f); w1 = w1 * (*(const f32x4*)(mb + 4100) + 1.f); h0 = *(const f32x4*)(mb + 3072); h1 = *(const f32x4*)(mb + 3076); }
#pragma unroll
            for (int ai = 0; ai < 2; ++ai)
#pragma unroll
                for (int m = 0; m < 4; ++m) { asm volatile("" ::: "memory"); const int rl = ai * 128 + wr * 64 + m * 16 + fr; const float r = S[rl]; const size_t off = (size_t)(u.pm * 256 + rl) * 1024 + c;
                    const f32x4 v0 = acc[ai][bj][m][0], v1 = acc[ai][bj][m][1];
                    if (mode == 0) { *(u32x4*)(x1b + off) = pack8(v0, v1); *(u32x4*)(h2 + off) = pack8((v0 * r) * w0 + h0, (v1 * r) * w1 + h1); }
                    else { *(f32x4*)(out + off) = (v0 * r) * w0; *(f32x4*)(out + off + 4) = (v1 * r) * w1; } }
        }
    }
};
struct EpiRelu2 {
    static constexpr bool HAS_MID = false;
    bf16_t* O; int ldc;
    __device__ __forceinline__ void operator()(Acc& acc, const Unit& u, int wr, int wc, int fr, int fq) const {
        const int row0 = u.pm * 256 + wr * 64 + fr, col0 = u.pn * 256 + wc * 32 + 8 * fq;
#pragma unroll
        for (int ai = 0; ai < 2; ++ai)
#pragma unroll
            for (int m = 0; m < 4; ++m) { const int row = row0 + ai * 128 + m * 16;
#pragma unroll
                for (int bj = 0; bj < 2; ++bj) { f32x4 v0 = acc[ai][bj][m][0], v1 = acc[ai][bj][m][1]; const int col = col0 + bj * 128;
                    bf16_t* rowp = O + ((size_t)(row >> 7) * (ldc >> 6) + (col >> 6)) * 8192 + (row & 127) * 64 + (col & 63) - bj * 128;
#pragma unroll
                    for (int j = 0; j < 4; ++j) { const float a = fmaxf(v0[j], 0.f), b = fmaxf(v1[j], 0.f); v0[j] = a * a; v1[j] = b * b; }
                    __builtin_nontemporal_store(pack8(v0, v1), (u32x4*)(rowp + bj * 128)); } }
    }
};

__device__ __forceinline__ int inproj_colmap(int n) {
    if (n < 512) return OFF_K + n;
    if (n < 768) { const int j = n - 512; return j < 32 ? OFF_IG + j : -1; }
    if (n < 1792) return OFF_V + (n - 768);
    if (n < 2304) return OFF_Q + (n - 1792);
    if (n < 6400) { const int lc = (n - 2304) & 255, jt = (n - 2304) >> 8, bj = lc >> 7, wc = (lc >> 5) & 3, fq = (lc >> 3) & 3, nn = (lc >> 2) & 1, jj = lc & 3;
        const int seg = 2 * bj + nn, ch = 64 * jt + 16 * wc + 4 * fq + jj;
        return (seg == 0 ? OFF_XIN : seg == 1 ? OFF_GC : seg == 2 ? OFF_GB : OFF_O) + ch; }
    { const int lc = (n - 6400) & 255, jt = (n - 6400) >> 8; return OFF_MRG + (lc >> 7) * 1024 + 128 * jt + (lc & 127); }
}
struct TrItem { const float* W; bf16_t* out; int ldw, nblk, ldo, kofs, item, map; };
__device__ __forceinline__ void tr_load(const TrItem& t, int lane, f32x4 (&v)[8]) {
    const int kb = t.item / t.nblk, nb = t.item % t.nblk, k0 = 64 * kb, n0 = 32 * nb;
    const int n4 = lane & 7, kr = lane >> 3;
    const int nn = n0 + 4 * n4; const int src = t.map ? inproj_colmap(nn) : nn;
#pragma unroll
    for (int it = 0; it < 8; ++it) v[it] = (src >= 0) ? __builtin_nontemporal_load((const f32x4*)(t.W + (size_t)(k0 + 8 * it + kr) * t.ldw + src)) : (f32x4){0.f, 0.f, 0.f, 0.f};
}
__device__ __forceinline__ void tr_finish(const TrItem& t, int lane, const f32x4 (&v)[8], LAS float* scr) {
    const int kb = t.item / t.nblk, nb = t.item % t.nblk, k0 = 64 * kb, n0 = 32 * nb;
    const int n4 = lane & 7, kr = lane >> 3;
#pragma unroll
    for (int it = 0; it < 8; ++it) { LAS float* d = scr + (8 * it + kr) * 33 + 4 * n4; d[0] = v[it][0]; d[1] = v[it][1]; d[2] = v[it][2]; d[3] = v[it][3]; }
    asm volatile("s_waitcnt lgkmcnt(0)" ::: "memory");
    const int c = lane & 7;
#pragma unroll
    for (int j = 0; j < 4; ++j) { const int n = (lane >> 3) + 8 * j; const LAS float* s = scr + (8 * c) * 33 + n;
        u32x4 o; o.x = cvt_pk_bf16(s[0 * 33], s[1 * 33]); o.y = cvt_pk_bf16(s[2 * 33], s[3 * 33]); o.z = cvt_pk_bf16(s[4 * 33], s[5 * 33]); o.w = cvt_pk_bf16(s[6 * 33], s[7 * 33]);
        *(u32x4*)(t.out + (size_t)(n0 + n) * t.ldo + t.kofs + k0 + 8 * c) = o; }
    asm volatile("s_waitcnt lgkmcnt(0)" ::: "memory");
}

struct Args { const float* in[18]; float* out; unsigned char* ws; int ph_lo, ph_hi; };
enum { I_X = 0, I_C, I_CTX, I_CCTX, I_WMOD, I_BMOD, I_N1W, I_WIN, I_BIN, I_CONVW, I_MNW, I_WCO, I_WMO, I_WOUT, I_N2W, I_WFF1, I_WFF2, I_FNW };

__device__ __forceinline__ void p0_mod(const Args& A, LAS unsigned char* lds, int tid, int lane, int wave, unsigned* modcnt) {
    unsigned char* ws = A.ws;
    LAS float* sl = (LAS float*)lds;
    LAS float* red = (LAS float*)(lds + 17 * 4096);
    bool filled = false; unsigned done = 0;
    for (int item = blockIdx.x; item < 6144 / 32; item += gridDim.x) {
        if (!filled) {
            float cv[34];
#pragma unroll
            for (int j = 0; j < 34; ++j) { const int i = tid + 512 * j; cv[j] = i < 16 * 1024 ? A.in[I_C][i] : A.in[I_CCTX][i - 16 * 1024]; }
#pragma unroll
            for (int j = 0; j < 34; ++j) sl[tid + 512 * j] = cv[j] * sigm(cv[j]);
            __syncthreads(); filled = true;
        }
        const int col = lane & 31, kh = lane >> 5, n0 = item * 32, kbase = 128 * wave + 64 * kh;
        float a[17];
#pragma unroll
        for (int r = 0; r < 17; ++r) a[r] = 0.f;
        const float* wp = A.in[I_WMOD] + (size_t)kbase * 6144 + n0 + col;
        float wv[64];
#pragma unroll
        for (int j = 0; j < 64; ++j) wv[j] = __builtin_nontemporal_load(wp + (size_t)j * 6144);
#pragma unroll
        for (int i = 0; i < 64; i += 8) {
#pragma unroll
            for (int r = 0; r < 17; ++r) { const f32x4 s4 = *(const LAS f32x4*)(sl + r * 1024 + kbase + i), s5 = *(const LAS f32x4*)(sl + r * 1024 + kbase + i + 4);
                a[r] += (s4[0] * wv[i + 0] + s4[1] * wv[i + 1]) + (s4[2] * wv[i + 2] + s4[3] * wv[i + 3]) + (s5[0] * wv[i + 4] + s5[1] * wv[i + 5]) + (s5[2] * wv[i + 6] + s5[3] * wv[i + 7]); }
        }
#pragma unroll
        for (int r = 0; r < 17; ++r) red[((wave * 2 + kh) * 17 + r) * 32 + col] = a[r];
        __syncthreads();
        for (int o = tid; o < 17 * 32; o += 512) { const int r = o >> 5, cc = o & 31; float s = A.in[I_BMOD][n0 + cc];
#pragma unroll
            for (int p = 0; p < 16; ++p) s += red[(p * 17 + r) * 32 + cc];
            ((float*)(ws + WS_MOD))[r * 6144 + n0 + cc] = s; }
        asm volatile("s_waitcnt vmcnt(0)" ::: "memory");
        __syncthreads();
        ++done;
    }
    if (done && tid == 0) { __builtin_amdgcn_fence(__ATOMIC_RELEASE, "agent"); asm volatile("s_waitcnt vmcnt(0)" ::: "memory"); __hip_atomic_fetch_add(modcnt, done, __ATOMIC_RELAXED, __HIP_MEMORY_SCOPE_AGENT); }
}
__device__ __forceinline__ void p0_weights(const Args& A, LAS unsigned char* lds, int tid, int lane, int wave) {
    unsigned char* ws = A.ws;
    LAS float* scr = (LAS float*)(lds + wave * 16384);
    const int gw = blockIdx.x * 8 + wave, NGW = gridDim.x * 8;
    constexpr int IT_WIN = 16 * (NIN / 32), IT_SQ = 16 * 32, IT_W1 = 16 * 128, IT_W2 = 64 * 32;
    constexpr int NITEMS = IT_WIN + 3 * IT_SQ + IT_W1 + IT_W2;
    auto mk = [&](int it) -> TrItem {
        int r = it;
        if (r < IT_WIN) return TrItem{A.in[I_WIN], (bf16_t*)(ws + WS_WIN), DIN, NIN / 32, 1024, 0, r, 1}; r -= IT_WIN;
        if (r < IT_SQ) return TrItem{A.in[I_WCO], (bf16_t*)(ws + WS_BT2), 1024, 32, 2048, 0, r, 0}; r -= IT_SQ;
        if (r < IT_SQ) return TrItem{A.in[I_WMO], (bf16_t*)(ws + WS_BT2), 1024, 32, 2048, 1024, r, 0}; r -= IT_SQ;
        if (r < IT_SQ) return TrItem{A.in[I_WOUT], (bf16_t*)(ws + WS_WO), 1024, 32, 1024, 0, r, 0}; r -= IT_SQ;
        if (r < IT_W1) return TrItem{A.in[I_WFF1], (bf16_t*)(ws + WS_W1), 4096, 128, 1024, 0, r, 0}; r -= IT_W1;
        return TrItem{A.in[I_WFF2], (bf16_t*)(ws + WS_W2), 1024, 32, F1P, 0, r, 0};
    };
    if (gw < NITEMS) {
        f32x4 va[8], vb[8];
        TrItem cur = mk(gw); tr_load(cur, lane, va);
        for (int it = gw; it < NITEMS; it += 2 * NGW) {
            const bool h1 = it + NGW < NITEMS, h2 = it + 2 * NGW < NITEMS;
            TrItem nx = cur; if (h1) { nx = mk(it + NGW); tr_load(nx, lane, vb); }
            tr_finish(cur, lane, va, scr);
            if (!h1) break;
            if (h2) { cur = mk(it + 2 * NGW); tr_load(cur, lane, va); }
            tr_finish(nx, lane, vb, scr);
        }
    }
    for (int i = blockIdx.x * 512 + tid; i < NIN; i += gridDim.x * 512) { const int s = inproj_colmap(i); ((float*)(ws + WS_BIASP))[i] = s >= 0 ? A.in[I_BIN][s] : 0.f; }
}

__device__ __forceinline__ float wave_allsum(float x) { return lane63(wave_scan_add(x)); }
__device__ __forceinline__ void modulate_rows4(const float* xrow, const float* w, const float* sh, const float* sc, bf16_t* orow, int lane) {
    f32x4 v[4][4]; float r[4];
#pragma unroll
    for (int q = 0; q < 4; ++q)
#pragma unroll
        for (int j = 0; j < 4; ++j) v[q][j] = __builtin_nontemporal_load((const f32x4*)(xrow + (size_t)q * DM) + lane + 64 * j);
#pragma unroll
    for (int q = 0; q < 4; ++q) { float s = 0.f;
#pragma unroll
        for (int j = 0; j < 4; ++j) s += (v[q][j].x * v[q][j].x + v[q][j].y * v[q][j].y) + (v[q][j].z * v[q][j].z + v[q][j].w * v[q][j].w);
        r[q] = rsqrtf(wave_allsum(s) * (1.f / DM) + EPS); }
#pragma unroll
    for (int j = 0; j < 4; ++j) { const f32x4 ww = ((const f32x4*)w)[lane + 64 * j], hh = ((const f32x4*)sh)[lane + 64 * j], cc = ((const f32x4*)sc)[lane + 64 * j];
        const f32x4 wc = ww * (cc + 1.f);
#pragma unroll
        for (int q = 0; q < 4; ++q) { const f32x4 y = (v[q][j] * r[q]) * wc + hh;
            u32x2 p; p.x = cvt_pk_bf16(y[0], y[1]); p.y = cvt_pk_bf16(y[2], y[3]); ((u32x2*)(orow + (size_t)q * DM))[lane + 64 * j] = p; } }
}

constexpr int L_QS = 0, L_KS = 18432, L_KTS = 36864, L_VTS = 54272, L_SS = 93440, L_CS = 128256, L_GW = 148992;
static_assert(L_GW + 8 * 512 <= LDS_BYTES, "mlstm LDS map");
#define BAR_LDS() asm volatile("s_waitcnt lgkmcnt(0)\n\ts_barrier" ::: "memory")

__device__ __forceinline__ void mlstm_seq(LAS unsigned char* lds, const bf16_t* Kb, const bf16_t* VTb, const bf16_t* Qb, const float* Gb, bf16_t* HD0, bf16_t* HD1, int seq, int tid, int lane, int w) {
    const int dir = seq >> 7, b = (seq >> 3) & 15, head = seq & 7;
    const int g = lane >> 4, l15 = lane & 15;
    bf16_t* HD = dir ? HD1 : HD0;
    for (int i = tid; i < 16 * 136; i += 512) { const int r = i / 136, cidx = i % 136; *(LAS bf16_t*)(lds + L_VTS + (128 + r) * 272 + cidx * 2) = (r == 0) ? (bf16_t)0x3F80 : (bf16_t)0; }
    const int tb = (w < 4) ? 2 * w : 15 - 2 * w;
    const int nvb = tb <= 2 ? 2 : (tb <= 5 ? 1 : 0), vst = tb <= 2 ? 2 * tb : tb + 3;
    f32x4 st[2][4];
#pragma unroll
    for (int i = 0; i < 2; ++i)
#pragma unroll
        for (int j = 0; j < 4; ++j) st[i][j] = (f32x4){0.f, 0.f, 0.f, 0.f};
    float mstate = 0.f;
    u32x4 pq[2], pk[2], pv[4]; float gi0, gi1, gf0, gf1;
    unsigned offq[2], offv[4], offg0, offg1;
#pragma unroll
    for (int i = 0; i < 2; ++i) { const int p = tid + 512 * i, row = p >> 3, pc = p & 7; offq[i] = (unsigned)((dir ? 127 - row : row) * 512 + head * 64 + pc * 8); }
#pragma unroll
    for (int i = 0; i < 4; ++i) { const int p = tid + 512 * i, v = p >> 4, pc = p & 15; offv[i] = (unsigned)((head * 128 + v) * MALL + pc * 8); }
    offg0 = (unsigned)((dir * 8 + head) * MALL + (dir ? 127 - lane : lane)); offg1 = (unsigned)((dir * 8 + head) * MALL + (dir ? 63 - lane : lane + 64));
#define PREFETCH(cc) do { const int cc_ = (cc); const bool isctx_ = cc_ < 2; const int T_ = isctx_ ? CTXL : SEQ, c_ = isctx_ ? cc_ : cc_ - 2; \
        const int base_ = isctx_ ? MTOK + b * CTXL : b * SEQ; const int tok0_ = base_ + (dir ? T_ - 128 * (c_ + 1) : 128 * c_); \
        const bf16_t* qb_ = Qb + (size_t)tok0_ * 512; const bf16_t* kb_ = Kb + (size_t)tok0_ * 512; const bf16_t* vb_ = VTb + tok0_; const float* gb_ = Gb + tok0_; \
        if (!isctx_) { _Pragma("unroll") for (int i = 0; i < 2; ++i) pq[i] = *(const u32x4*)(qb_ + offq[i]); } \
        _Pragma("unroll") for (int i = 0; i < 2; ++i) pk[i] = *(const u32x4*)(kb_ + offq[i]); \
        _Pragma("unroll") for (int i = 0; i < 4; ++i) pv[i] = *(const u32x4*)(vb_ + offv[i]); \
        gi0 = gb_[offg0]; gf0 = gb_[offg0 + 16 * MALL]; gi1 = gb_[offg1]; gf1 = gb_[offg1 + 16 * MALL]; \
    } while (0)
    PREFETCH(0);
    for (int cc = 0; cc < 18; ++cc) {
        const bool isctx = cc < 2; const int T_ = isctx ? CTXL : SEQ, c_ = isctx ? cc : cc - 2;
        const int tok0 = (isctx ? MTOK + b * CTXL : b * SEQ) + (dir ? T_ - 128 * (c_ + 1) : 128 * c_);
        const float b0 = wave_scan_add(gf0), b1 = wave_scan_add(gf1) + lane63(b0);
        const float a0 = gi0 - b0, a1 = gi1 - b1;
        const float Mc = fmaxf(mstate, lane63(wave_scan_max(fmaxf(a0, a1))));
        const float e0 = __expf(a0 - Mc), e1 = __expf(a1 - Mc), th0 = __expf(-b0 - Mc), th1 = __expf(-b1 - Mc);
        const float decay = __expf(mstate - Mc);
        mstate = lane63(b1) + Mc;
#pragma unroll
        for (int sl = 0; sl < 2; ++sl) if (sl < nvb) {
#pragma unroll
            for (int db = 0; db < 4; ++db) { st[sl][db] = st[sl][db] * decay; u32x2 p; p.x = cvt_pk_bf16(st[sl][db][0], st[sl][db][1]); p.y = cvt_pk_bf16(st[sl][db][2], st[sl][db][3]);
                *(LAS u32x2*)(lds + L_CS + (16 * (vst + sl) + l15) * 144 + (16 * db + 4 * g) * 2) = p; } }
        if (!isctx) {
#pragma unroll
            for (int i = 0; i < 2; ++i) { const int p = tid + 512 * i, row = p >> 3, pc = p & 7; *(LAS u32x4*)(lds + L_QS + row * 144 + pc * 16) = pq[i]; }
        }
        {
#pragma unroll
            for (int i = 0; i < 2; ++i) { const int p = tid + 512 * i, row = p >> 3, pc = p & 7, kidx = dir ? 127 - row : row;
                const float es = __shfl(i ? e1 : e0, 8 * w + (lane >> 3));
                const int kcol = (((kidx >> 3) ^ pc) << 3) | (kidx & 7);
                const unsigned ww[4] = {pk[i].x, pk[i].y, pk[i].z, pk[i].w}; unsigned sc4[4];
#pragma unroll
                for (int q2 = 0; q2 < 4; ++q2) { const unsigned pkd = cvt_pk_bf16(bf_lo(ww[q2]) * es, bf_hi(ww[q2]) * es); sc4[q2] = pkd;
                    *(LAS bf16_t*)(lds + L_KTS + (pc * 8 + 2 * q2) * 272 + kcol * 2) = (bf16_t)(pkd & 0xffffu);
                    *(LAS bf16_t*)(lds + L_KTS + (pc * 8 + 2 * q2 + 1) * 272 + kcol * 2) = (bf16_t)(pkd >> 16); }
                *(LAS u32x4*)(lds + L_KS + row * 144 + pc * 16) = (u32x4){sc4[0], sc4[1], sc4[2], sc4[3]}; }
#pragma unroll
            for (int i = 0; i < 4; ++i) { const int p = tid + 512 * i, v = p >> 4, pc = p & 15;
                const int rho = (v & ~31) | (((v >> 2) & 1) << 4) | (((v >> 3) & 3) << 2) | (v & 3);
                *(LAS u32x4*)(lds + L_VTS + rho * 272 + pc * 16) = pv[i]; }
        }
        BAR_LDS();
        if (cc + 1 < 18) PREFETCH(cc + 1);
        if (!isctx) {
            const int trow = 16 * tb + l15;
            const int klo = dir ? ((7 - tb) >> 1) : 0, khi = dir ? 3 : (tb >> 1);
            bf16x8 qf[2];
#pragma unroll
            for (int kk = 0; kk < 2; ++kk) qf[kk] = *(const LAS bf16x8*)(lds + L_QS + trow * 144 + (kk * 32 + g * 8) * 2);
#pragma unroll
            for (int sb = 0; sb < 8; ++sb) {
                f32x4 sa = (f32x4){0.f, 0.f, 0.f, 0.f};
                if (sb <= tb) {
#pragma unroll
                    for (int kk = 0; kk < 2; ++kk) { const bf16x8 kf = *(const LAS bf16x8*)(lds + L_KS + (16 * sb + l15) * 144 + (kk * 32 + g * 8) * 2);
                        sa = __builtin_amdgcn_mfma_f32_16x16x32_bf16(kf, qf[kk], sa, 0, 0, 0); }
                    if (sb == tb) { const int s0 = 16 * sb + 4 * g;
#pragma unroll
                        for (int r = 0; r < 4; ++r) sa[r] = (s0 + r <= trow) ? sa[r] : 0.f; }
                }
                const int s0 = 16 * sb + 4 * g;
                u32x2 p;
                if (dir) { p.x = cvt_pk_bf16(sa[3], sa[2]); p.y = cvt_pk_bf16(sa[1], sa[0]); *(LAS u32x2*)(lds + L_SS + trow * 272 + (124 - s0) * 2) = p; }
                else { p.x = cvt_pk_bf16(sa[0], sa[1]); p.y = cvt_pk_bf16(sa[2], sa[3]); *(LAS u32x2*)(lds + L_SS + trow * 272 + s0 * 2) = p; }
            }
            f32x4 num[9];
#pragma unroll
            for (int vb = 0; vb < 9; ++vb) { num[vb] = (f32x4){0.f, 0.f, 0.f, 0.f};
#pragma unroll
                for (int kk = 0; kk < 2; ++kk) { const bf16x8 cf = *(const LAS bf16x8*)(lds + L_CS + (16 * vb + l15) * 144 + (kk * 32 + g * 8) * 2);
                    num[vb] = __builtin_amdgcn_mfma_f32_16x16x32_bf16(cf, qf[kk], num[vb], 0, 0, 0); } }
#pragma unroll
            for (int kk = 0; kk < 4; ++kk) {
                if (kk >= klo && kk <= khi) {
                    const bf16x8 sf = *(const LAS bf16x8*)(lds + L_SS + trow * 272 + (kk * 32 + g * 8) * 2);
#pragma unroll
                    for (int vb = 0; vb < 9; ++vb) { const bf16x8 vf = *(const LAS bf16x8*)(lds + L_VTS + (16 * vb + l15) * 272 + (kk * 32 + g * 8) * 2);
                        num[vb] = __builtin_amdgcn_mfma_f32_16x16x32_bf16(vf, sf, num[vb], 0, 0, 0); }
                }
            }
            const float den = __shfl(num[8][0], l15);
            const float thr = __shfl((tb < 4) ? th0 : th1, (16 * tb + l15) & 63);
            const float inv = 1.f / fmaxf(fabsf(den), thr);
            const int tok = tok0 + (dir ? 127 - trow : trow);
            bf16_t* hp = HD + (size_t)tok * 1024 + head * 128 + 8 * g;
#pragma unroll
            for (int vp = 0; vp < 4; ++vp) { u32x4 p; p.x = cvt_pk_bf16(num[2 * vp][0] * inv, num[2 * vp][1] * inv); p.y = cvt_pk_bf16(num[2 * vp][2] * inv, num[2 * vp][3] * inv);
                p.z = cvt_pk_bf16(num[2 * vp + 1][0] * inv, num[2 * vp + 1][1] * inv); p.w = cvt_pk_bf16(num[2 * vp + 1][2] * inv, num[2 * vp + 1][3] * inv); *(u32x4*)(hp + 32 * vp) = p; }
        }
        if (nvb > 0) {
            bf16x8 vf0[4], vf1[4];
#pragma unroll
            for (int kk = 0; kk < 4; ++kk) { vf0[kk] = *(const LAS bf16x8*)(lds + L_VTS + (16 * vst + l15) * 272 + (kk * 32 + g * 8) * 2);
                vf1[kk] = *(const LAS bf16x8*)(lds + L_VTS + (16 * (vst + nvb - 1) + l15) * 272 + (kk * 32 + g * 8) * 2); }
            if (nvb == 2) {
#pragma unroll
                for (int db = 0; db < 4; ++db)
#pragma unroll
                    for (int kk = 0; kk < 4; ++kk) { const bf16x8 kf = *(const LAS bf16x8*)(lds + L_KTS + (16 * db + l15) * 272 + (((4 * kk + g) ^ ((2 * db + (l15 >> 3)) & 7)) << 4));
                        st[0][db] = __builtin_amdgcn_mfma_f32_16x16x32_bf16(kf, vf0[kk], st[0][db], 0, 0, 0);
                        st[1][db] = __builtin_amdgcn_mfma_f32_16x16x32_bf16(kf, vf1[kk], st[1][db], 0, 0, 0); }
            } else {
#pragma unroll
                for (int db = 0; db < 4; ++db)
#pragma unroll
                    for (int kk = 0; kk < 4; ++kk) { const bf16x8 kf = *(const LAS bf16x8*)(lds + L_KTS + (16 * db + l15) * 272 + (((4 * kk + g) ^ ((2 * db + (l15 >> 3)) & 7)) << 4));
                        st[0][db] = __builtin_amdgcn_mfma_f32_16x16x32_bf16(kf, vf0[kk], st[0][db], 0, 0, 0); }
            }
        }
        BAR_LDS();
    }
#undef PREFETCH
}

__device__ __forceinline__ void combine_rows4(const bf16_t* h0, const bf16_t* h1, bf16_t* ab, const float* nw, int lane) {
    u32x4 a[4][2], b[4][2], o[4][2];
#pragma unroll
    for (int q = 0; q < 4; ++q)
#pragma unroll
        for (int i = 0; i < 2; ++i) { const int p = lane + 64 * i;
            a[q][i] = __builtin_nontemporal_load((const u32x4*)(h0 + (size_t)q * 1024 + 8 * p)); b[q][i] = __builtin_nontemporal_load((const u32x4*)(h1 + (size_t)q * 1024 + 8 * p)); o[q][i] = __builtin_nontemporal_load((const u32x4*)(ab + (size_t)q * 2048 + 8 * p)); }
#pragma unroll
    for (int i = 0; i < 2; ++i) { const int p = lane + 64 * i;
        const f32x4 n0 = *(const f32x4*)(nw + 8 * p), n1 = *(const f32x4*)(nw + 8 * p + 4);
#pragma unroll
        for (int q = 0; q < 4; ++q) { const u32x4 aa = a[q][i], bb = b[q][i], oo = o[q][i];
            float s[8] = {bf_lo(aa.x) + bf_lo(bb.x), bf_hi(aa.x) + bf_hi(bb.x), bf_lo(aa.y) + bf_lo(bb.y), bf_hi(aa.y) + bf_hi(bb.y), bf_lo(aa.z) + bf_lo(bb.z), bf_hi(aa.z) + bf_hi(bb.z), bf_lo(aa.w) + bf_lo(bb.w), bf_hi(aa.w) + bf_hi(bb.w)};
            float ss = 0.f;
#pragma unroll
            for (int j = 0; j < 8; ++j) ss += s[j] * s[j];
            ss += dppf<0x121>(0.f, ss); ss += dppf<0x122>(0.f, ss); ss += dppf<0x124>(0.f, ss); ss += dppf<0x128>(0.f, ss);
            const float r = rsqrtf(ss * (1.f / 128.f) + EPS);
            const float og[8] = {bf_lo(oo.x), bf_hi(oo.x), bf_lo(oo.y), bf_hi(oo.y), bf_lo(oo.z), bf_hi(oo.z), bf_lo(oo.w), bf_hi(oo.w)};
            u32x4 qv;
            qv.x = cvt_pk_bf16(s[0] * r * n0[0] * og[0], s[1] * r * n0[1] * og[1]); qv.y = cvt_pk_bf16(s[2] * r * n0[2] * og[2], s[3] * r * n0[3] * og[3]);
            qv.z = cvt_pk_bf16(s[4] * r * n1[0] * og[4], s[5] * r * n1[1] * og[5]); qv.w = cvt_pk_bf16(s[6] * r * n1[2] * og[6], s[7] * r * n1[3] * og[7]);
            *(u32x4*)(ab + (size_t)q * 2048 + 8 * p) = qv; } }
}

#define XB_TMO      128
#define XB_XCNT(j)  (256  + 64 * (j))
#define XB_XSUB(j)  (1280 + 64 * (j))
#define XB_XGEN(j)  (2304 + 64 * (j))
#define XB_TOP      3328
#define XB_TOPGEN   3392
#define XCD_BAR_WORDS 3456
#define XB_SPIN_CAP (1u << 18)
__device__ __forceinline__ unsigned xb_ld(unsigned* p)              { return __hip_atomic_load(p, __ATOMIC_RELAXED, __HIP_MEMORY_SCOPE_AGENT); }
__device__ __forceinline__ unsigned xb_add(unsigned* p, unsigned v) { return __hip_atomic_fetch_add(p, v, __ATOMIC_RELAXED, __HIP_MEMORY_SCOPE_AGENT); }
__device__ __forceinline__ unsigned xb_xcc_id() { return (unsigned)__builtin_amdgcn_s_getreg((3 << 11) | 20) & 0xFu; }
#define XB_SPIN(cond, bar) do { unsigned _sp = 0; while (cond) { __builtin_amdgcn_s_sleep(1); \
    if ((++_sp & 255u) == 0u) { if (xb_ld(&(bar)[XB_TMO])) break; if (_sp > XB_SPIN_CAP) { atomicAdd(&(bar)[XB_TMO], 1u); break; } } } } while (0)
struct XcdBarrier { unsigned* bar; unsigned x; volatile LAS unsigned* st; };
__device__ __forceinline__ XcdBarrier xcd_barrier_post(unsigned* bar, volatile LAS unsigned* st) {
    XcdBarrier b; b.bar = bar; b.x = xb_xcc_id(); b.st = st;
    if (threadIdx.x == 0) (void)xb_add(&bar[XB_XCNT(b.x)], 1u);
    return b;
}
__device__ __forceinline__ void xcd_barrier_complete(unsigned* bar, unsigned x, unsigned& nloc, unsigned& nx) {
    const unsigned G = gridDim.x * gridDim.y * gridDim.z;
    unsigned sum, cnt, mine, sp = 0u;
    for (;;) {
        sum = 0u; cnt = 0u; mine = 0u;
#pragma unroll
        for (unsigned j = 0; j < 16; ++j) { const unsigned c = xb_ld(&bar[XB_XCNT(j)]); sum += c; cnt += (c > 0u) ? 1u : 0u; mine = (j == x) ? c : mine; }
        if (sum == G) break;
        __builtin_amdgcn_s_sleep(1);
        if ((++sp & 255u) == 0u) { if (xb_ld(&bar[XB_TMO])) break; if (sp > XB_SPIN_CAP) { atomicAdd(&bar[XB_TMO], 1u); break; } }
    }
    nloc = mine > 0u ? mine : 1u; nx = cnt > 0u ? cnt : 1u;
}
__device__ __forceinline__ void xcd_barrier(const XcdBarrier& b) {
    asm volatile("s_waitcnt vmcnt(0)" ::: "memory");
    __syncthreads();
    if (threadIdx.x == 0) {
        unsigned* bar = b.bar;
        __builtin_amdgcn_s_waitcnt(0);
        unsigned nloc = b.st[0], nx = b.st[1];
        if (nloc == 0u) { xcd_barrier_complete(bar, b.x, nloc, nx); b.st[0] = nloc; b.st[1] = nx; }
        const unsigned old = xb_add(&bar[XB_XSUB(b.x)], 1u);
        const unsigned gen = old / nloc;
        if (old + 1u == (gen + 1u) * nloc) {
            __builtin_amdgcn_fence(__ATOMIC_RELEASE, "agent");
            asm volatile("s_waitcnt vmcnt(0)" ::: "memory");
            const unsigned og = xb_add(&bar[XB_TOP], 1u);
            const unsigned tg = og / nx;
            if (og + 1u == (tg + 1u) * nx) xb_add(&bar[XB_TOPGEN], 1u);
            else XB_SPIN(xb_ld(&bar[XB_TOPGEN]) == tg, bar);
            __builtin_amdgcn_fence(__ATOMIC_ACQUIRE, "agent");
            xb_add(&bar[XB_XGEN(b.x)], 1u);
            asm volatile("s_waitcnt vmcnt(0)" ::: "memory");
        } else {
            XB_SPIN(xb_ld(&bar[XB_XGEN(b.x)]) == gen, bar);
            __builtin_amdgcn_fence(__ATOMIC_ACQUIRE, "agent");
            asm volatile("s_waitcnt vmcnt(0)" ::: "memory");
        }
    }
    __syncthreads();
}

constexpr int N_PHASES = 11;
__global__ void __launch_bounds__(512, 2) mk_fwd(Args A) {
    extern __shared__ __attribute__((aligned(16))) unsigned char lds_raw[];
    LAS unsigned char* lds = (LAS unsigned char*)lds_raw;
    cg::grid_group grid = cg::this_grid();
    const int tid = threadIdx.x, lane = tid & 63, wave = __builtin_amdgcn_readfirstlane(tid >> 6);
    const int G = gridDim.x, gw = blockIdx.x * 8 + wave, NGW = G * 8;
    unsigned char* ws = A.ws;
    const float* mod = (const float*)(ws + WS_MOD);
    bf16_t* H = (bf16_t*)(ws + WS_H);
    const int lo = A.ph_lo, hi = A.ph_hi;
#ifndef PHMASK
#define PHMASK 0x7ff
#endif
#ifndef REPMASK
#define REPMASK 0
#endif
#ifndef XSYNC
#define XSYNC 0
#endif
#ifndef TS_LO
#define TS_LO -2
#define TS_HI -2
#endif
#define REP(k) for (int rep_ = 0; rep_ < 1 + ((REPMASK >> (k)) & 1); ++rep_)
#define IN(k) (((PHMASK >> (k)) & 1) && lo <= (k) && (k) < hi)
    unsigned* barw = (unsigned*)(ws + WS_BAR);
    volatile LAS unsigned* bst = (volatile LAS unsigned*)(lds + LDS_BYTES - 16);
    if (tid < 4) bst[tid] = 0u;
    __syncthreads();
    if (hi < 0) grid.sync();
    XcdBarrier xbar = xcd_barrier_post(barw, bst);
    unsigned long long ts_a = 0, ts_b = 0;
    if (TS_LO == -1) ts_a = __builtin_amdgcn_s_memrealtime();
#define SEAM(k) do { if (IN(k) && IN((k) + 1)) xcd_barrier(xbar); if (TS_LO == (k)) ts_a = __builtin_amdgcn_s_memrealtime(); if (TS_HI == (k)) ts_b = __builtin_amdgcn_s_memrealtime(); } while (0)

    if (IN(0)) {
        unsigned* modcnt = (unsigned*)(ws + WS_MODCNT);
        p0_mod(A, lds, tid, lane, wave, modcnt);
        if (TS_LO == 20) ts_a = __builtin_amdgcn_s_memrealtime(); if (TS_HI == 20) ts_b = __builtin_amdgcn_s_memrealtime();
        __syncthreads();
        p0_weights(A, lds, tid, lane, wave);
        if (TS_LO == 21) ts_a = __builtin_amdgcn_s_memrealtime(); if (TS_HI == 21) ts_b = __builtin_amdgcn_s_memrealtime();
        if (tid == 0) { unsigned sp = 0; while (__hip_atomic_load(modcnt, __ATOMIC_RELAXED, __HIP_MEMORY_SCOPE_AGENT) < 6144u / 32u) { __builtin_amdgcn_s_sleep(2); if (++sp > (1u << 22)) break; }
            __builtin_amdgcn_fence(__ATOMIC_ACQUIRE, "agent"); asm volatile("s_waitcnt vmcnt(0)" ::: "memory"); }
        __syncthreads();
        for (int row = 4 * gw; row < MALL; row += 4 * NGW) {
            const bool isx = row < MTOK; const int bb = isx ? (row >> 11) : 16;
            const float* xr = isx ? A.in[I_X] + (size_t)row * DM : A.in[I_CTX] + (size_t)(row - MTOK) * DM;
            modulate_rows4(xr, A.in[I_N1W], mod + bb * 6144, mod + bb * 6144 + 1024, H + (size_t)row * DM, lane);
        }
    }
    if (TS_LO == 0) ts_a = __builtin_amdgcn_s_memrealtime(); if (TS_HI == 0) ts_b = __builtin_amdgcn_s_memrealtime();
    SEAM(1);
    if (IN(2)) REP(2) {
        pg8::Gemm g{H, (const bf16_t*)(ws + WS_WIN), 1024, 1024, 1024, 0}; pg8::InProjOrder S{G, (int)blockIdx.x};
        EpiInProj E{(bf16_t*)(ws + WS_K), (bf16_t*)(ws + WS_VT), (bf16_t*)(ws + WS_Q), (float*)(ws + WS_G), (bf16_t*)(ws + WS_AB), (bf16_t*)A.out, (const float*)(ws + WS_BIASP), A.in[I_CONVW]};
        pg8::gemm_phase<EpiInProj, pg8::InProjOrder>(lds, g, S, E);
    }
    SEAM(2);
    if (IN(3)) REP(3) {
        for (int seq = blockIdx.x; seq < 256; seq += G)
            mlstm_seq(lds, (const bf16_t*)(ws + WS_K), (const bf16_t*)(ws + WS_VT), (const bf16_t*)(ws + WS_Q), (const float*)(ws + WS_G), (bf16_t*)(ws + WS_H), (bf16_t*)(ws + WS_HD1), seq, tid, lane, wave);
    }
    SEAM(3);
    if (IN(4)) {
        for (int row = 4 * gw; row < MTOK; row += 4 * NGW)
            combine_rows4((const bf16_t*)(ws + WS_H) + (size_t)row * 1024, (const bf16_t*)(ws + WS_HD1) + (size_t)row * 1024, (bf16_t*)(ws + WS_AB) + (size_t)row * 2048 + 1024, A.in[I_MNW], lane);
    }
    SEAM(4);
    if (IN(5)) REP(5) {
        pg8::Gemm g{(const bf16_t*)(ws + WS_AB), (const bf16_t*)(ws + WS_BT2), 1024, 2048, 2048, 0}; pg8::SplitKOrder S; S.base.init(MTOK, 1024, G, (int)blockIdx.x);
        EpiG2 E{(const bf16_t*)A.out, (bf16_t*)(ws + WS_H)};
        pg8::gemm_phase<EpiG2, pg8::SplitKOrder>(lds, g, S, E);
    }
    SEAM(5);
    if (IN(6)) REP(6) {
        pg8::Gemm g{(const bf16_t*)(ws + WS_H), (const bf16_t*)(ws + WS_WO), 1024, 1024, 1024, 0}; pg8::StaticOrder S; S.init(MTOK, 1024, G, (int)blockIdx.x);
        EpiResNorm<0> E{A.in[I_X], A.out, mod + 2048, 0, H, A.in[I_N2W], mod, (bf16_t*)(ws + WS_HD1), (float*)(ws + WS_XBUF), (unsigned*)(ws + WS_CNT), lds + 131072};
        pg8::gemm_phase<EpiResNorm<0>, pg8::StaticOrder>(lds, g, S, E);
    }
    SEAM(6);
    if (IN(8)) REP(8) {
        pg8::Gemm g{H, (const bf16_t*)(ws + WS_W1), 1024, 1024, 1024, 0}; pg8::StaticOrder S; S.init(MTOK, DFF, G, (int)blockIdx.x);
        EpiRelu2 E{(bf16_t*)(ws + WS_F1), DFF};
        pg8::gemm_phase<EpiRelu2, pg8::StaticOrder>(lds, g, S, E);
    }
    SEAM(8);
    if (IN(9)) {
        pg8::Gemm g{(const bf16_t*)(ws + WS_F1), (const bf16_t*)(ws + WS_W2), DFF, DFF, F1P, 1}; pg8::StaticOrder S; S.init(MTOK, 1024, G, (int)blockIdx.x);
        EpiResNorm<1> E{A.out, A.out, mod + 5120, 1, nullptr, A.in[I_FNW], mod, (bf16_t*)(ws + WS_HD1), (float*)(ws + WS_XBUF) + (size_t)MTOK * 4, (unsigned*)(ws + WS_CNT) + 128 * 64, lds + 131072};
        pg8::gemm_phase<EpiResNorm<1>, pg8::StaticOrder>(lds, g, S, E);
    }
    if (TS_LO > -2) {
        xcd_barrier(xbar); if (TS_HI == 9) ts_b = __builtin_amdgcn_s_memrealtime();
        if (blockIdx.x == 0) { const int n = (int)((ts_b - ts_a) / 100ull); for (int i = tid; i < n; i += 512) A.out[(size_t)i * 4096 + 3] += 0.25f; }
    }
#undef IN
#undef SEAM
}

#ifndef MK_N_LAUNCHES
#define MK_N_LAUNCHES 1
#endif
extern "C" void kernel_launch(void* const* d_in, const int* in_sizes, int n_in, void* d_out, int out_size, void* d_ws, size_t ws_size, hipStream_t stream) {
    static int grid = 0;
    if (grid == 0) {
        if (n_in != 18 || out_size != MTOK * DM || ws_size < WS_END) { fprintf(stderr, "kernel_launch: unexpected shapes (n_in %d out %d ws %zu)\n", n_in, out_size, ws_size); grid = -1; return; }
        int dev = 0, cus = 0, per_cu = 0;
        hipGetDevice(&dev); hipDeviceGetAttribute(&cus, hipDeviceAttributeMultiprocessorCount, dev);
        hipFuncSetAttribute((const void*)mk_fwd, hipFuncAttributeMaxDynamicSharedMemorySize, LDS_BYTES);
        if (hipOccupancyMaxActiveBlocksPerMultiprocessor(&per_cu, (const void*)mk_fwd, 512, LDS_BYTES) != hipSuccess || per_cu < 1) { fprintf(stderr, "kernel_launch: occupancy query says %d\n", per_cu); per_cu = 1; }
        (void)hipGetLastError();
        grid = cus * per_cu;
        if (grid > 256) grid = 256;
    }
    if (grid < 0) return;
    Args a{};
    for (int i = 0; i < 18; ++i) a.in[i] = (const float*)d_in[i];
    a.out = (float*)d_out; a.ws = (unsigned char*)d_ws;
    (void)hipMemsetAsync((unsigned char*)d_ws + WS_BAR, 0, 256 * 1024, stream);
#if MK_N_LAUNCHES == 1
    a.ph_lo = 0; a.ph_hi = N_PHASES;
    void* args[] = {&a};
    hipError_t e = hipLaunchCooperativeKernel((const void*)mk_fwd, dim3(grid), dim3(512), args, LDS_BYTES, stream);
    if (e != hipSuccess) fprintf(stderr, "cooperative launch failed: %s (grid %d)\n", hipGetErrorString(e), grid);
#else
    for (int p = 0; p < N_PHASES; ++p) { a.ph_lo = p; a.ph_hi = p + 1; hipLaunchKernelGGL(mk_fwd, dim3(grid), dim3(512), LDS_BYTES, stream, a); }
#endif
}
```

```cpp
#include <hip/hip_runtime.h>
#include <hip/hip_cooperative_groups.h>
#include <cstdio>
#include <cstdint>
namespace cg = cooperative_groups;

#define LAS __attribute__((address_space(3)))
typedef unsigned short bf16_t;
typedef short bf16x8 __attribute__((ext_vector_type(8)));
typedef float f32x4 __attribute__((ext_vector_type(4)));
typedef unsigned u32x4 __attribute__((ext_vector_type(4)));
typedef unsigned u32x2 __attribute__((ext_vector_type(2)));

constexpr int DM = 1024, NB = 16, SEQ = 2048, CTXL = 256, NH = 8, DK = 64, DV = 128, DFF = 4096;
constexpr int MTOK = NB * SEQ;
constexpr int MCTX = NB * CTXL;
constexpr int MALL = MTOK + MCTX;
constexpr int DIN = 8224, NIN = 8448;
constexpr float EPS = 1e-6f;
constexpr int OFF_K = 0, OFF_V = 512, OFF_IG = 1536, OFF_Q = 1568, OFF_O = 2080, OFF_XIN = 3104, OFF_GC = 4128, OFF_GB = 5152, OFF_MRG = 6176;

constexpr size_t MiB = 1u << 20;
constexpr size_t WS_MOD = 0;
constexpr size_t WS_BIASP = 512 * 1024;
constexpr size_t WS_BAR = 768 * 1024;
constexpr size_t WS_MODCNT = 900 * 1024;
constexpr size_t WS_CNT = 800 * 1024;
constexpr size_t WS_XBUF = 450 * MiB;
constexpr size_t WS_WIN = 1 * MiB;
constexpr size_t WS_BT2 = 18 * MiB;
constexpr size_t WS_WO = 22 * MiB;
constexpr size_t WS_W1 = 24 * MiB;
constexpr int F1P = DFF + 64;
constexpr size_t WS_W2 = 452 * MiB;
constexpr size_t WS_H = 40 * MiB;
constexpr size_t WS_K = 112 * MiB;
constexpr size_t WS_VT = 148 * MiB;
constexpr size_t WS_Q = 220 * MiB;
constexpr size_t WS_G = 252 * MiB;
constexpr size_t WS_AB = 258 * MiB;
constexpr size_t WS_HD1 = 386 * MiB;
constexpr size_t WS_F1 = 112 * MiB;
constexpr size_t WS_END = 462 * MiB;

constexpr int LDS_BYTES = 155648;

typedef float f32x2_t __attribute__((ext_vector_type(2))); typedef __bf16 bf16x2_t __attribute__((ext_vector_type(2)));
__device__ __forceinline__ unsigned cvt_pk_bf16(float lo, float hi) { const f32x2_t v = {lo, hi}; const bf16x2_t b = __builtin_convertvector(v, bf16x2_t); return __builtin_bit_cast(unsigned, b); }
__device__ __forceinline__ float bf_lo(unsigned w) { return __uint_as_float(w << 16); }
__device__ __forceinline__ float bf_hi(unsigned w) { return __uint_as_float(w & 0xffff0000u); }
__device__ __forceinline__ float sigm(float x) { return __builtin_amdgcn_rcpf(1.f + __expf(-x)); }
__device__ __forceinline__ float wave_sum(float v) {
#pragma unroll
    for (int o = 1; o < 64; o <<= 1) v += __shfl_xor(v, o);
    return v;
}
__device__ __forceinline__ float wave_max(float v) {
#pragma unroll
    for (int o = 1; o < 64; o <<= 1) v = fmaxf(v, __shfl_xor(v, o));
    return v;
}
template <int CTRL, int RM = 0xf> __device__ __forceinline__ float dppf(float old, float src) {
    return __int_as_float(__builtin_amdgcn_update_dpp(__float_as_int(old), __float_as_int(src), CTRL, RM, 0xf, false));
}
__device__ __forceinline__ float wave_scan_add(float x) {
    x += dppf<0x111>(0.f, x); x += dppf<0x112>(0.f, x); x += dppf<0x114>(0.f, x); x += dppf<0x118>(0.f, x);
    x += dppf<0x142, 0xA>(0.f, x); x += dppf<0x143, 0xC>(0.f, x); return x;
}
__device__ __forceinline__ float wave_scan_max(float x) {
    const float ninf = -INFINITY;
    x = fmaxf(x, dppf<0x111>(ninf, x)); x = fmaxf(x, dppf<0x112>(ninf, x)); x = fmaxf(x, dppf<0x114>(ninf, x)); x = fmaxf(x, dppf<0x118>(ninf, x));
    x = fmaxf(x, dppf<0x142, 0xA>(ninf, x)); x = fmaxf(x, dppf<0x143, 0xC>(ninf, x)); return x;
}
__device__ __forceinline__ float lane63(float x) { return __int_as_float(__builtin_amdgcn_readlane(__float_as_int(x), 63)); }
__device__ __forceinline__ float logsig(float x) { return fminf(x, 0.f) - __logf(1.f + __expf(-fabsf(x))); }

namespace pg8 {
constexpr int BM = 256, BK = 64, HALF = 128, HTB = HALF * BK * 2, STAGE_BYTES = 8 * HTB, NXCD = 8, WGM = 8;
__host__ __device__ __forceinline__ int lds_byte(int r, int c) { const int st = (r >> 4) * 2 + (c >> 5), rr = r & 15, cc = c & 31, ob = rr * 64 + cc * 2; return st * 1024 + (ob ^ (((ob >> 9) & 1) << 5)); }
__host__ __device__ __forceinline__ void stage_rc(int b, int& R, int& C) { const int st = b / 1024, sb = b % 1024, swz = sb ^ (((sb >> 9) & 1) << 5); R = (st >> 1) * 16 + swz / 64; C = (st & 1) * 32 + (swz % 64) / 2; }
__host__ __device__ __forceinline__ int perm32(int rho) { const int n = rho >> 4, i = rho & 15; return 8 * (i >> 2) + 4 * n + (i & 3); }

struct Unit { int pm, pn, sw, h; };
struct Gemm { const bf16_t* A; const bf16_t* Bt; int K, lda, ldb, atile; };

__device__ __forceinline__ void rect_map(int l, int nM, int nN, int& pm, int& pn) {
    const int nig = WGM * nN, gid = l / nig, fm = gid * WGM, gsz = (nM - fm) < WGM ? (nM - fm) : WGM, rem = l % nig;
    pm = fm + rem % gsz; pn = rem / gsz;
}
struct StaticOrder {
    int nM, nN, nwg, G, c, rev = 0;
    __device__ void init(int M, int N, int G_, int c_) { nM = M / BM; nN = N / BM; nwg = nM * nN; G = G_; c = c_; }
    __device__ bool next(int i, Unit& u) const {
        const long L = (long)i * G + c; if (L >= nwg) return false;
        int wgid = (int)L; { const int q = nwg / NXCD, r = nwg % NXCD, xcd = wgid % NXCD, off = wgid / NXCD; wgid = (xcd < r ? xcd * (q + 1) : r * (q + 1) + (xcd - r) * q) + off; }
        rect_map(wgid, nM, nN, u.pm, u.pn); if (rev) u.pm = nM - 1 - u.pm; u.sw = 0; u.h = 0; return true;
    }
};
struct InProjOrder {
    int G, c;
    static constexpr int N_RC = 128 * 26, N_RB = 144 * 4, N_RA = 144 * 3, NWG = N_RC + N_RB + N_RA;
    __device__ bool next(int i, Unit& u) const {
        const long L = (long)i * G + c; if (L >= NWG) return false;
        int w = (int)L; w = (w % NXCD) * (NWG / NXCD) + w / NXCD;
        int a, b; u.h = 0;
        if (w < N_RC) { rect_map(w, 128, 26, a, b); u.pm = a; u.pn = 7 + b; u.sw = 0; }
        else if (w < N_RC + N_RB) { rect_map(w - N_RC, 144, 4, a, b); u.pm = 3 + b; u.pn = a; u.sw = 1; }
        else { rect_map(w - N_RC - N_RB, 144, 3, a, b); u.pm = a; u.pn = b; u.sw = 0; }
        return true;
    }
};
static_assert(InProjOrder::NWG % NXCD == 0, "in-proj unit count");
struct SplitKOrder {
    StaticOrder base;
    __device__ bool next(int i, Unit& u) const { if (!base.next(i >> 1, u)) return false; u.h = i & 1; return true; }
};

template <class Epi, class Sched>
__device__ __forceinline__ void gemm_phase(LAS unsigned char* lds, const Gemm g, const Sched& S, const Epi& E) {
    const int tid = threadIdx.x, wid = __builtin_amdgcn_readfirstlane(tid >> 6), lane = tid & 63, wr = wid >> 2, wc = wid & 3, fr = lane & 15, fq = lane >> 4;
    const int K = g.K, nt = K / BK;
    unsigned voffA[2], voffB[2];
#pragma unroll
    for (int i = 0; i < 2; ++i) { int R, C; stage_rc(tid * 16 + i * 8192, R, C); const int Rb = (R & ~31) + perm32(R & 31);
        voffA[i] = g.atile ? (unsigned)(R * BK + C) * 2u : (unsigned)(R * g.lda + C) * 2u; voffB[i] = (unsigned)(Rb * g.ldb + C) * 2u; }
    const size_t kstep = (size_t)(BK * 2), kstepA = g.atile ? (size_t)HTB : kstep;
    const size_t hstepA = g.atile ? (size_t)(g.lda / BK) * HTB : (size_t)HALF * g.lda * 2, hstepB = (size_t)HALF * g.ldb * 2;
    const unsigned ldsw = (unsigned)wid * 1024u;
    const int aoff = lds_byte(wr * 64 + fr, fq * 8), boff = lds_byte(wc * 32 + fr, fq * 8);
#define PG8_SA(b, h) (((b) * 2 + (h)) * HTB)
#define PG8_SB(b, h) ((4 + (b) * 2 + (h)) * HTB)
#define PG8_STAGE(bufoff, gbase, voff) do { _Pragma("unroll") for (int _i = 0; _i < 2; ++_i) \
        __builtin_amdgcn_global_load_lds((const unsigned*)((const char*)(gbase) + (voff)[_i]), (LAS unsigned*)(lds + (bufoff) + ldsw + _i * 8192), 16, 0, 0); } while (0)
#define PG8_LDA(dst, b, h) do { _Pragma("unroll") for (int m = 0; m < 4; ++m) _Pragma("unroll") for (int k = 0; k < 2; ++k) dst[m][k] = *(const LAS bf16x8*)(lds + PG8_SA(b, h) + aoff + m * 2048 + k * 1024); } while (0)
#define PG8_LDB(dst, b, h) do { _Pragma("unroll") for (int n = 0; n < 2; ++n) _Pragma("unroll") for (int k = 0; k < 2; ++k) dst[n][k] = *(const LAS bf16x8*)(lds + PG8_SB(b, h) + boff + n * 2048 + k * 1024); } while (0)
#define PG8_MMA(ai, bj, At, Bt) do { __builtin_amdgcn_s_setprio(1); _Pragma("unroll") for (int m = 0; m < 4; ++m) _Pragma("unroll") for (int n = 0; n < 2; ++n) _Pragma("unroll") for (int k = 0; k < 2; ++k) \
        acc[ai][bj][m][n] = __builtin_amdgcn_mfma_f32_16x16x32_bf16(Bt[n][k], At[m][k], acc[ai][bj][m][n], 0, 0, 0); __builtin_amdgcn_s_setprio(0); } while (0)
#define PG8_WAIT_V(n) asm volatile("s_waitcnt vmcnt(" #n ")" ::: "memory")
#define PG8_WAIT_L(n) asm volatile("s_waitcnt lgkmcnt(" #n ")" ::: "memory")
#define PG8_BAR __builtin_amdgcn_s_barrier()
#define PG8_SCHED __builtin_amdgcn_sched_barrier(0)
#define PG8_PA(u) ((const char*)((u).sw ? g.Bt : g.A) + (size_t)(u).pm * 2 * hstepA + (size_t)(u).h * K * 2)
#define PG8_PB(u) ((const char*)((u).sw ? g.A : g.Bt) + (size_t)(u).pn * 2 * hstepB + (size_t)(u).h * K * 2)
    Unit cur, nxt; int ui = 0;
    if (!S.next(0, cur)) return;
    f32x4 acc[2][2][4][2];
#pragma unroll
    for (int a = 0; a < 2; ++a)
#pragma unroll
        for (int b = 0; b < 2; ++b)
#pragma unroll
            for (int m = 0; m < 4; ++m)
#pragma unroll
                for (int n = 0; n < 2; ++n) acc[a][b][m][n] = (f32x4){0.f, 0.f, 0.f, 0.f};
    bf16x8 At[4][2], B0[2][2], B1[2][2];
    const char* cA = PG8_PA(cur); const char* cB = PG8_PB(cur);
    PG8_STAGE(PG8_SB(0, 0), cB, voffB); PG8_STAGE(PG8_SB(0, 1), cB + hstepB, voffB); PG8_STAGE(PG8_SA(0, 0), cA, voffA); PG8_STAGE(PG8_SA(0, 1), cA + hstepA, voffA);
    if (wr == 1) PG8_BAR;
    PG8_WAIT_V(2); PG8_BAR;
    PG8_STAGE(PG8_SB(1, 0), cB + kstep, voffB); PG8_STAGE(PG8_SA(1, 0), cA + kstepA, voffA); PG8_STAGE(PG8_SB(1, 1), cB + hstepB + kstep, voffB);
    PG8_WAIT_V(6); PG8_BAR;
    for (;;) {
        const bool has_next = S.next(ui + 1, nxt);
        const char* nA = has_next ? PG8_PA(nxt) : cA; const char* nB = has_next ? PG8_PB(nxt) : cB;
        for (int t = 0; t < nt; t += 2) {
            const bool last = (t == nt - 2);
            const char* a1 = cA + (size_t)(t + 1) * kstepA;
            const char* a2 = last ? nA : cA + (size_t)(t + 2) * kstepA; const char* b2 = last ? nB : cB + (size_t)(t + 2) * kstep;
            const char* a3 = a2 + kstepA; const char* b3 = b2 + kstep;
            PG8_LDB(B0, 0, 0); PG8_LDB(B1, 0, 1); PG8_SCHED; PG8_LDA(At, 0, 0); PG8_STAGE(PG8_SA(1, 1), a1 + hstepA, voffA);
            PG8_WAIT_V(8); PG8_WAIT_L(0); PG8_BAR; PG8_MMA(0, 0, At, B0); PG8_MMA(0, 1, At, B1); PG8_BAR; PG8_SCHED;
            PG8_LDA(At, 0, 1); PG8_STAGE(PG8_SB(0, 0), b2, voffB); PG8_STAGE(PG8_SB(0, 1), b2 + hstepB, voffB); PG8_STAGE(PG8_SA(0, 0), a2, voffA);
            PG8_WAIT_V(8); PG8_WAIT_L(0); PG8_BAR; PG8_MMA(1, 0, At, B0); PG8_MMA(1, 1, At, B1); PG8_BAR; PG8_SCHED;
            PG8_LDB(B0, 1, 0); PG8_LDB(B1, 1, 1); PG8_SCHED; PG8_LDA(At, 1, 0); PG8_STAGE(PG8_SA(0, 1), a2 + hstepA, voffA);
            PG8_WAIT_V(8); PG8_WAIT_L(0); PG8_BAR; PG8_MMA(0, 0, At, B0); PG8_MMA(0, 1, At, B1); PG8_BAR; PG8_SCHED;
            PG8_LDA(At, 1, 1); PG8_STAGE(PG8_SB(1, 0), b3, voffB); PG8_STAGE(PG8_SB(1, 1), b3 + hstepB, voffB); PG8_STAGE(PG8_SA(1, 0), a3, voffA);
            PG8_WAIT_V(8); PG8_WAIT_L(0); PG8_BAR; PG8_MMA(1, 0, At, B0); PG8_MMA(1, 1, At, B1); PG8_BAR; PG8_SCHED;
        }
        if (wr == 0) PG8_BAR;
        bool keep = false;
        if constexpr (Epi::HAS_MID) keep = (cur.h == 0);
        if constexpr (Epi::HAS_MID) { if (keep) E.mid(acc, cur, wr, wc, fr, fq); else E(acc, cur, wr, wc, fr, fq); }
        else E(acc, cur, wr, wc, fr, fq);
        if (!has_next) break;
        if (!keep)
#pragma unroll
        for (int a = 0; a < 2; ++a)
#pragma unroll
            for (int b = 0; b < 2; ++b)
#pragma unroll
                for (int m = 0; m < 4; ++m)
#pragma unroll
                    for (int n = 0; n < 2; ++n) acc[a][b][m][n] = (f32x4){0.f, 0.f, 0.f, 0.f};
        cur = nxt; cA = nA; cB = nB; ++ui;
        if (wr == 1) PG8_BAR;
    }
    PG8_WAIT_V(0);
    PG8_BAR;
#undef PG8_SA
#undef PG8_SB
#undef PG8_STAGE
#undef PG8_LDA
#undef PG8_LDB
#undef PG8_MMA
#undef PG8_WAIT_V
#undef PG8_WAIT_L
#undef PG8_BAR
#undef PG8_SCHED
#undef PG8_PA
#undef PG8_PB
}
}
using pg8::Unit;

typedef f32x4 Acc[2][2][4][2];

__device__ __forceinline__ u32x4 pack8(const f32x4 v0, const f32x4 v1) {
    u32x4 w; w.x = cvt_pk_bf16(v0[0], v0[1]); w.y = cvt_pk_bf16(v0[2], v0[3]); w.z = cvt_pk_bf16(v1[0], v1[1]); w.w = cvt_pk_bf16(v1[2], v1[3]); return w;
}

struct EpiInProj {
    static constexpr bool HAS_MID = false;
    bf16_t* Kb; bf16_t* VTb; bf16_t* Qb; float* Gb; bf16_t* AB; bf16_t* MG; const float* biasp; const float* convw;
    __device__ __forceinline__ void operator()(Acc& acc, const Unit& u, int wr, int wc, int fr, int fq) const {
        if (u.sw) {
            const int r0 = u.pm * 256 + wr * 64 + fr, t0 = u.pn * 256 + wc * 32 + 8 * fq;
#pragma unroll
            for (int ai = 0; ai < 2; ++ai)
#pragma unroll
                for (int m = 0; m < 4; ++m) { const int wrow = r0 + ai * 128 + m * 16; const float bs = biasp[wrow]; bf16_t* rowp = VTb + (size_t)(wrow - 768) * MALL + t0;
#pragma unroll
                    for (int bj = 0; bj < 2; ++bj) *(u32x4*)(rowp + bj * 128) = pack8(acc[ai][bj][m][0] + bs, acc[ai][bj][m][1] + bs); }
            return;
        }
        const int row0 = u.pm * 256 + wr * 64 + fr, pn = u.pn;
        const int cb = pn * 256 + wc * 32 + 8 * fq;
        if (pn == 2) {
            if (wc == 0) {
                const f32x4 b0 = *(const f32x4*)(biasp + cb), b1 = *(const f32x4*)(biasp + cb + 4);
#pragma unroll
                for (int ai = 0; ai < 2; ++ai)
#pragma unroll
                    for (int m = 0; m < 4; ++m) { float* gp = Gb + (size_t)(8 * fq) * MALL + (row0 + ai * 128 + m * 16);
                        f32x4 g0 = acc[ai][0][m][0] + b0, g1 = acc[ai][0][m][1] + b1;
                        if (fq >= 2) {
#pragma unroll
                            for (int j = 0; j < 4; ++j) { g0[j] = logsig(g0[j]); g1[j] = logsig(g1[j]); } }
#pragma unroll
                        for (int j = 0; j < 4; ++j) { gp[(size_t)j * MALL] = g0[j]; gp[(size_t)(4 + j) * MALL] = g1[j]; } }
            }
            return;
        }
        if (pn >= 9 && pn < 25) {
            const int ch = 64 * (pn - 9) + 16 * wc + 4 * fq;
            const f32x4 bX = *(const f32x4*)(biasp + cb), bC = *(const f32x4*)(biasp + cb + 4), bB = *(const f32x4*)(biasp + cb + 128), bO = *(const f32x4*)(biasp + cb + 132);
            const f32x4 w0 = *(const f32x4*)(convw + ch), w1 = *(const f32x4*)(convw + 1024 + ch), w2 = *(const f32x4*)(convw + 2048 + ch);
#pragma unroll
            for (int ai = 0; ai < 2; ++ai) {
                f32x4 uu[4];
#pragma unroll
                for (int m = 0; m < 4; ++m) uu[m] = (acc[ai][0][m][0] + bX) * (acc[ai][0][m][1] + bC);
#pragma unroll
                for (int m = 0; m < 4; ++m) {
                    f32x4 pv, nx;
#pragma unroll
                    for (int j = 0; j < 4; ++j) {
                        const float pold = (m > 0) ? dppf<0x121>(0.f, uu[m > 0 ? m - 1 : 0][j]) : 0.f;
                        pv[j] = dppf<0x111>(pold, uu[m][j]);
                        const float nold = (m < 3) ? dppf<0x12F>(0.f, uu[m < 3 ? m + 1 : 3][j]) : 0.f;
                        nx[j] = dppf<0x101>(nold, uu[m][j]);
                    }
                    const f32x4 cv = w0 * pv + w1 * uu[m] + w2 * nx;
                    const f32x4 aa = (acc[ai][1][m][0] + bB) * cv;
                    f32x4 os = acc[ai][1][m][1] + bO;
#pragma unroll
                    for (int j = 0; j < 4; ++j) os[j] = sigm(os[j]);
                    bf16_t* rp = AB + (size_t)(row0 + ai * 128 + m * 16) * 2048 + ch;
                    u32x2 wa, wo; wa.x = cvt_pk_bf16(aa[0], aa[1]); wa.y = cvt_pk_bf16(aa[2], aa[3]); wo.x = cvt_pk_bf16(os[0], os[1]); wo.y = cvt_pk_bf16(os[2], os[3]);
                    *(u32x2*)rp = wa; *(u32x2*)(rp + 1024) = wo;
                }
            }
            return;
        }
        if (pn >= 25) {
            const int ch = 128 * (pn - 25) + 32 * wc + 8 * fq;
            f32x4 ba[2], bb[2];
#pragma unroll
            for (int n = 0; n < 2; ++n) { ba[n] = *(const f32x4*)(biasp + cb + 4 * n); bb[n] = *(const f32x4*)(biasp + cb + 128 + 4 * n); }
#pragma unroll
            for (int ai = 0; ai < 2; ++ai)
#pragma unroll
                for (int m = 0; m < 4; ++m) { bf16_t* rp = MG + (size_t)(row0 + ai * 128 + m * 16) * 2048 + ch;
                    f32x4 rr[2], gg[2];
#pragma unroll
                    for (int n = 0; n < 2; ++n) { const f32x4 xa = acc[ai][0][m][n] + ba[n], xb = acc[ai][1][m][n] + bb[n];
#pragma unroll
                        for (int j = 0; j < 4; ++j) { const float ea = 1.f + __expf(-xa[j]), eb = 1.f + __expf(-xb[j]); rr[n][j] = eb * __builtin_amdgcn_rcpf(ea); gg[n][j] = __builtin_amdgcn_rcpf(eb); } }
                    *(u32x4*)rp = pack8(rr[0], rr[1]); *(u32x4*)(rp + 1024) = pack8(gg[0], gg[1]); }
            return;
        }
        bf16_t* base; int ldc, col0, mode;
        if (pn < 2) { base = Kb; ldc = 512; col0 = pn * 256; mode = 0; }
        else { base = Qb; ldc = 512; col0 = (pn - 7) * 256; mode = 1; }
        col0 += wc * 32 + 8 * fq;
        f32x4 bv[2][2];
#pragma unroll
        for (int bj = 0; bj < 2; ++bj)
#pragma unroll
            for (int n = 0; n < 2; ++n) bv[bj][n] = *(const f32x4*)(biasp + cb + bj * 128 + 4 * n);
#pragma unroll
        for (int ai = 0; ai < 2; ++ai)
#pragma unroll
            for (int m = 0; m < 4; ++m) { bf16_t* rowp = base + (size_t)(row0 + ai * 128 + m * 16) * ldc + col0;
#pragma unroll
                for (int bj = 0; bj < 2; ++bj) { f32x4 v0 = acc[ai][bj][m][0] + bv[bj][0], v1 = acc[ai][bj][m][1] + bv[bj][1];
                    if (mode == 0) { v0 = v0 * 0.125f; v1 = v1 * 0.125f; }
                    *(u32x4*)(rowp + bj * 128) = pack8(v0, v1); } }
    }
};

struct EpiG2 {
    static constexpr bool HAS_MID = true;
    const bf16_t* MG; bf16_t* MRG;
    __device__ __forceinline__ void mid(Acc& acc, const Unit& u, int wr, int wc, int fr, int fq) const {
        const int row0 = u.pm * 256 + wr * 64 + fr, col0 = u.pn * 256 + wc * 32 + 8 * fq;
#pragma unroll
        for (int ai = 0; ai < 2; ++ai) {
            u32x4 rr[4][2];
#pragma unroll
            for (int m = 0; m < 4; ++m)
#pragma unroll
                for (int bj = 0; bj < 2; ++bj) rr[m][bj] = __builtin_nontemporal_load((const u32x4*)(MG + (size_t)(row0 + ai * 128 + m * 16) * 2048 + col0 + bj * 128));
#pragma unroll
            for (int m = 0; m < 4; ++m)
#pragma unroll
                for (int bj = 0; bj < 2; ++bj) { const u32x4 q = rr[m][bj];
                    const f32x4 r0 = {bf_lo(q.x), bf_hi(q.x), bf_lo(q.y), bf_hi(q.y)}, r1 = {bf_lo(q.z), bf_hi(q.z), bf_lo(q.w), bf_hi(q.w)};
                    acc[ai][bj][m][0] = acc[ai][bj][m][0] * r0; acc[ai][bj][m][1] = acc[ai][bj][m][1] * r1; }
            asm volatile("" ::: "memory");
        }
    }
    __device__ __forceinline__ void operator()(Acc& acc, const Unit& u, int wr, int wc, int fr, int fq) const {
        const int row0 = u.pm * 256 + wr * 64 + fr, col0 = u.pn * 256 + wc * 32 + 8 * fq;
#pragma unroll
        for (int ai = 0; ai < 2; ++ai) {
            u32x4 gg[4][2];
#pragma unroll
            for (int m = 0; m < 4; ++m)
#pragma unroll
                for (int bj = 0; bj < 2; ++bj) gg[m][bj] = __builtin_nontemporal_load((const u32x4*)(MG + (size_t)(row0 + ai * 128 + m * 16) * 2048 + col0 + bj * 128 + 1024));
#pragma unroll
            for (int m = 0; m < 4; ++m)
#pragma unroll
                for (int bj = 0; bj < 2; ++bj) { const u32x4 gb = gg[m][bj];
                    const f32x4 g0 = {bf_lo(gb.x), bf_hi(gb.x), bf_lo(gb.y), bf_hi(gb.y)}, g1 = {bf_lo(gb.z), bf_hi(gb.z), bf_lo(gb.w), bf_hi(gb.w)};
                    *(u32x4*)(MRG + (size_t)(row0 + ai * 128 + m * 16) * 1024 + col0 + bj * 128) = pack8(acc[ai][bj][m][0] * g0, acc[ai][bj][m][1] * g1); }
            asm volatile("" ::: "memory");
        }
    }
};
struct EpiRes {
    static constexpr bool HAS_MID = false;
    const float* base; float* out; const float* gate;
    __device__ __forceinline__ void operator()(Acc& acc, const Unit& u, int wr, int wc, int fr, int fq) const {
        const int row0 = u.pm * 256 + wr * 64 + fr, col0 = u.pn * 256 + wc * 32 + 8 * fq;
        const float* gp = gate + (size_t)((u.pm * 256) >> 11) * 6144 + col0;
        f32x4 gv[2][2];
#pragma unroll
        for (int bj = 0; bj < 2; ++bj)
#pragma unroll
            for (int n = 0; n < 2; ++n) gv[bj][n] = *(const f32x4*)(gp + bj * 128 + 4 * n);
#pragma unroll
        for (int ai = 0; ai < 2; ++ai)
#pragma unroll
            for (int m = 0; m < 4; ++m) { const size_t off = (size_t)(row0 + ai * 128 + m * 16) * 1024 + col0;
#pragma unroll
                for (int bj = 0; bj < 2; ++bj)
#pragma unroll
                    for (int n = 0; n < 2; ++n) { const f32x4 bs = *(const f32x4*)(base + off + bj * 128 + 4 * n);
                        *(f32x4*)(out + off + bj * 128 + 4 * n) = bs + gv[bj][n] * acc[ai][bj][m][n]; } }
    }
};
template <int mode> struct EpiResNorm {
    static constexpr bool HAS_MID = false;
    const float* base; float* out; const float* gate; int mode_unused;
    bf16_t* h2; const float* nw; const float* mod;
    bf16_t* x1b;
    float* xbuf; unsigned* cnt; LAS unsigned char* xl;
    __device__ __forceinline__ void operator()(Acc& acc, const Unit& u, int wr, int wc, int fr, int fq) const {
        const int wid = wr * 4 + wc, lane = fq * 16 + fr;
        const int row0 = u.pm * 256 + wr * 64 + fr, col0 = u.pn * 256 + wc * 32 + 8 * fq, bb = (u.pm * 256) >> 11;
        {
            const float* gp = gate + (size_t)bb * 6144 + col0;
            f32x4 gv[2][2];
#pragma unroll
            for (int bj = 0; bj < 2; ++bj)
#pragma unroll
                for (int n = 0; n < 2; ++n) gv[bj][n] = *(const f32x4*)(gp + bj * 128 + 4 * n);
#pragma unroll
            for (int ai = 0; ai < 2; ++ai)
#pragma unroll
                for (int m = 0; m < 4; ++m) { const size_t off = (size_t)(row0 + ai * 128 + m * 16) * 1024 + col0;
#pragma unroll
                    for (int bj = 0; bj < 2; ++bj) {
                        if (mode == 1) { const u32x4 q = __builtin_nontemporal_load((const u32x4*)(x1b + off + bj * 128));
                            const f32x4 b0 = {bf_lo(q.x), bf_hi(q.x), bf_lo(q.y), bf_hi(q.y)}, b1 = {bf_lo(q.z), bf_hi(q.z), bf_lo(q.w), bf_hi(q.w)};
                            acc[ai][bj][m][0] = b0 + gv[bj][0] * acc[ai][bj][m][0]; acc[ai][bj][m][1] = b1 + gv[bj][1] * acc[ai][bj][m][1]; }
                        else {
#pragma unroll
                            for (int n = 0; n < 2; ++n) { const f32x4 bs = __builtin_nontemporal_load((const f32x4*)(base + off + bj * 128 + 4 * n)); acc[ai][bj][m][n] = bs + gv[bj][n] * acc[ai][bj][m][n]; } }
                    }
                    asm volatile("" : "+v"(acc[ai][0][m][0]), "+v"(acc[ai][0][m][1]), "+v"(acc[ai][1][m][0]), "+v"(acc[ai][1][m][1]));
                    if (m & 1) asm volatile("" ::: "memory"); }
        }
        LAS float* P = (LAS float*)xl; LAS float* S = (LAS float*)(xl + 4096);
#pragma unroll
        for (int ai = 0; ai < 2; ++ai)
#pragma unroll
            for (int m = 0; m < 4; ++m) { float q = 0.f;
#pragma unroll
                for (int bj = 0; bj < 2; ++bj)
#pragma unroll
                    for (int n = 0; n < 2; ++n) { const f32x4 x = acc[ai][bj][m][n]; q += (x[0] * x[0] + x[1] * x[1]) + (x[2] * x[2] + x[3] * x[3]); }
                q += __shfl_xor(q, 16); q += __shfl_xor(q, 32);
                if (fq == 0) P[(ai * 128 + wr * 64 + m * 16 + fr) * 4 + wc] = q; }
        asm volatile("s_waitcnt lgkmcnt(0)\n\ts_barrier" ::: "memory");
        const int row = wid * 32 + (lane & 31);
        if (lane < 32) { const float tot = (P[row * 4 + 0] + P[row * 4 + 1]) + (P[row * 4 + 2] + P[row * 4 + 3]);
            __hip_atomic_store(xbuf + (size_t)(u.pm * 256 + row) * 4 + u.pn, tot, __ATOMIC_RELAXED, __HIP_MEMORY_SCOPE_AGENT); }
        asm volatile("s_waitcnt vmcnt(0)" ::: "memory");
        if (lane == 0) __hip_atomic_fetch_add(cnt + 64 * u.pm, 1u, __ATOMIC_RELAXED, __HIP_MEMORY_SCOPE_AGENT);
        if (wid == 0) {
            unsigned sp = 0;
            while ((unsigned)__builtin_amdgcn_readfirstlane(__hip_atomic_load(cnt + 64 * u.pm, __ATOMIC_RELAXED, __HIP_MEMORY_SCOPE_AGENT)) < 32u) { __builtin_amdgcn_s_sleep(2); if (++sp > (1u << 20)) break; }
            __builtin_amdgcn_fence(__ATOMIC_ACQUIRE, "agent");
        }
        asm volatile("s_waitcnt vmcnt(0) lgkmcnt(0)\n\ts_barrier" ::: "memory");
        if (lane < 32) { const float* sl = xbuf + (size_t)(u.pm * 256 + row) * 4; float t = 0.f;
#pragma unroll
            for (int k = 0; k < 4; ++k) t += __hip_atomic_load(sl + k, __ATOMIC_RELAXED, __HIP_MEMORY_SCOPE_AGENT);
            S[row] = rsqrtf(t * (1.f / 1024.f) + EPS); }
        asm volatile("s_waitcnt vmcnt(0) lgkmcnt(0)\n\ts_barrier" ::: "memory");
#pragma unroll
        for (int bj = 0; bj < 2; ++bj) {
            const int c = col0 + bj * 128;
            f32x4 w0 = *(const f32x4*)(nw + c), w1 = *(const f32x4*)(nw + c + 4), h0 = (f32x4){0.f, 0.f, 0.f, 0.f}, h1 = h0;
            if (mode == 0) { const float* mb = mod + (size_t)bb * 6144 + c; w0 = w0 * (*(const f32x4*)(mb + 4096) + 1.f); w1 = w1 * (*(const f32x4*)(mb + 4100) + 1.f); h0 = *(const f32x4*)(mb + 3072); h1 = *(const f32x4*)(mb + 3076); }
#pragma unroll
            for (int ai = 0; ai < 2; ++ai)
#pragma unroll
                for (int m = 0; m < 4; ++m) { asm volatile("" ::: "memory"); const int rl = ai * 128 + wr * 64 + m * 16 + fr; const float r = S[rl]; const size_t off = (size_t)(u.pm * 256 + rl) * 1024 + c;
                    const f32x4 v0 = acc[ai][bj][m][0], v1 = acc[ai][bj][m][1];
                    if (mode == 0) { *(u32x4*)(x1b + off) = pack8(v0, v1); *(u32x4*)(h2 + off) = pack8((v0 * r) * w0 + h0, (v1 * r) * w1 + h1); }
                    else { *(f32x4*)(out + off) = (v0 * r) * w0; *(f32x4*)(out + off + 4) = (v1 * r) * w1; } }
        }
    }
};
struct EpiRelu2 {
    static constexpr bool HAS_MID = false;
    bf16_t* O; int ldc;
    __device__ __forceinline__ void operator()(Acc& acc, const Unit& u, int wr, int wc, int fr, int fq) const {
        const int row0 = u.pm * 256 + wr * 64 + fr, col0 = u.pn * 256 + wc * 32 + 8 * fq;
#pragma unroll
        for (int ai = 0; ai < 2; ++ai)
#pragma unroll
            for (int m = 0; m < 4; ++m) { const int row = row0 + ai * 128 + m * 16;
#pragma unroll
                for (int bj = 0; bj < 2; ++bj) { f32x4 v0 = acc[ai][bj][m][0], v1 = acc[ai][bj][m][1]; const int col = col0 + bj * 128;
                    bf16_t* rowp = O + ((size_t)(row >> 7) * (ldc >> 6) + (col >> 6)) * 8192 + (row & 127) * 64 + (col & 63) - bj * 128;
#pragma unroll
                    for (int j = 0; j < 4; ++j) { const float a = fmaxf(v0[j], 0.f), b = fmaxf(v1[j], 0.f); v0[j] = a * a; v1[j] = b * b; }
                    __builtin_nontemporal_store(pack8(v0, v1), (u32x4*)(rowp + bj * 128)); } }
    }
};

__device__ __forceinline__ int inproj_colmap(int n) {
    if (n < 512) return OFF_K + n;
    if (n < 768) { const int j = n - 512; return j < 32 ? OFF_IG + j : -1; }
    if (n < 1792) return OFF_V + (n - 768);
    if (n < 2304) return OFF_Q + (n - 1792);
    if (n < 6400) { const int lc = (n - 2304) & 255, jt = (n - 2304) >> 8, bj = lc >> 7, wc = (lc >> 5) & 3, fq = (lc >> 3) & 3, nn = (lc >> 2) & 1, jj = lc & 3;
        const int seg = 2 * bj + nn, ch = 64 * jt + 16 * wc + 4 * fq + jj;
        return (seg == 0 ? OFF_XIN : seg == 1 ? OFF_GC : seg == 2 ? OFF_GB : OFF_O) + ch; }
    { const int lc = (n - 6400) & 255, jt = (n - 6400) >> 8; return OFF_MRG + (lc >> 7) * 1024 + 128 * jt + (lc & 127); }
}
struct TrItem { const float* W; bf16_t* out; int ldw, nblk, ldo, kofs, item, map; };
__device__ __forceinline__ void tr_load(const TrItem& t, int lane, f32x4 (&v)[8]) {
    const int kb = t.item / t.nblk, nb = t.item % t.nblk, k0 = 64 * kb, n0 = 32 * nb;
    const int n4 = lane & 7, kr = lane >> 3;
    const int nn = n0 + 4 * n4; const int src = t.map ? inproj_colmap(nn) : nn;
#pragma unroll
    for (int it = 0; it < 8; ++it) v[it] = (src >= 0) ? __builtin_nontemporal_load((const f32x4*)(t.W + (size_t)(k0 + 8 * it + kr) * t.ldw + src)) : (f32x4){0.f, 0.f, 0.f, 0.f};
}
__device__ __forceinline__ void tr_finish(const TrItem& t, int lane, const f32x4 (&v)[8], LAS float* scr) {
    const int kb = t.item / t.nblk, nb = t.item % t.nblk, k0 = 64 * kb, n0 = 32 * nb;
    const int n4 = lane & 7, kr = lane >> 3;
#pragma unroll
    for (int it = 0; it < 8; ++it) { LAS float* d = scr + (8 * it + kr) * 33 + 4 * n4; d[0] = v[it][0]; d[1] = v[it][1]; d[2] = v[it][2]; d[3] = v[it][3]; }
    asm volatile("s_waitcnt lgkmcnt(0)" ::: "memory");
    const int c = lane & 7;
#pragma unroll
    for (int j = 0; j < 4; ++j) { const int n = (lane >> 3) + 8 * j; const LAS float* s = scr + (8 * c) * 33 + n;
        u32x4 o; o.x = cvt_pk_bf16(s[0 * 33], s[1 * 33]); o.y = cvt_pk_bf16(s[2 * 33], s[3 * 33]); o.z = cvt_pk_bf16(s[4 * 33], s[5 * 33]); o.w = cvt_pk_bf16(s[6 * 33], s[7 * 33]);
        *(u32x4*)(t.out + (size_t)(n0 + n) * t.ldo + t.kofs + k0 + 8 * c) = o; }
    asm volatile("s_waitcnt lgkmcnt(0)" ::: "memory");
}

struct Args { const float* in[18]; float* out; unsigned char* ws; int ph_lo, ph_hi; };
enum { I_X = 0, I_C, I_CTX, I_CCTX, I_WMOD, I_BMOD, I_N1W, I_WIN, I_BIN, I_CONVW, I_MNW, I_WCO, I_WMO, I_WOUT, I_N2W, I_WFF1, I_WFF2, I_FNW };

__device__ __forceinline__ void p0_mod(const Args& A, LAS unsigned char* lds, int tid, int lane, int wave, unsigned* modcnt) {
    unsigned char* ws = A.ws;
    LAS float* sl = (LAS float*)lds;
    LAS float* red = (LAS float*)(lds + 17 * 4096);
    bool filled = false; unsigned done = 0;
    for (int item = blockIdx.x; item < 6144 / 32; item += gridDim.x) {
        if (!filled) {
            float cv[34];
#pragma unroll
            for (int j = 0; j < 34; ++j) { const int i = tid + 512 * j; cv[j] = i < 16 * 1024 ? A.in[I_C][i] : A.in[I_CCTX][i - 16 * 1024]; }
#pragma unroll
            for (int j = 0; j < 34; ++j) sl[tid + 512 * j] = cv[j] * sigm(cv[j]);
            __syncthreads(); filled = true;
        }
        const int col = lane & 31, kh = lane >> 5, n0 = item * 32, kbase = 128 * wave + 64 * kh;
        float a[17];
#pragma unroll
        for (int r = 0; r < 17; ++r) a[r] = 0.f;
        const float* wp = A.in[I_WMOD] + (size_t)kbase * 6144 + n0 + col;
        float wv[64];
#pragma unroll
        for (int j = 0; j < 64; ++j) wv[j] = __builtin_nontemporal_load(wp + (size_t)j * 6144);
#pragma unroll
        for (int i = 0; i < 64; i += 8) {
#pragma unroll
            for (int r = 0; r < 17; ++r) { const f32x4 s4 = *(const LAS f32x4*)(sl + r * 1024 + kbase + i), s5 = *(const LAS f32x4*)(sl + r * 1024 + kbase + i + 4);
                a[r] += (s4[0] * wv[i + 0] + s4[1] * wv[i + 1]) + (s4[2] * wv[i + 2] + s4[3] * wv[i + 3]) + (s5[0] * wv[i + 4] + s5[1] * wv[i + 5]) + (s5[2] * wv[i + 6] + s5[3] * wv[i + 7]); }
        }
#pragma unroll
        for (int r = 0; r < 17; ++r) red[((wave * 2 + kh) * 17 + r) * 32 + col] = a[r];
        __syncthreads();
        for (int o = tid; o < 17 * 32; o += 512) { const int r = o >> 5, cc = o & 31; float s = A.in[I_BMOD][n0 + cc];
#pragma unroll
            for (int p = 0; p < 16; ++p) s += red[(p * 17 + r) * 32 + cc];
            ((float*)(ws + WS_MOD))[r * 6144 + n0 + cc] = s; }
        asm volatile("s_waitcnt vmcnt(0)" ::: "memory");
        __syncthreads();
        ++done;
    }
    if (done && tid == 0) { __builtin_amdgcn_fence(__ATOMIC_RELEASE, "agent"); asm volatile("s_waitcnt vmcnt(0)" ::: "memory"); __hip_atomic_fetch_add(modcnt, done, __ATOMIC_RELAXED, __HIP_MEMORY_SCOPE_AGENT); }
}
__device__ __forceinline__ void p0_weights(const Args& A, LAS unsigned char* lds, int tid, int lane, int wave) {
    unsigned char* ws = A.ws;
    LAS float* scr = (LAS float*)(lds + wave * 16384);
    const int gw = blockIdx.x * 8 + wave, NGW = gridDim.x * 8;
    constexpr int IT_WIN = 16 * (NIN / 32), IT_SQ = 16 * 32, IT_W1 = 16 * 128, IT_W2 = 64 * 32;
    constexpr int NITEMS = IT_WIN + 3 * IT_SQ + IT_W1 + IT_W2;
    auto mk = [&](int it) -> TrItem {
        int r = it;
        if (r < IT_WIN) return TrItem{A.in[I_WIN], (bf16_t*)(ws + WS_WIN), DIN, NIN / 32, 1024, 0, r, 1}; r -= IT_WIN;
        if (r < IT_SQ) return TrItem{A.in[I_WCO], (bf16_t*)(ws + WS_BT2), 1024, 32, 2048, 0, r, 0}; r -= IT_SQ;
        if (r < IT_SQ) return TrItem{A.in[I_WMO], (bf16_t*)(ws + WS_BT2), 1024, 32, 2048, 1024, r, 0}; r -= IT_SQ;
        if (r < IT_SQ) return TrItem{A.in[I_WOUT], (bf16_t*)(ws + WS_WO), 1024, 32, 1024, 0, r, 0}; r -= IT_SQ;
        if (r < IT_W1) return TrItem{A.in[I_WFF1], (bf16_t*)(ws + WS_W1), 4096, 128, 1024, 0, r, 0}; r -= IT_W1;
        return TrItem{A.in[I_WFF2], (bf16_t*)(ws + WS_W2), 1024, 32, F1P, 0, r, 0};
    };
    if (gw < NITEMS) {
        f32x4 va[8], vb[8];
        TrItem cur = mk(gw); tr_load(cur, lane, va);
        for (int it = gw; it < NITEMS; it += 2 * NGW) {
            const bool h1 = it + NGW < NITEMS, h2 = it + 2 * NGW < NITEMS;
            TrItem nx = cur; if (h1) { nx = mk(it + NGW); tr_load(nx, lane, vb); }
            tr_finish(cur, lane, va, scr);
            if (!h1) break;
            if (h2) { cur = mk(it + 2 * NGW); tr_load(cur, lane, va); }
            tr_finish(nx, lane, vb, scr);
        }
    }
    for (int i = blockIdx.x * 512 + tid; i < NIN; i += gridDim.x * 512) { const int s = inproj_colmap(i); ((float*)(ws + WS_BIASP))[i] = s >= 0 ? A.in[I_BIN][s] : 0.f; }
}

__device__ __forceinline__ float wave_allsum(float x) { return lane63(wave_scan_add(x)); }
__device__ __forceinline__ void modulate_rows4(const float* xrow, const float* w, const float* sh, const float* sc, bf16_t* orow, int lane) {
    f32x4 v[4][4]; float r[4];
#pragma unroll
    for (int q = 0; q < 4; ++q)
#pragma unroll
        for (int j = 0; j < 4; ++j) v[q][j] = __builtin_nontemporal_load((const f32x4*)(xrow + (size_t)q * DM) + lane + 64 * j);
#pragma unroll
    for (int q = 0; q < 4; ++q) { float s = 0.f;
#pragma unroll
        for (int j = 0; j < 4; ++j) s += (v[q][j].x * v[q][j].x + v[q][j].y * v[q][j].y) + (v[q][j].z * v[q][j].z + v[q][j].w * v[q][j].w);
        r[q] = rsqrtf(wave_allsum(s) * (1.f / DM) + EPS); }
#pragma unroll
    for (int j = 0; j < 4; ++j) { const f32x4 ww = ((const f32x4*)w)[lane + 64 * j], hh = ((const f32x4*)sh)[lane + 64 * j], cc = ((const f32x4*)sc)[lane + 64 * j];
        const f32x4 wc = ww * (cc + 1.f);
#pragma unroll
        for (int q = 0; q < 4; ++q) { const f32x4 y = (v[q][j] * r[q]) * wc + hh;
            u32x2 p; p.x = cvt_pk_bf16(y[0], y[1]); p.y = cvt_pk_bf16(y[2], y[3]); ((u32x2*)(orow + (size_t)q * DM))[lane + 64 * j] = p; } }
}

constexpr int L_QS = 0, L_KS = 18432, L_KTS = 36864, L_VTS = 54272, L_SS = 93440, L_CS = 128256, L_GW = 148992;
static_assert(L_GW + 8 * 512 <= LDS_BYTES, "mlstm LDS map");
#define BAR_LDS() asm volatile("s_waitcnt lgkmcnt(0)\n\ts_barrier" ::: "memory")

__device__ __forceinline__ void mlstm_seq(LAS unsigned char* lds, const bf16_t* Kb, const bf16_t* VTb, const bf16_t* Qb, const float* Gb, bf16_t* HD0, bf16_t* HD1, int seq, int tid, int lane, int w) {
    const int dir = seq >> 7, b = (seq >> 3) & 15, head = seq & 7;
    const int g = lane >> 4, l15 = lane & 15;
    bf16_t* HD = dir ? HD1 : HD0;
    for (int i = tid; i < 16 * 136; i += 512) { const int r = i / 136, cidx = i % 136; *(LAS bf16_t*)(lds + L_VTS + (128 + r) * 272 + cidx * 2) = (r == 0) ? (bf16_t)0x3F80 : (bf16_t)0; }
    const int tb = (w < 4) ? 2 * w : 15 - 2 * w;
    f32x4 st[4], nst;
#pragma unroll
    for (int i = 0; i < 4; ++i) st[i] = (f32x4){0.f, 0.f, 0.f, 0.f};
    nst = (f32x4){0.f, 0.f, 0.f, 0.f};
    float mstate = 0.f;
    u32x4 pq[2], pk[2], pv[4]; float gi0, gi1, gf0, gf1;
    unsigned offq[2], offv[4], offg0, offg1;
#pragma unroll
    for (int i = 0; i < 2; ++i) { const int p = tid + 512 * i, row = p >> 3, pc = p & 7; offq[i] = (unsigned)((dir ? 127 - row : row) * 512 + head * 64 + pc * 8); }
#pragma unroll
    for (int i = 0; i < 4; ++i) { const int p = tid + 512 * i, v = p >> 4, pc = p & 15; offv[i] = (unsigned)((head * 128 + v) * MALL + pc * 8); }
    offg0 = (unsigned)((dir * 8 + head) * MALL + (dir ? 127 - lane : lane)); offg1 = (unsigned)((dir * 8 + head) * MALL + (dir ? 63 - lane : lane + 64));
#define PREFETCH(cc) do { const int cc_ = (cc); const bool isctx_ = cc_ < 2; const int T_ = isctx_ ? CTXL : SEQ, c_ = isctx_ ? cc_ : cc_ - 2; \
        const int base_ = isctx_ ? MTOK + b * CTXL : b * SEQ; const int tok0_ = base_ + (dir ? T_ - 128 * (c_ + 1) : 128 * c_); \
        const bf16_t* qb_ = Qb + (size_t)tok0_ * 512; const bf16_t* kb_ = Kb + (size_t)tok0_ * 512; const bf16_t* vb_ = VTb + tok0_; const float* gb_ = Gb + tok0_; \
        if (!isctx_) { _Pragma("unroll") for (int i = 0; i < 2; ++i) pq[i] = *(const u32x4*)(qb_ + offq[i]); } \
        _Pragma("unroll") for (int i = 0; i < 2; ++i) pk[i] = *(const u32x4*)(kb_ + offq[i]); \
        _Pragma("unroll") for (int i = 0; i < 4; ++i) pv[i] = *(const u32x4*)(vb_ + offv[i]); \
        gi0 = gb_[offg0]; gf0 = gb_[offg0 + 16 * MALL]; gi1 = gb_[offg1]; gf1 = gb_[offg1 + 16 * MALL]; \
    } while (0)
    PREFETCH(0);
    for (int cc = 0; cc < 18; ++cc) {
        const bool isctx = cc < 2; const int T_ = isctx ? CTXL : SEQ, c_ = isctx ? cc : cc - 2;
        const int tok0 = (isctx ? MTOK + b * CTXL : b * SEQ) + (dir ? T_ - 128 * (c_ + 1) : 128 * c_);
        const float b0 = wave_scan_add(gf0), b1 = wave_scan_add(gf1) + lane63(b0);
        const float a0 = gi0 - b0, a1 = gi1 - b1;
        const float Mc = fmaxf(mstate, lane63(wave_scan_max(fmaxf(a0, a1))));
        const float e0 = __expf(a0 - Mc), e1 = __expf(a1 - Mc), th0 = __expf(-b0 - Mc), th1 = __expf(-b1 - Mc);
        const float decay = __expf(mstate - Mc);
        mstate = lane63(b1) + Mc;
#pragma unroll
        for (int db = 0; db < 4; ++db) { st[db] = st[db] * decay; u32x2 p; p.x = cvt_pk_bf16(st[db][0], st[db][1]); p.y = cvt_pk_bf16(st[db][2], st[db][3]);
            *(LAS u32x2*)(lds + L_CS + (16 * w + l15) * 144 + (16 * db + 4 * g) * 2) = p; }
        if (w < 4) { nst = nst * decay; u32x2 p; p.x = cvt_pk_bf16(nst[0], nst[1]); p.y = cvt_pk_bf16(nst[2], nst[3]);
            *(LAS u32x2*)(lds + L_CS + (128 + l15) * 144 + (16 * w + 4 * g) * 2) = p; }
        if (!isctx) {
#pragma unroll
            for (int i = 0; i < 2; ++i) { const int p = tid + 512 * i, row = p >> 3, pc = p & 7; *(LAS u32x4*)(lds + L_QS + row * 144 + pc * 16) = pq[i]; }
        }
        {
#pragma unroll
            for (int i = 0; i < 2; ++i) { const int p = tid + 512 * i, row = p >> 3, pc = p & 7, kidx = dir ? 127 - row : row;
                const float es = __shfl(i ? e1 : e0, 8 * w + (lane >> 3));
                const int kcol = (((kidx >> 3) ^ pc) << 3) | (kidx & 7);
                const unsigned ww[4] = {pk[i].x, pk[i].y, pk[i].z, pk[i].w}; unsigned sc4[4];
#pragma unroll
                for (int q2 = 0; q2 < 4; ++q2) { const unsigned pkd = cvt_pk_bf16(bf_lo(ww[q2]) * es, bf_hi(ww[q2]) * es); sc4[q2] = pkd;
                    *(LAS bf16_t*)(lds + L_KTS + (pc * 8 + 2 * q2) * 272 + kcol * 2) = (bf16_t)(pkd & 0xffffu);
                    *(LAS bf16_t*)(lds + L_KTS + (pc * 8 + 2 * q2 + 1) * 272 + kcol * 2) = (bf16_t)(pkd >> 16); }
                *(LAS u32x4*)(lds + L_KS + row * 144 + pc * 16) = (u32x4){sc4[0], sc4[1], sc4[2], sc4[3]}; }
#pragma unroll
            for (int i = 0; i < 4; ++i) { const int p = tid + 512 * i, v = p >> 4, pc = p & 15;
                const int rho = (v & ~31) | (((v >> 2) & 1) << 4) | (((v >> 3) & 3) << 2) | (v & 3);
                *(LAS u32x4*)(lds + L_VTS + rho * 272 + pc * 16) = pv[i]; }
        }
        BAR_LDS();
        if (cc + 1 < 18 && (isctx || w < 4)) PREFETCH(cc + 1);
        if (!isctx) {
            const int trow = 16 * tb + l15;
            const int klo = dir ? ((7 - tb) >> 1) : 0, khi = dir ? 3 : (tb >> 1);
            bf16x8 qf[2];
#pragma unroll
            for (int kk = 0; kk < 2; ++kk) qf[kk] = *(const LAS bf16x8*)(lds + L_QS + trow * 144 + (kk * 32 + g * 8) * 2);
#define SB() __builtin_amdgcn_sched_barrier(0)
            f32x4 sa[8];
#pragma unroll
            for (int sp = 0; sp < 4; ++sp) {
                if (2 * sp <= tb) {
                    bf16x8 kf[2][2];
#pragma unroll
                    for (int j = 0; j < 2; ++j)
#pragma unroll
                        for (int kk = 0; kk < 2; ++kk) kf[j][kk] = *(const LAS bf16x8*)(lds + L_KS + (16 * (2 * sp + j) + l15) * 144 + (kk * 32 + g * 8) * 2);
                    SB();
#pragma unroll
                    for (int j = 0; j < 2; ++j) sa[2 * sp + j] = __builtin_amdgcn_mfma_f32_16x16x32_bf16(kf[j][0], qf[0], (f32x4){0.f, 0.f, 0.f, 0.f}, 0, 0, 0);
#pragma unroll
                    for (int j = 0; j < 2; ++j) sa[2 * sp + j] = __builtin_amdgcn_mfma_f32_16x16x32_bf16(kf[j][1], qf[1], sa[2 * sp + j], 0, 0, 0);
                    SB();
                } else { sa[2 * sp] = (f32x4){0.f, 0.f, 0.f, 0.f}; sa[2 * sp + 1] = (f32x4){0.f, 0.f, 0.f, 0.f}; }
            }
#pragma unroll
            for (int sb = 0; sb < 8; ++sb) { const int s0 = 16 * sb + 4 * g; f32x4 v = sa[sb];
#pragma unroll
                for (int r = 0; r < 4; ++r) v[r] = (s0 + r <= trow) ? v[r] : 0.f;
                u32x2 p;
                if (dir) { p.x = cvt_pk_bf16(v[3], v[2]); p.y = cvt_pk_bf16(v[1], v[0]); *(LAS u32x2*)(lds + L_SS + trow * 272 + (124 - s0) * 2) = p; }
                else { p.x = cvt_pk_bf16(v[0], v[1]); p.y = cvt_pk_bf16(v[2], v[3]); *(LAS u32x2*)(lds + L_SS + trow * 272 + s0 * 2) = p; } }
            if (cc + 1 < 18 && w >= 4) PREFETCH(cc + 1);
            f32x4 num[9];
            {
                bf16x8 c0[9];
#pragma unroll
                for (int vb = 0; vb < 9; ++vb) c0[vb] = *(const LAS bf16x8*)(lds + L_CS + (16 * vb + l15) * 144 + (g * 8) * 2);
                SB();
#pragma unroll
                for (int vb = 0; vb < 9; ++vb) num[vb] = __builtin_amdgcn_mfma_f32_16x16x32_bf16(c0[vb], qf[0], (f32x4){0.f, 0.f, 0.f, 0.f}, 0, 0, 0);
                SB();
#pragma unroll
                for (int vb = 0; vb < 9; ++vb) c0[vb] = *(const LAS bf16x8*)(lds + L_CS + (16 * vb + l15) * 144 + (32 + g * 8) * 2);
                SB();
#pragma unroll
                for (int vb = 0; vb < 9; ++vb) num[vb] = __builtin_amdgcn_mfma_f32_16x16x32_bf16(c0[vb], qf[1], num[vb], 0, 0, 0);
                SB();
            }
#pragma unroll
            for (int kk = 0; kk < 4; ++kk) {
                if (kk >= klo && kk <= khi) {
                    bf16x8 vf[9];
                    const bf16x8 sf = *(const LAS bf16x8*)(lds + L_SS + trow * 272 + (kk * 32 + g * 8) * 2);
#pragma unroll
                    for (int vb = 0; vb < 9; ++vb) vf[vb] = *(const LAS bf16x8*)(lds + L_VTS + (16 * vb + l15) * 272 + (kk * 32 + g * 8) * 2);
                    SB();
#pragma unroll
                    for (int vb = 0; vb < 9; ++vb) num[vb] = __builtin_amdgcn_mfma_f32_16x16x32_bf16(vf[vb], sf, num[vb], 0, 0, 0);
                    SB();
                }
            }
            const float den = __shfl(num[8][0], l15);
            const float thr = __shfl((tb < 4) ? th0 : th1, (16 * tb + l15) & 63);
            const float inv = 1.f / fmaxf(fabsf(den), thr);
            const int tok = tok0 + (dir ? 127 - trow : trow);
            bf16_t* hp = HD + (size_t)tok * 1024 + head * 128 + 8 * g;
#pragma unroll
            for (int vp = 0; vp < 4; ++vp) { u32x4 p; p.x = cvt_pk_bf16(num[2 * vp][0] * inv, num[2 * vp][1] * inv); p.y = cvt_pk_bf16(num[2 * vp][2] * inv, num[2 * vp][3] * inv);
                p.z = cvt_pk_bf16(num[2 * vp + 1][0] * inv, num[2 * vp + 1][1] * inv); p.w = cvt_pk_bf16(num[2 * vp + 1][2] * inv, num[2 * vp + 1][3] * inv); *(u32x4*)(hp + 32 * vp) = p; }
        }
        {
            bf16x8 vf[4], of[4];
#pragma unroll
            for (int kk = 0; kk < 4; ++kk) { vf[kk] = *(const LAS bf16x8*)(lds + L_VTS + (16 * w + l15) * 272 + (kk * 32 + g * 8) * 2);
                of[kk] = *(const LAS bf16x8*)(lds + L_VTS + (128 + l15) * 272 + (kk * 32 + g * 8) * 2); }
#pragma unroll
            for (int db = 0; db < 4; ++db) {
                bf16x8 kf[4];
#pragma unroll
                for (int kk = 0; kk < 4; ++kk) kf[kk] = *(const LAS bf16x8*)(lds + L_KTS + (16 * db + l15) * 272 + (((4 * kk + g) ^ ((2 * db + (l15 >> 3)) & 7)) << 4));
                SB();
#pragma unroll
                for (int kk = 0; kk < 4; ++kk) st[db] = __builtin_amdgcn_mfma_f32_16x16x32_bf16(kf[kk], vf[kk], st[db], 0, 0, 0);
                if (w == db) {
#pragma unroll
                    for (int kk = 0; kk < 4; ++kk) nst = __builtin_amdgcn_mfma_f32_16x16x32_bf16(kf[kk], of[kk], nst, 0, 0, 0);
                }
                SB();
            }
        }
#undef SB
        BAR_LDS();
    }
#undef PREFETCH
}

__device__ __forceinline__ void combine_rows4(const bf16_t* h0, const bf16_t* h1, bf16_t* ab, const float* nw, int lane) {
    u32x4 a[4][2], b[4][2], o[4][2];
#pragma unroll
    for (int q = 0; q < 4; ++q)
#pragma unroll
        for (int i = 0; i < 2; ++i) { const int p = lane + 64 * i;
            a[q][i] = __builtin_nontemporal_load((const u32x4*)(h0 + (size_t)q * 1024 + 8 * p)); b[q][i] = __builtin_nontemporal_load((const u32x4*)(h1 + (size_t)q * 1024 + 8 * p)); o[q][i] = __builtin_nontemporal_load((const u32x4*)(ab + (size_t)q * 2048 + 8 * p)); }
#pragma unroll
    for (int i = 0; i < 2; ++i) { const int p = lane + 64 * i;
        const f32x4 n0 = *(const f32x4*)(nw + 8 * p), n1 = *(const f32x4*)(nw + 8 * p + 4);
#pragma unroll
        for (int q = 0; q < 4; ++q) { const u32x4 aa = a[q][i], bb = b[q][i], oo = o[q][i];
            float s[8] = {bf_lo(aa.x) + bf_lo(bb.x), bf_hi(aa.x) + bf_hi(bb.x), bf_lo(aa.y) + bf_lo(bb.y), bf_hi(aa.y) + bf_hi(bb.y), bf_lo(aa.z) + bf_lo(bb.z), bf_hi(aa.z) + bf_hi(bb.z), bf_lo(aa.w) + bf_lo(bb.w), bf_hi(aa.w) + bf_hi(bb.w)};
            float ss = 0.f;
#pragma unroll
            for (int j = 0; j < 8; ++j) ss += s[j] * s[j];
            ss += dppf<0x121>(0.f, ss); ss += dppf<0x122>(0.f, ss); ss += dppf<0x124>(0.f, ss); ss += dppf<0x128>(0.f, ss);
            const float r = rsqrtf(ss * (1.f / 128.f) + EPS);
            const float og[8] = {bf_lo(oo.x), bf_hi(oo.x), bf_lo(oo.y), bf_hi(oo.y), bf_lo(oo.z), bf_hi(oo.z), bf_lo(oo.w), bf_hi(oo.w)};
            u32x4 qv;
            qv.x = cvt_pk_bf16(s[0] * r * n0[0] * og[0], s[1] * r * n0[1] * og[1]); qv.y = cvt_pk_bf16(s[2] * r * n0[2] * og[2], s[3] * r * n0[3] * og[3]);
            qv.z = cvt_pk_bf16(s[4] * r * n1[0] * og[4], s[5] * r * n1[1] * og[5]); qv.w = cvt_pk_bf16(s[6] * r * n1[2] * og[6], s[7] * r * n1[3] * og[7]);
            *(u32x4*)(ab + (size_t)q * 2048 + 8 * p) = qv; } }
}

#define XB_TMO      128
#define XB_XCNT(j)  (256  + 64 * (j))
#define XB_XSUB(j)  (1280 + 64 * (j))
#define XB_XGEN(j)  (2304 + 64 * (j))
#define XB_TOP      3328
#define XB_TOPGEN   3392
#define XCD_BAR_WORDS 3456
#define XB_SPIN_CAP (1u << 18)
__device__ __forceinline__ unsigned xb_ld(unsigned* p)              { return __hip_atomic_load(p, __ATOMIC_RELAXED, __HIP_MEMORY_SCOPE_AGENT); }
__device__ __forceinline__ unsigned xb_add(unsigned* p, unsigned v) { return __hip_atomic_fetch_add(p, v, __ATOMIC_RELAXED, __HIP_MEMORY_SCOPE_AGENT); }
__device__ __forceinline__ unsigned xb_xcc_id() { return (unsigned)__builtin_amdgcn_s_getreg((3 << 11) | 20) & 0xFu; }
#define XB_SPIN(cond, bar) do { unsigned _sp = 0; while (cond) { __builtin_amdgcn_s_sleep(1); \
    if ((++_sp & 255u) == 0u) { if (xb_ld(&(bar)[XB_TMO])) break; if (_sp > XB_SPIN_CAP) { atomicAdd(&(bar)[XB_TMO], 1u); break; } } } } while (0)
struct XcdBarrier { unsigned* bar; unsigned x; volatile LAS unsigned* st; };
__device__ __forceinline__ XcdBarrier xcd_barrier_post(unsigned* bar, volatile LAS unsigned* st) {
    XcdBarrier b; b.bar = bar; b.x = xb_xcc_id(); b.st = st;
    if (threadIdx.x == 0) (void)xb_add(&bar[XB_XCNT(b.x)], 1u);
    return b;
}
__device__ __forceinline__ void xcd_barrier_complete(unsigned* bar, unsigned x, unsigned& nloc, unsigned& nx) {
    const unsigned G = gridDim.x * gridDim.y * gridDim.z;
    unsigned sum, cnt, mine, sp = 0u;
    for (;;) {
        sum = 0u; cnt = 0u; mine = 0u;
#pragma unroll
        for (unsigned j = 0; j < 16; ++j) { const unsigned c = xb_ld(&bar[XB_XCNT(j)]); sum += c; cnt += (c > 0u) ? 1u : 0u; mine = (j == x) ? c : mine; }
        if (sum == G) break;
        __builtin_amdgcn_s_sleep(1);
        if ((++sp & 255u) == 0u) { if (xb_ld(&bar[XB_TMO])) break; if (sp > XB_SPIN_CAP) { atomicAdd(&bar[XB_TMO], 1u); break; } }
    }
    nloc = mine > 0u ? mine : 1u; nx = cnt > 0u ? cnt : 1u;
}
__device__ __forceinline__ void xcd_barrier(const XcdBarrier& b) {
    asm volatile("s_waitcnt vmcnt(0)" ::: "memory");
    __syncthreads();
    if (threadIdx.x == 0) {
        unsigned* bar = b.bar;
        __builtin_amdgcn_s_waitcnt(0);
        unsigned nloc = b.st[0], nx = b.st[1];
        if (nloc == 0u) { xcd_barrier_complete(bar, b.x, nloc, nx); b.st[0] = nloc; b.st[1] = nx; }
        const unsigned old = xb_add(&bar[XB_XSUB(b.x)], 1u);
        const unsigned gen = old / nloc;
        if (old + 1u == (gen + 1u) * nloc) {
            __builtin_amdgcn_fence(__ATOMIC_RELEASE, "agent");
            asm volatile("s_waitcnt vmcnt(0)" ::: "memory");
            const unsigned og = xb_add(&bar[XB_TOP], 1u);
            const unsigned tg = og / nx;
            if (og + 1u == (tg + 1u) * nx) xb_add(&bar[XB_TOPGEN], 1u);
            else XB_SPIN(xb_ld(&bar[XB_TOPGEN]) == tg, bar);
            __builtin_amdgcn_fence(__ATOMIC_ACQUIRE, "agent");
            xb_add(&bar[XB_XGEN(b.x)], 1u);
            asm volatile("s_waitcnt vmcnt(0)" ::: "memory");
        } else {
            XB_SPIN(xb_ld(&bar[XB_XGEN(b.x)]) == gen, bar);
            __builtin_amdgcn_fence(__ATOMIC_ACQUIRE, "agent");
            asm volatile("s_waitcnt vmcnt(0)" ::: "memory");
        }
    }
    __syncthreads();
}

constexpr int N_PHASES = 11;
__global__ void __launch_bounds__(512, 2) mk_fwd(Args A) {
    extern __shared__ __attribute__((aligned(16))) unsigned char lds_raw[];
    LAS unsigned char* lds = (LAS unsigned char*)lds_raw;
    cg::grid_group grid = cg::this_grid();
    const int tid = threadIdx.x, lane = tid & 63, wave = __builtin_amdgcn_readfirstlane(tid >> 6);
    const int G = gridDim.x, gw = blockIdx.x * 8 + wave, NGW = G * 8;
    unsigned char* ws = A.ws;
    const float* mod = (const float*)(ws + WS_MOD);
    bf16_t* H = (bf16_t*)(ws + WS_H);
    const int lo = A.ph_lo, hi = A.ph_hi;
#ifndef PHMASK
#define PHMASK 0x7ff
#endif
#ifndef REPMASK
#define REPMASK 0
#endif
#ifndef XSYNC
#define XSYNC 0
#endif
#ifndef TS_LO
#define TS_LO -2
#define TS_HI -2
#endif
#define REP(k) for (int rep_ = 0; rep_ < 1 + ((REPMASK >> (k)) & 1); ++rep_)
#define IN(k) (((PHMASK >> (k)) & 1) && lo <= (k) && (k) < hi)
    unsigned* barw = (unsigned*)(ws + WS_BAR);
    volatile LAS unsigned* bst = (volatile LAS unsigned*)(lds + LDS_BYTES - 16);
    if (tid < 4) bst[tid] = 0u;
    __syncthreads();
    if (hi < 0) grid.sync();
    XcdBarrier xbar = xcd_barrier_post(barw, bst);
    unsigned long long ts_a = 0, ts_b = 0;
    if (TS_LO == -1) ts_a = __builtin_amdgcn_s_memrealtime();
#define SEAM(k) do { if (IN(k) && IN((k) + 1)) xcd_barrier(xbar); if (TS_LO == (k)) ts_a = __builtin_amdgcn_s_memrealtime(); if (TS_HI == (k)) ts_b = __builtin_amdgcn_s_memrealtime(); } while (0)

    if (IN(0)) {
        unsigned* modcnt = (unsigned*)(ws + WS_MODCNT);
        p0_mod(A, lds, tid, lane, wave, modcnt);
        if (TS_LO == 20) ts_a = __builtin_amdgcn_s_memrealtime(); if (TS_HI == 20) ts_b = __builtin_amdgcn_s_memrealtime();
        __syncthreads();
        p0_weights(A, lds, tid, lane, wave);
        if (TS_LO == 21) ts_a = __builtin_amdgcn_s_memrealtime(); if (TS_HI == 21) ts_b = __builtin_amdgcn_s_memrealtime();
        if (tid == 0) { unsigned sp = 0; while (__hip_atomic_load(modcnt, __ATOMIC_RELAXED, __HIP_MEMORY_SCOPE_AGENT) < 6144u / 32u) { __builtin_amdgcn_s_sleep(2); if (++sp > (1u << 22)) break; }
            __builtin_amdgcn_fence(__ATOMIC_ACQUIRE, "agent"); asm volatile("s_waitcnt vmcnt(0)" ::: "memory"); }
        __syncthreads();
        for (int row = 4 * gw; row < MALL; row += 4 * NGW) {
            const bool isx = row < MTOK; const int bb = isx ? (row >> 11) : 16;
            const float* xr = isx ? A.in[I_X] + (size_t)row * DM : A.in[I_CTX] + (size_t)(row - MTOK) * DM;
            modulate_rows4(xr, A.in[I_N1W], mod + bb * 6144, mod + bb * 6144 + 1024, H + (size_t)row * DM, lane);
        }
    }
    if (TS_LO == 0) ts_a = __builtin_amdgcn_s_memrealtime(); if (TS_HI == 0) ts_b = __builtin_amdgcn_s_memrealtime();
    SEAM(1);
    if (IN(2)) REP(2) {
        pg8::Gemm g{H, (const bf16_t*)(ws + WS_WIN), 1024, 1024, 1024, 0}; pg8::InProjOrder S{G, (int)blockIdx.x};
        EpiInProj E{(bf16_t*)(ws + WS_K), (bf16_t*)(ws + WS_VT), (bf16_t*)(ws + WS_Q), (float*)(ws + WS_G), (bf16_t*)(ws + WS_AB), (bf16_t*)A.out, (const float*)(ws + WS_BIASP), A.in[I_CONVW]};
        pg8::gemm_phase<EpiInProj, pg8::InProjOrder>(lds, g, S, E);
    }
    SEAM(2);
    if (IN(3)) REP(3) {
        for (int seq = blockIdx.x; seq < 256; seq += G)
            mlstm_seq(lds, (const bf16_t*)(ws + WS_K), (const bf16_t*)(ws + WS_VT), (const bf16_t*)(ws + WS_Q), (const float*)(ws + WS_G), (bf16_t*)(ws + WS_H), (bf16_t*)(ws + WS_HD1), seq, tid, lane, wave);
    }
    SEAM(3);
    if (IN(4)) {
        for (int row = 4 * gw; row < MTOK; row += 4 * NGW)
            combine_rows4((const bf16_t*)(ws + WS_H) + (size_t)row * 1024, (const bf16_t*)(ws + WS_HD1) + (size_t)row * 1024, (bf16_t*)(ws + WS_AB) + (size_t)row * 2048 + 1024, A.in[I_MNW], lane);
    }
    SEAM(4);
    if (IN(5)) REP(5) {
        pg8::Gemm g{(const bf16_t*)(ws + WS_AB), (const bf16_t*)(ws + WS_BT2), 1024, 2048, 2048, 0}; pg8::SplitKOrder S; S.base.init(MTOK, 1024, G, (int)blockIdx.x);
        EpiG2 E{(const bf16_t*)A.out, (bf16_t*)(ws + WS_H)};
        pg8::gemm_phase<EpiG2, pg8::SplitKOrder>(lds, g, S, E);
    }
    SEAM(5);
    if (IN(6)) REP(6) {
        pg8::Gemm g{(const bf16_t*)(ws + WS_H), (const bf16_t*)(ws + WS_WO), 1024, 1024, 1024, 0}; pg8::StaticOrder S; S.init(MTOK, 1024, G, (int)blockIdx.x);
        EpiResNorm<0> E{A.in[I_X], A.out, mod + 2048, 0, H, A.in[I_N2W], mod, (bf16_t*)(ws + WS_HD1), (float*)(ws + WS_XBUF), (unsigned*)(ws + WS_CNT), lds + 131072};
        pg8::gemm_phase<EpiResNorm<0>, pg8::StaticOrder>(lds, g, S, E);
    }
    SEAM(6);
    if (IN(8)) REP(8) {
        pg8::Gemm g{H, (const bf16_t*)(ws + WS_W1), 1024, 1024, 1024, 0}; pg8::StaticOrder S; S.init(MTOK, DFF, G, (int)blockIdx.x);
        EpiRelu2 E{(bf16_t*)(ws + WS_F1), DFF};
        pg8::gemm_phase<EpiRelu2, pg8::StaticOrder>(lds, g, S, E);
    }
    SEAM(8);
    if (IN(9)) {
        pg8::Gemm g{(const bf16_t*)(ws + WS_F1), (const bf16_t*)(ws + WS_W2), DFF, DFF, F1P, 1}; pg8::StaticOrder S; S.init(MTOK, 1024, G, (int)blockIdx.x);
        EpiResNorm<1> E{A.out, A.out, mod + 5120, 1, nullptr, A.in[I_FNW], mod, (bf16_t*)(ws + WS_HD1), (float*)(ws + WS_XBUF) + (size_t)MTOK * 4, (unsigned*)(ws + WS_CNT) + 128 * 64, lds + 131072};
        pg8::gemm_phase<EpiResNorm<1>, pg8::StaticOrder>(lds, g, S, E);
    }
    if (TS_LO > -2) {
        xcd_barrier(xbar); if (TS_HI == 9) ts_b = __builtin_amdgcn_s_memrealtime();
        if (blockIdx.x == 0) { const int n = (int)((ts_b - ts_a) / 100ull); for (int i = tid; i < n; i += 512) A.out[(size_t)i * 4096 + 3] += 0.25f; }
    }
#undef IN
#undef SEAM
}

#ifndef MK_N_LAUNCHES
#define MK_N_LAUNCHES 1
#endif
extern "C" void kernel_launch(void* const* d_in, const int* in_sizes, int n_in, void* d_out, int out_size, void* d_ws, size_t ws_size, hipStream_t stream) {
    static int grid = 0;
    if (grid == 0) {
        if (n_in != 18 || out_size != MTOK * DM || ws_size < WS_END) { fprintf(stderr, "kernel_launch: unexpected shapes (n_in %d out %d ws %zu)\n", n_in, out_size, ws_size); grid = -1; return; }
        int dev = 0, cus = 0, per_cu = 0;
        hipGetDevice(&dev); hipDeviceGetAttribute(&cus, hipDeviceAttributeMultiprocessorCount, dev);
        hipFuncSetAttribute((const void*)mk_fwd, hipFuncAttributeMaxDynamicSharedMemorySize, LDS_BYTES);
        if (hipOccupancyMaxActiveBlocksPerMultiprocessor(&per_cu, (const void*)mk_fwd, 512, LDS_BYTES) != hipSuccess || per_cu < 1) { fprintf(stderr, "kernel_launch: occupancy query says %d\n", per_cu); per_cu = 1; }
        (void)hipGetLastError();
        grid = cus * per_cu;
        if (grid > 256) grid = 256;
    }
    if (grid < 0) return;
    Args a{};
    for (int i = 0; i < 18; ++i) a.in[i] = (const float*)d_in[i];
    a.out = (float*)d_out; a.ws = (unsigned char*)d_ws;
    (void)hipMemsetAsync((unsigned char*)d_ws + WS_BAR, 0, 256 * 1024, stream);
#if MK_N_LAUNCHES == 1
    a.ph_lo = 0; a.ph_hi = N_PHASES;
    void* args[] = {&a};
    hipError_t e = hipLaunchCooperativeKernel((const void*)mk_fwd, dim3(grid), dim3(512), args, LDS_BYTES, stream);
    if (e != hipSuccess) fprintf(stderr, "cooperative launch failed: %s (grid %d)\n", hipGetErrorString(e), grid);
#else
    for (int p = 0; p < N_PHASES; ++p) { a.ph_lo = p; a.ph_hi = p + 1; hipLaunchKernelGGL(mk_fwd, dim3(grid), dim3(512), LDS_BYTES, stream, a); }
#endif
}
```

```cpp
#include <hip/hip_runtime.h>
#include <hip/hip_cooperative_groups.h>
#include <cstdio>
#include <cstdint>
namespace cg = cooperative_groups;

#define LAS __attribute__((address_space(3)))
typedef unsigned short bf16_t;
typedef short bf16x8 __attribute__((ext_vector_type(8)));
typedef float f32x4 __attribute__((ext_vector_type(4)));
typedef unsigned u32x4 __attribute__((ext_vector_type(4)));
typedef unsigned u32x2 __attribute__((ext_vector_type(2)));

constexpr int DM = 1024, NB = 16, SEQ = 2048, CTXL = 256, NH = 8, DK = 64, DV = 128, DFF = 4096;
constexpr int MTOK = NB * SEQ;
constexpr int MCTX = NB * CTXL;
constexpr int MALL = MTOK + MCTX;
constexpr int DIN = 8224, NIN = 8448;
constexpr float EPS = 1e-6f;
constexpr int OFF_K = 0, OFF_V = 512, OFF_IG = 1536, OFF_Q = 1568, OFF_O = 2080, OFF_XIN = 3104, OFF_GC = 4128, OFF_GB = 5152, OFF_MRG = 6176;

constexpr size_t MiB = 1u << 20;
constexpr size_t WS_MOD = 0;
constexpr size_t WS_BIASP = 512 * 1024;
constexpr size_t WS_BAR = 768 * 1024;
constexpr size_t WS_MODCNT = 900 * 1024;
constexpr size_t WS_CNT = 800 * 1024;
constexpr size_t WS_XBUF = 450 * MiB;
constexpr size_t WS_WIN = 1 * MiB;
constexpr size_t WS_BT2 = 18 * MiB;
constexpr size_t WS_WO = 22 * MiB;
constexpr size_t WS_W1 = 24 * MiB;
constexpr int F1P = DFF + 64;
constexpr size_t WS_W2 = 452 * MiB;
constexpr size_t WS_H = 40 * MiB;
constexpr size_t WS_K = 112 * MiB;
constexpr size_t WS_VT = 148 * MiB;
constexpr size_t WS_Q = 220 * MiB;
constexpr size_t WS_G = 252 * MiB;
constexpr size_t WS_AB = 258 * MiB;
constexpr size_t WS_HD1 = 386 * MiB;
constexpr size_t WS_F1 = 112 * MiB;
constexpr size_t WS_END = 462 * MiB;

constexpr int LDS_BYTES = 155648;

typedef float f32x2_t __attribute__((ext_vector_type(2))); typedef __bf16 bf16x2_t __attribute__((ext_vector_type(2)));
__device__ __forceinline__ unsigned cvt_pk_bf16(float lo, float hi) { const f32x2_t v = {lo, hi}; const bf16x2_t b = __builtin_convertvector(v, bf16x2_t); return __builtin_bit_cast(unsigned, b); }
__device__ __forceinline__ float bf_lo(unsigned w) { return __uint_as_float(w << 16); }
__device__ __forceinline__ float bf_hi(unsigned w) { return __uint_as_float(w & 0xffff0000u); }
__device__ __forceinline__ float sigm(float x) { return __builtin_amdgcn_rcpf(1.f + __expf(-x)); }
__device__ __forceinline__ float wave_sum(float v) {
#pragma unroll
    for (int o = 1; o < 64; o <<= 1) v += __shfl_xor(v, o);
    return v;
}
__device__ __forceinline__ float wave_max(float v) {
#pragma unroll
    for (int o = 1; o < 64; o <<= 1) v = fmaxf(v, __shfl_xor(v, o));
    return v;
}
template <int CTRL, int RM = 0xf> __device__ __forceinline__ float dppf(float old, float src) {
    return __int_as_float(__builtin_amdgcn_update_dpp(__float_as_int(old), __float_as_int(src), CTRL, RM, 0xf, false));
}
__device__ __forceinline__ float wave_scan_add(float x) {
    x += dppf<0x111>(0.f, x); x += dppf<0x112>(0.f, x); x += dppf<0x114>(0.f, x); x += dppf<0x118>(0.f, x);
    x += dppf<0x142, 0xA>(0.f, x); x += dppf<0x143, 0xC>(0.f, x); return x;
}
__device__ __forceinline__ float wave_scan_max(float x) {
    const float ninf = -INFINITY;
    x = fmaxf(x, dppf<0x111>(ninf, x)); x = fmaxf(x, dppf<0x112>(ninf, x)); x = fmaxf(x, dppf<0x114>(ninf, x)); x = fmaxf(x, dppf<0x118>(ninf, x));
    x = fmaxf(x, dppf<0x142, 0xA>(ninf, x)); x = fmaxf(x, dppf<0x143, 0xC>(ninf, x)); return x;
}
__device__ __forceinline__ float lane63(float x) { return __int_as_float(__builtin_amdgcn_readlane(__float_as_int(x), 63)); }
__device__ __forceinline__ float logsig(float x) { return fminf(x, 0.f) - __logf(1.f + __expf(-fabsf(x))); }

namespace pg8 {
constexpr int BM = 256, BK = 64, HALF = 128, HTB = HALF * BK * 2, STAGE_BYTES = 8 * HTB, NXCD = 8, WGM = 8;
__host__ __device__ __forceinline__ int lds_byte(int r, int c) { const int st = (r >> 4) * 2 + (c >> 5), rr = r & 15, cc = c & 31, ob = rr * 64 + cc * 2; return st * 1024 + (ob ^ (((ob >> 9) & 1) << 5)); }
__host__ __device__ __forceinline__ void stage_rc(int b, int& R, int& C) { const int st = b / 1024, sb = b % 1024, swz = sb ^ (((sb >> 9) & 1) << 5); R = (st >> 1) * 16 + swz / 64; C = (st & 1) * 32 + (swz % 64) / 2; }
__host__ __device__ __forceinline__ int perm32(int rho) { const int n = rho >> 4, i = rho & 15; return 8 * (i >> 2) + 4 * n + (i & 3); }

struct Unit { int pm, pn, sw, h; };
struct Gemm { const bf16_t* A; const bf16_t* Bt; int K, lda, ldb, atile; };

__device__ __forceinline__ void rect_map(int l, int nM, int nN, int& pm, int& pn) {
    const int nig = WGM * nN, gid = l / nig, fm = gid * WGM, gsz = (nM - fm) < WGM ? (nM - fm) : WGM, rem = l % nig;
    pm = fm + rem % gsz; pn = rem / gsz;
}
struct StaticOrder {
    int nM, nN, nwg, G, c, rev = 0;
    __device__ void init(int M, int N, int G_, int c_) { nM = M / BM; nN = N / BM; nwg = nM * nN; G = G_; c = c_; }
    __device__ bool next(int i, Unit& u) const {
        const long L = (long)i * G + c; if (L >= nwg) return false;
        int wgid = (int)L; { const int q = nwg / NXCD, r = nwg % NXCD, xcd = wgid % NXCD, off = wgid / NXCD; wgid = (xcd < r ? xcd * (q + 1) : r * (q + 1) + (xcd - r) * q) + off; }
        rect_map(wgid, nM, nN, u.pm, u.pn); if (rev) u.pm = nM - 1 - u.pm; u.sw = 0; u.h = 0; return true;
    }
};
struct InProjOrder {
    int G, c;
    static constexpr int N_RC = 128 * 26, N_RB = 144 * 4, N_RA = 144 * 3, NWG = N_RC + N_RB + N_RA;
    __device__ bool next(int i, Unit& u) const {
        const long L = (long)i * G + c; if (L >= NWG) return false;
        int w = (int)L; w = (w % NXCD) * (NWG / NXCD) + w / NXCD;
        int a, b; u.h = 0;
        if (w < N_RC) { rect_map(w, 128, 26, a, b); u.pm = a; u.pn = 7 + b; u.sw = 0; }
        else if (w < N_RC + N_RB) { rect_map(w - N_RC, 144, 4, a, b); u.pm = 3 + b; u.pn = a; u.sw = 1; }
        else { rect_map(w - N_RC - N_RB, 144, 3, a, b); u.pm = a; u.pn = b; u.sw = 0; }
        return true;
    }
};
static_assert(InProjOrder::NWG % NXCD == 0, "in-proj unit count");
struct SplitKOrder {
    StaticOrder base;
    __device__ bool next(int i, Unit& u) const { if (!base.next(i >> 1, u)) return false; u.h = i & 1; return true; }
};

template <class Epi, class Sched>
__device__ __forceinline__ void gemm_phase(LAS unsigned char* lds, const Gemm g, const Sched& S, const Epi& E) {
    const int tid = threadIdx.x, wid = __builtin_amdgcn_readfirstlane(tid >> 6), lane = tid & 63, wr = wid >> 2, wc = wid & 3, fr = lane & 15, fq = lane >> 4;
    const int K = g.K, nt = K / BK;
    unsigned voffA[2], voffB[2];
#pragma unroll
    for (int i = 0; i < 2; ++i) { int R, C; stage_rc(tid * 16 + i * 8192, R, C); const int Rb = (R & ~31) + perm32(R & 31);
        voffA[i] = g.atile ? (unsigned)(R * BK + C) * 2u : (unsigned)(R * g.lda + C) * 2u; voffB[i] = (unsigned)(Rb * g.ldb + C) * 2u; }
    const size_t kstep = (size_t)(BK * 2), kstepA = g.atile ? (size_t)HTB : kstep;
    const size_t hstepA = g.atile ? (size_t)(g.lda / BK) * HTB : (size_t)HALF * g.lda * 2, hstepB = (size_t)HALF * g.ldb * 2;
    const unsigned ldsw = (unsigned)wid * 1024u;
    const int aoff = lds_byte(wr * 64 + fr, fq * 8), boff = lds_byte(wc * 32 + fr, fq * 8);
#define PG8_SA(b, h) (((b) * 2 + (h)) * HTB)
#define PG8_SB(b, h) ((4 + (b) * 2 + (h)) * HTB)
#define PG8_STAGE(bufoff, gbase, voff) do { _Pragma("unroll") for (int _i = 0; _i < 2; ++_i) \
        __builtin_amdgcn_global_load_lds((const unsigned*)((const char*)(gbase) + (voff)[_i]), (LAS unsigned*)(lds + (bufoff) + ldsw + _i * 8192), 16, 0, 0); } while (0)
#define PG8_LDA(dst, b, h) do { _Pragma("unroll") for (int m = 0; m < 4; ++m) _Pragma("unroll") for (int k = 0; k < 2; ++k) dst[m][k] = *(const LAS bf16x8*)(lds + PG8_SA(b, h) + aoff + m * 2048 + k * 1024); } while (0)
#define PG8_LDB(dst, b, h) do { _Pragma("unroll") for (int n = 0; n < 2; ++n) _Pragma("unroll") for (int k = 0; k < 2; ++k) dst[n][k] = *(const LAS bf16x8*)(lds + PG8_SB(b, h) + boff + n * 2048 + k * 1024); } while (0)
#define PG8_MMA(ai, bj, At, Bt) do { __builtin_amdgcn_s_setprio(1); _Pragma("unroll") for (int m = 0; m < 4; ++m) _Pragma("unroll") for (int n = 0; n < 2; ++n) _Pragma("unroll") for (int k = 0; k < 2; ++k) \
        acc[ai][bj][m][n] = __builtin_amdgcn_mfma_f32_16x16x32_bf16(Bt[n][k], At[m][k], acc[ai][bj][m][n], 0, 0, 0); __builtin_amdgcn_s_setprio(0); } while (0)
#define PG8_WAIT_V(n) asm volatile("s_waitcnt vmcnt(" #n ")" ::: "memory")
#define PG8_WAIT_L(n) asm volatile("s_waitcnt lgkmcnt(" #n ")" ::: "memory")
#define PG8_BAR __builtin_amdgcn_s_barrier()
#define PG8_SCHED __builtin_amdgcn_sched_barrier(0)
#define PG8_PA(u) ((const char*)((u).sw ? g.Bt : g.A) + (size_t)(u).pm * 2 * hstepA + (size_t)(u).h * K * 2)
#define PG8_PB(u) ((const char*)((u).sw ? g.A : g.Bt) + (size_t)(u).pn * 2 * hstepB + (size_t)(u).h * K * 2)
    Unit cur, nxt; int ui = 0;
    if (!S.next(0, cur)) return;
    f32x4 acc[2][2][4][2];
#pragma unroll
    for (int a = 0; a < 2; ++a)
#pragma unroll
        for (int b = 0; b < 2; ++b)
#pragma unroll
            for (int m = 0; m < 4; ++m)
#pragma unroll
                for (int n = 0; n < 2; ++n) acc[a][b][m][n] = (f32x4){0.f, 0.f, 0.f, 0.f};
    bf16x8 At[4][2], B0[2][2], B1[2][2];
    const char* cA = PG8_PA(cur); const char* cB = PG8_PB(cur);
    PG8_STAGE(PG8_SB(0, 0), cB, voffB); PG8_STAGE(PG8_SB(0, 1), cB + hstepB, voffB); PG8_STAGE(PG8_SA(0, 0), cA, voffA); PG8_STAGE(PG8_SA(0, 1), cA + hstepA, voffA);
    if (wr == 1) PG8_BAR;
    PG8_WAIT_V(2); PG8_BAR;
    PG8_STAGE(PG8_SB(1, 0), cB + kstep, voffB); PG8_STAGE(PG8_SA(1, 0), cA + kstepA, voffA); PG8_STAGE(PG8_SB(1, 1), cB + hstepB + kstep, voffB);
    PG8_WAIT_V(6); PG8_BAR;
    for (;;) {
        const bool has_next = S.next(ui + 1, nxt);
        const char* nA = has_next ? PG8_PA(nxt) : cA; const char* nB = has_next ? PG8_PB(nxt) : cB;
        for (int t = 0; t < nt; t += 2) {
            const bool last = (t == nt - 2);
            const char* a1 = cA + (size_t)(t + 1) * kstepA;
            const char* a2 = last ? nA : cA + (size_t)(t + 2) * kstepA; const char* b2 = last ? nB : cB + (size_t)(t + 2) * kstep;
            const char* a3 = a2 + kstepA; const char* b3 = b2 + kstep;
            PG8_LDB(B0, 0, 0); PG8_LDB(B1, 0, 1); PG8_SCHED; PG8_LDA(At, 0, 0); PG8_STAGE(PG8_SA(1, 1), a1 + hstepA, voffA);
            PG8_WAIT_V(8); PG8_WAIT_L(0); PG8_BAR; PG8_MMA(0, 0, At, B0); PG8_MMA(0, 1, At, B1); PG8_BAR; PG8_SCHED;
            PG8_LDA(At, 0, 1); PG8_STAGE(PG8_SB(0, 0), b2, voffB); PG8_STAGE(PG8_SB(0, 1), b2 + hstepB, voffB); PG8_STAGE(PG8_SA(0, 0), a2, voffA);
            PG8_WAIT_V(8); PG8_WAIT_L(0); PG8_BAR; PG8_MMA(1, 0, At, B0); PG8_MMA(1, 1, At, B1); PG8_BAR; PG8_SCHED;
            PG8_LDB(B0, 1, 0); PG8_LDB(B1, 1, 1); PG8_SCHED; PG8_LDA(At, 1, 0); PG8_STAGE(PG8_SA(0, 1), a2 + hstepA, voffA);
            PG8_WAIT_V(8); PG8_WAIT_L(0); PG8_BAR; PG8_MMA(0, 0, At, B0); PG8_MMA(0, 1, At, B1); PG8_BAR; PG8_SCHED;
            PG8_LDA(At, 1, 1); PG8_STAGE(PG8_SB(1, 0), b3, voffB); PG8_STAGE(PG8_SB(1, 1), b3 + hstepB, voffB); PG8_STAGE(PG8_SA(1, 0), a3, voffA);
            PG8_WAIT_V(8); PG8_WAIT_L(0); PG8_BAR; PG8_MMA(1, 0, At, B0); PG8_MMA(1, 1, At, B1); PG8_BAR; PG8_SCHED;
        }
        if (wr == 0) PG8_BAR;
        bool keep = false;
        if constexpr (Epi::HAS_MID) keep = (cur.h == 0);
        if constexpr (Epi::HAS_MID) { if (keep) E.mid(acc, cur, wr, wc, fr, fq); else E(acc, cur, wr, wc, fr, fq); }
        else E(acc, cur, wr, wc, fr, fq);
        if (!has_next) break;
        if (!keep)
#pragma unroll
        for (int a = 0; a < 2; ++a)
#pragma unroll
            for (int b = 0; b < 2; ++b)
#pragma unroll
                for (int m = 0; m < 4; ++m)
#pragma unroll
                    for (int n = 0; n < 2; ++n) acc[a][b][m][n] = (f32x4){0.f, 0.f, 0.f, 0.f};
        cur = nxt; cA = nA; cB = nB; ++ui;
        if (wr == 1) PG8_BAR;
    }
    PG8_WAIT_V(0);
    PG8_BAR;
#undef PG8_SA
#undef PG8_SB
#undef PG8_STAGE
#undef PG8_LDA
#undef PG8_LDB
#undef PG8_MMA
#undef PG8_WAIT_V
#undef PG8_WAIT_L
#undef PG8_BAR
#undef PG8_SCHED
#undef PG8_PA
#undef PG8_PB
}
}
using pg8::Unit;

typedef f32x4 Acc[2][2][4][2];

__device__ __forceinline__ u32x4 pack8(const f32x4 v0, const f32x4 v1) {
    u32x4 w; w.x = cvt_pk_bf16(v0[0], v0[1]); w.y = cvt_pk_bf16(v0[2], v0[3]); w.z = cvt_pk_bf16(v1[0], v1[1]); w.w = cvt_pk_bf16(v1[2], v1[3]); return w;
}

struct EpiInProj {
    static constexpr bool HAS_MID = false;
    bf16_t* Kb; bf16_t* VTb; bf16_t* Qb; float* Gb; bf16_t* AB; bf16_t* MG; const float* biasp; const float* convw;
    __device__ __forceinline__ void operator()(Acc& acc, const Unit& u, int wr, int wc, int fr, int fq) const {
        if (u.sw) {
            const int r0 = u.pm * 256 + wr * 64 + fr, t0 = u.pn * 256 + wc * 32 + 8 * fq;
#pragma unroll
            for (int ai = 0; ai < 2; ++ai)
#pragma unroll
                for (int m = 0; m < 4; ++m) { const int wrow = r0 + ai * 128 + m * 16; const float bs = biasp[wrow]; bf16_t* rowp = VTb + (size_t)(wrow - 768) * MALL + t0;
#pragma unroll
                    for (int bj = 0; bj < 2; ++bj) *(u32x4*)(rowp + bj * 128) = pack8(acc[ai][bj][m][0] + bs, acc[ai][bj][m][1] + bs); }
            return;
        }
        const int row0 = u.pm * 256 + wr * 64 + fr, pn = u.pn;
        const int cb = pn * 256 + wc * 32 + 8 * fq;
        if (pn == 2) {
            if (wc == 0) {
                const f32x4 b0 = *(const f32x4*)(biasp + cb), b1 = *(const f32x4*)(biasp + cb + 4);
#pragma unroll
                for (int ai = 0; ai < 2; ++ai)
#pragma unroll
                    for (int m = 0; m < 4; ++m) { float* gp = Gb + (size_t)(8 * fq) * MALL + (row0 + ai * 128 + m * 16);
                        f32x4 g0 = acc[ai][0][m][0] + b0, g1 = acc[ai][0][m][1] + b1;
                        if (fq >= 2) {
#pragma unroll
                            for (int j = 0; j < 4; ++j) { g0[j] = logsig(g0[j]); g1[j] = logsig(g1[j]); } }
#pragma unroll
                        for (int j = 0; j < 4; ++j) { gp[(size_t)j * MALL] = g0[j]; gp[(size_t)(4 + j) * MALL] = g1[j]; } }
            }
            return;
        }
        if (pn >= 9 && pn < 25) {
            const int ch = 64 * (pn - 9) + 16 * wc + 4 * fq;
            const f32x4 bX = *(const f32x4*)(biasp + cb), bC = *(const f32x4*)(biasp + cb + 4), bB = *(const f32x4*)(biasp + cb + 128), bO = *(const f32x4*)(biasp + cb + 132);
            const f32x4 w0 = *(const f32x4*)(convw + ch), w1 = *(const f32x4*)(convw + 1024 + ch), w2 = *(const f32x4*)(convw + 2048 + ch);
#pragma unroll
            for (int ai = 0; ai < 2; ++ai) {
                f32x4 uu[4];
#pragma unroll
                for (int m = 0; m < 4; ++m) uu[m] = (acc[ai][0][m][0] + bX) * (acc[ai][0][m][1] + bC);
#pragma unroll
                for (int m = 0; m < 4; ++m) {
                    f32x4 pv, nx;
#pragma unroll
                    for (int j = 0; j < 4; ++j) {
                        const float pold = (m > 0) ? dppf<0x121>(0.f, uu[m > 0 ? m - 1 : 0][j]) : 0.f;
                        pv[j] = dppf<0x111>(pold, uu[m][j]);
                        const float nold = (m < 3) ? dppf<0x12F>(0.f, uu[m < 3 ? m + 1 : 3][j]) : 0.f;
                        nx[j] = dppf<0x101>(nold, uu[m][j]);
                    }
                    const f32x4 cv = w0 * pv + w1 * uu[m] + w2 * nx;
                    const f32x4 aa = (acc[ai][1][m][0] + bB) * cv;
                    f32x4 os = acc[ai][1][m][1] + bO;
#pragma unroll
                    for (int j = 0; j < 4; ++j) os[j] = sigm(os[j]);
                    bf16_t* rp = AB + (size_t)(row0 + ai * 128 + m * 16) * 2048 + ch;
                    u32x2 wa, wo; wa.x = cvt_pk_bf16(aa[0], aa[1]); wa.y = cvt_pk_bf16(aa[2], aa[3]); wo.x = cvt_pk_bf16(os[0], os[1]); wo.y = cvt_pk_bf16(os[2], os[3]);
                    *(u32x2*)rp = wa; *(u32x2*)(rp + 1024) = wo;
                }
            }
            return;
        }
        if (pn >= 25) {
            const int ch = 128 * (pn - 25) + 32 * wc + 8 * fq;
            f32x4 ba[2], bb[2];
#pragma unroll
            for (int n = 0; n < 2; ++n) { ba[n] = *(const f32x4*)(biasp + cb + 4 * n); bb[n] = *(const f32x4*)(biasp + cb + 128 + 4 * n); }
#pragma unroll
            for (int ai = 0; ai < 2; ++ai)
#pragma unroll
                for (int m = 0; m < 4; ++m) { bf16_t* rp = MG + (size_t)(row0 + ai * 128 + m * 16) * 2048 + ch;
                    f32x4 rr[2], gg[2];
#pragma unroll
                    for (int n = 0; n < 2; ++n) { const f32x4 xa = acc[ai][0][m][n] + ba[n], xb = acc[ai][1][m][n] + bb[n];
#pragma unroll
                        for (int j = 0; j < 4; ++j) { const float ea = 1.f + __expf(-xa[j]), eb = 1.f + __expf(-xb[j]); rr[n][j] = eb * __builtin_amdgcn_rcpf(ea); gg[n][j] = __builtin_amdgcn_rcpf(eb); } }
                    *(u32x4*)rp = pack8(rr[0], rr[1]); *(u32x4*)(rp + 1024) = pack8(gg[0], gg[1]); }
            return;
        }
        bf16_t* base; int ldc, col0, mode;
        if (pn < 2) { base = Kb; ldc = 512; col0 = pn * 256; mode = 0; }
        else { base = Qb; ldc = 512; col0 = (pn - 7) * 256; mode = 1; }
        col0 += wc * 32 + 8 * fq;
        f32x4 bv[2][2];
#pragma unroll
        for (int bj = 0; bj < 2; ++bj)
#pragma unroll
            for (int n = 0; n < 2; ++n) bv[bj][n] = *(const f32x4*)(biasp + cb + bj * 128 + 4 * n);
#pragma unroll
        for (int ai = 0; ai < 2; ++ai)
#pragma unroll
            for (int m = 0; m < 4; ++m) { bf16_t* rowp = base + (size_t)(row0 + ai * 128 + m * 16) * ldc + col0;
#pragma unroll
                for (int bj = 0; bj < 2; ++bj) { f32x4 v0 = acc[ai][bj][m][0] + bv[bj][0], v1 = acc[ai][bj][m][1] + bv[bj][1];
                    if (mode == 0) { v0 = v0 * 0.125f; v1 = v1 * 0.125f; }
                    *(u32x4*)(rowp + bj * 128) = pack8(v0, v1); } }
    }
};

struct EpiG2 {
    static constexpr bool HAS_MID = true;
    const bf16_t* MG; bf16_t* MRG;
    __device__ __forceinline__ void mid(Acc& acc, const Unit& u, int wr, int wc, int fr, int fq) const {
        const int row0 = u.pm * 256 + wr * 64 + fr, col0 = u.pn * 256 + wc * 32 + 8 * fq;
#pragma unroll
        for (int ai = 0; ai < 2; ++ai) {
            u32x4 rr[4][2];
#pragma unroll
            for (int m = 0; m < 4; ++m)
#pragma unroll
                for (int bj = 0; bj < 2; ++bj) rr[m][bj] = __builtin_nontemporal_load((const u32x4*)(MG + (size_t)(row0 + ai * 128 + m * 16) * 2048 + col0 + bj * 128));
#pragma unroll
            for (int m = 0; m < 4; ++m)
#pragma unroll
                for (int bj = 0; bj < 2; ++bj) { const u32x4 q = rr[m][bj];
                    const f32x4 r0 = {bf_lo(q.x), bf_hi(q.x), bf_lo(q.y), bf_hi(q.y)}, r1 = {bf_lo(q.z), bf_hi(q.z), bf_lo(q.w), bf_hi(q.w)};
                    acc[ai][bj][m][0] = acc[ai][bj][m][0] * r0; acc[ai][bj][m][1] = acc[ai][bj][m][1] * r1; }
            asm volatile("" ::: "memory");
        }
    }
    __device__ __forceinline__ void operator()(Acc& acc, const Unit& u, int wr, int wc, int fr, int fq) const {
        const int row0 = u.pm * 256 + wr * 64 + fr, col0 = u.pn * 256 + wc * 32 + 8 * fq;
#pragma unroll
        for (int ai = 0; ai < 2; ++ai) {
            u32x4 gg[4][2];
#pragma unroll
            for (int m = 0; m < 4; ++m)
#pragma unroll
                for (int bj = 0; bj < 2; ++bj) gg[m][bj] = __builtin_nontemporal_load((const u32x4*)(MG + (size_t)(row0 + ai * 128 + m * 16) * 2048 + col0 + bj * 128 + 1024));
#pragma unroll
            for (int m = 0; m < 4; ++m)
#pragma unroll
                for (int bj = 0; bj < 2; ++bj) { const u32x4 gb = gg[m][bj];
                    const f32x4 g0 = {bf_lo(gb.x), bf_hi(gb.x), bf_lo(gb.y), bf_hi(gb.y)}, g1 = {bf_lo(gb.z), bf_hi(gb.z), bf_lo(gb.w), bf_hi(gb.w)};
                    *(u32x4*)(MRG + (size_t)(row0 + ai * 128 + m * 16) * 1024 + col0 + bj * 128) = pack8(acc[ai][bj][m][0] * g0, acc[ai][bj][m][1] * g1); }
            asm volatile("" ::: "memory");
        }
    }
};
struct EpiRes {
    static constexpr bool HAS_MID = false;
    const float* base; float* out; const float* gate;
    __device__ __forceinline__ void operator()(Acc& acc, const Unit& u, int wr, int wc, int fr, int fq) const {
        const int row0 = u.pm * 256 + wr * 64 + fr, col0 = u.pn * 256 + wc * 32 + 8 * fq;
        const float* gp = gate + (size_t)((u.pm * 256) >> 11) * 6144 + col0;
        f32x4 gv[2][2];
#pragma unroll
        for (int bj = 0; bj < 2; ++bj)
#pragma unroll
            for (int n = 0; n < 2; ++n) gv[bj][n] = *(const f32x4*)(gp + bj * 128 + 4 * n);
#pragma unroll
        for (int ai = 0; ai < 2; ++ai)
#pragma unroll
            for (int m = 0; m < 4; ++m) { const size_t off = (size_t)(row0 + ai * 128 + m * 16) * 1024 + col0;
#pragma unroll
                for (int bj = 0; bj < 2; ++bj)
#pragma unroll
                    for (int n = 0; n < 2; ++n) { const f32x4 bs = *(const f32x4*)(base + off + bj * 128 + 4 * n);
                        *(f32x4*)(out + off + bj * 128 + 4 * n) = bs + gv[bj][n] * acc[ai][bj][m][n]; } }
    }
};
template <int mode> struct EpiResNorm {
    static constexpr bool HAS_MID = false;
    const float* base; float* out; const float* gate; int mode_unused;
    bf16_t* h2; const float* nw; const float* mod;
    bf16_t* x1b;
    float* xbuf; unsigned* cnt; LAS unsigned char* xl;
    __device__ __forceinline__ void operator()(Acc& acc, const Unit& u, int wr, int wc, int fr, int fq) const {
        const int wid = wr * 4 + wc, lane = fq * 16 + fr;
        const int row0 = u.pm * 256 + wr * 64 + fr, col0 = u.pn * 256 + wc * 32 + 8 * fq, bb = (u.pm * 256) >> 11;
        {
            const float* gp = gate + (size_t)bb * 6144 + col0;
            f32x4 gv[2][2];
#pragma unroll
            for (int bj = 0; bj < 2; ++bj)
#pragma unroll
                for (int n = 0; n < 2; ++n) gv[bj][n] = *(const f32x4*)(gp + bj * 128 + 4 * n);
#pragma unroll
            for (int ai = 0; ai < 2; ++ai)
#pragma unroll
                for (int m = 0; m < 4; ++m) { const size_t off = (size_t)(row0 + ai * 128 + m * 16) * 1024 + col0;
#pragma unroll
                    for (int bj = 0; bj < 2; ++bj) {
                        if (mode == 1) { const u32x4 q = __builtin_nontemporal_load((const u32x4*)(x1b + off + bj * 128));
                            const f32x4 b0 = {bf_lo(q.x), bf_hi(q.x), bf_lo(q.y), bf_hi(q.y)}, b1 = {bf_lo(q.z), bf_hi(q.z), bf_lo(q.w), bf_hi(q.w)};
                            acc[ai][bj][m][0] = b0 + gv[bj][0] * acc[ai][bj][m][0]; acc[ai][bj][m][1] = b1 + gv[bj][1] * acc[ai][bj][m][1]; }
                        else {
#pragma unroll
                            for (int n = 0; n < 2; ++n) { const f32x4 bs = __builtin_nontemporal_load((const f32x4*)(base + off + bj * 128 + 4 * n)); acc[ai][bj][m][n] = bs + gv[bj][n] * acc[ai][bj][m][n]; } }
                    }
                    asm volatile("" : "+v"(acc[ai][0][m][0]), "+v"(acc[ai][0][m][1]), "+v"(acc[ai][1][m][0]), "+v"(acc[ai][1][m][1]));
                    if (m & 1) asm volatile("" ::: "memory"); }
        }
        LAS float* P = (LAS float*)xl; LAS float* S = (LAS float*)(xl + 4096);
#pragma unroll
        for (int ai = 0; ai < 2; ++ai)
#pragma unroll
            for (int m = 0; m < 4; ++m) { float q = 0.f;
#pragma unroll
                for (int bj = 0; bj < 2; ++bj)
#pragma unroll
                    for (int n = 0; n < 2; ++n) { const f32x4 x = acc[ai][bj][m][n]; q += (x[0] * x[0] + x[1] * x[1]) + (x[2] * x[2] + x[3] * x[3]); }
                q += __shfl_xor(q, 16); q += __shfl_xor(q, 32);
                if (fq == 0) P[(ai * 128 + wr * 64 + m * 16 + fr) * 4 + wc] = q; }
        asm volatile("s_waitcnt lgkmcnt(0)\n\ts_barrier" ::: "memory");
        const int row = wid * 32 + (lane & 31);
        if (lane < 32) { const float tot = (P[row * 4 + 0] + P[row * 4 + 1]) + (P[row * 4 + 2] + P[row * 4 + 3]);
            __hip_atomic_store(xbuf + (size_t)(u.pm * 256 + row) * 4 + u.pn, tot, __ATOMIC_RELAXED, __HIP_MEMORY_SCOPE_AGENT); }
        asm volatile("s_waitcnt vmcnt(0)" ::: "memory");
        if (lane == 0) __hip_atomic_fetch_add(cnt + 64 * u.pm, 1u, __ATOMIC_RELAXED, __HIP_MEMORY_SCOPE_AGENT);
        if (wid == 0) {
            unsigned sp = 0;
            while ((unsigned)__builtin_amdgcn_readfirstlane(__hip_atomic_load(cnt + 64 * u.pm, __ATOMIC_RELAXED, __HIP_MEMORY_SCOPE_AGENT)) < 32u) { __builtin_amdgcn_s_sleep(2); if (++sp > (1u << 20)) break; }
            __builtin_amdgcn_fence(__ATOMIC_ACQUIRE, "agent");
        }
        asm volatile("s_waitcnt vmcnt(0) lgkmcnt(0)\n\ts_barrier" ::: "memory");
        if (lane < 32) { const float* sl = xbuf + (size_t)(u.pm * 256 + row) * 4; float t = 0.f;
#pragma unroll
            for (int k = 0; k < 4; ++k) t += __hip_atomic_load(sl + k, __ATOMIC_RELAXED, __HIP_MEMORY_SCOPE_AGENT);
            S[row] = rsqrtf(t * (1.f / 1024.f) + EPS); }
        asm volatile("s_waitcnt vmcnt(0) lgkmcnt(0)\n\ts_barrier" ::: "memory");
#pragma unroll
        for (int bj = 0; bj < 2; ++bj) {
            const int c = col0 + bj * 128;
            f32x4 w0 = *(const f32x4*)(nw + c), w1 = *(const f32x4*)(nw + c + 4), h0 = (f32x4){0.f, 0.f, 0.f, 0.f}, h1 = h0;
            if (mode == 0) { const float* mb = mod + (size_t)bb * 6144 + c; w0 = w0 * (*(const f32x4*)(mb + 4096) + 1.f); w1 = w1 * (*(const f32x4*)(mb + 4100) + 1.f); h0 = *(const f32x4*)(mb + 3072); h1 = *(const f32x4*)(mb + 3076); }
#pragma unroll
            for (int ai = 0; ai < 2; ++ai)
#pragma unroll
                for (int m = 0; m < 4; ++m) { asm volatile("" ::: "memory"); const int rl = ai * 128 + wr * 64 + m * 16 + fr; const float r = S[rl]; const size_t off = (size_t)(u.pm * 256 + rl) * 1024 + c;
                    const f32x4 v0 = acc[ai][bj][m][0], v1 = acc[ai][bj][m][1];
                    if (mode == 0) { *(u32x4*)(x1b + off) = pack8(v0, v1); *(u32x4*)(h2 + off) = pack8((v0 * r) * w0 + h0, (v1 * r) * w1 + h1); }
                    else { *(f32x4*)(out + off) = (v0 * r) * w0; *(f32x4*)(out + off + 4) = (v1 * r) * w1; } }
        }
    }
};
struct EpiRelu2 {
    static constexpr bool HAS_MID = false;
    bf16_t* O; int ldc;
    __device__ __forceinline__ void operator()(Acc& acc, const Unit& u, int wr, int wc, int fr, int fq) const {
        const int row0 = u.pm * 256 + wr * 64 + fr, col0 = u.pn * 256 + wc * 32 + 8 * fq;
#pragma unroll
        for (int ai = 0; ai < 2; ++ai)
#pragma unroll
            for (int m = 0; m < 4; ++m) { const int row = row0 + ai * 128 + m * 16;
#pragma unroll
                for (int bj = 0; bj < 2; ++bj) { f32x4 v0 = acc[ai][bj][m][0], v1 = acc[ai][bj][m][1]; const int col = col0 + bj * 128;
                    bf16_t* rowp = O + ((size_t)(row >> 7) * (ldc >> 6) + (col >> 6)) * 8192 + (row & 127) * 64 + (col & 63) - bj * 128;
#pragma unroll
                    for (int j = 0; j < 4; ++j) { const float a = fmaxf(v0[j], 0.f), b = fmaxf(v1[j], 0.f); v0[j] = a * a; v1[j] = b * b; }
                    __builtin_nontemporal_store(pack8(v0, v1), (u32x4*)(rowp + bj * 128)); } }
    }
};

__device__ __forceinline__ int inproj_colmap(int n) {
    if (n < 512) return OFF_K + n;
    if (n < 768) { const int j = n - 512; return j < 32 ? OFF_IG + j : -1; }
    if (n < 1792) return OFF_V + (n - 768);
    if (n < 2304) return OFF_Q + (n - 1792);
    if (n < 6400) { const int lc = (n - 2304) & 255, jt = (n - 2304) >> 8, bj = lc >> 7, wc = (lc >> 5) & 3, fq = (lc >> 3) & 3, nn = (lc >> 2) & 1, jj = lc & 3;
        const int seg = 2 * bj + nn, ch = 64 * jt + 16 * wc + 4 * fq + jj;
        return (seg == 0 ? OFF_XIN : seg == 1 ? OFF_GC : seg == 2 ? OFF_GB : OFF_O) + ch; }
    { const int lc = (n - 6400) & 255, jt = (n - 6400) >> 8; return OFF_MRG + (lc >> 7) * 1024 + 128 * jt + (lc & 127); }
}
struct TrItem { const float* W; bf16_t* out; int ldw, nblk, ldo, kofs, item, map; };
__device__ __forceinline__ void tr_load(const TrItem& t, int lane, f32x4 (&v)[8]) {
    const int kb = t.item / t.nblk, nb = t.item % t.nblk, k0 = 64 * kb, n0 = 32 * nb;
    const int n4 = lane & 7, kr = lane >> 3;
    const int nn = n0 + 4 * n4; const int src = t.map ? inproj_colmap(nn) : nn;
#pragma unroll
    for (int it = 0; it < 8; ++it) v[it] = (src >= 0) ? __builtin_nontemporal_load((const f32x4*)(t.W + (size_t)(k0 + 8 * it + kr) * t.ldw + src)) : (f32x4){0.f, 0.f, 0.f, 0.f};
}
__device__ __forceinline__ void tr_finish(const TrItem& t, int lane, const f32x4 (&v)[8], LAS float* scr) {
    const int kb = t.item / t.nblk, nb = t.item % t.nblk, k0 = 64 * kb, n0 = 32 * nb;
    const int n4 = lane & 7, kr = lane >> 3;
#pragma unroll
    for (int it = 0; it < 8; ++it) { LAS float* d = scr + (8 * it + kr) * 33 + 4 * n4; d[0] = v[it][0]; d[1] = v[it][1]; d[2] = v[it][2]; d[3] = v[it][3]; }
    asm volatile("s_waitcnt lgkmcnt(0)" ::: "memory");
    const int c = lane & 7;
#pragma unroll
    for (int j = 0; j < 4; ++j) { const int n = (lane >> 3) + 8 * j; const LAS float* s = scr + (8 * c) * 33 + n;
        u32x4 o; o.x = cvt_pk_bf16(s[0 * 33], s[1 * 33]); o.y = cvt_pk_bf16(s[2 * 33], s[3 * 33]); o.z = cvt_pk_bf16(s[4 * 33], s[5 * 33]); o.w = cvt_pk_bf16(s[6 * 33], s[7 * 33]);
        *(u32x4*)(t.out + (size_t)(n0 + n) * t.ldo + t.kofs + k0 + 8 * c) = o; }
    asm volatile("s_waitcnt lgkmcnt(0)" ::: "memory");
}

struct Args { const float* in[18]; float* out; unsigned char* ws; int ph_lo, ph_hi; };
enum { I_X = 0, I_C, I_CTX, I_CCTX, I_WMOD, I_BMOD, I_N1W, I_WIN, I_BIN, I_CONVW, I_MNW, I_WCO, I_WMO, I_WOUT, I_N2W, I_WFF1, I_WFF2, I_FNW };

__device__ __forceinline__ void p0_mod(const Args& A, LAS unsigned char* lds, int tid, int lane, int wave, unsigned* modcnt) {
    unsigned char* ws = A.ws;
    LAS float* sl = (LAS float*)lds;
    LAS float* red = (LAS float*)(lds + 17 * 4096);
    bool filled = false; unsigned done = 0;
    for (int item = blockIdx.x; item < 6144 / 32; item += gridDim.x) {
        if (!filled) {
            float cv[34];
#pragma unroll
            for (int j = 0; j < 34; ++j) { const int i = tid + 512 * j; cv[j] = i < 16 * 1024 ? A.in[I_C][i] : A.in[I_CCTX][i - 16 * 1024]; }
#pragma unroll
            for (int j = 0; j < 34; ++j) sl[tid + 512 * j] = cv[j] * sigm(cv[j]);
            __syncthreads(); filled = true;
        }
        const int col = lane & 31, kh = lane >> 5, n0 = item * 32, kbase = 128 * wave + 64 * kh;
        float a[17];
#pragma unroll
        for (int r = 0; r < 17; ++r) a[r] = 0.f;
        const float* wp = A.in[I_WMOD] + (size_t)kbase * 6144 + n0 + col;
        float wv[64];
#pragma unroll
        for (int j = 0; j < 64; ++j) wv[j] = __builtin_nontemporal_load(wp + (size_t)j * 6144);
#pragma unroll
        for (int i = 0; i < 64; i += 8) {
#pragma unroll
            for (int r = 0; r < 17; ++r) { const f32x4 s4 = *(const LAS f32x4*)(sl + r * 1024 + kbase + i), s5 = *(const LAS f32x4*)(sl + r * 1024 + kbase + i + 4);
                a[r] += (s4[0] * wv[i + 0] + s4[1] * wv[i + 1]) + (s4[2] * wv[i + 2] + s4[3] * wv[i + 3]) + (s5[0] * wv[i + 4] + s5[1] * wv[i + 5]) + (s5[2] * wv[i + 6] + s5[3] * wv[i + 7]); }
        }
#pragma unroll
        for (int r = 0; r < 17; ++r) red[((wave * 2 + kh) * 17 + r) * 32 + col] = a[r];
        __syncthreads();
        for (int o = tid; o < 17 * 32; o += 512) { const int r = o >> 5, cc = o & 31; float s = A.in[I_BMOD][n0 + cc];
#pragma unroll
            for (int p = 0; p < 16; ++p) s += red[(p * 17 + r) * 32 + cc];
            ((float*)(ws + WS_MOD))[r * 6144 + n0 + cc] = s; }
        asm volatile("s_waitcnt vmcnt(0)" ::: "memory");
        __syncthreads();
        ++done;
    }
    if (done && tid == 0) { __builtin_amdgcn_fence(__ATOMIC_RELEASE, "agent"); asm volatile("s_waitcnt vmcnt(0)" ::: "memory"); __hip_atomic_fetch_add(modcnt, done, __ATOMIC_RELAXED, __HIP_MEMORY_SCOPE_AGENT); }
}
__device__ __forceinline__ void p0_weights(const Args& A, LAS unsigned char* lds, int tid, int lane, int wave) {
    unsigned char* ws = A.ws;
    LAS float* scr = (LAS float*)(lds + wave * 16384);
    const int gw = blockIdx.x * 8 + wave, NGW = gridDim.x * 8;
    constexpr int IT_WIN = 16 * (NIN / 32), IT_SQ = 16 * 32, IT_W1 = 16 * 128, IT_W2 = 64 * 32;
    constexpr int NITEMS = IT_WIN + 3 * IT_SQ + IT_W1 + IT_W2;
    auto mk = [&](int it) -> TrItem {
        int r = it;
        if (r < IT_WIN) return TrItem{A.in[I_WIN], (bf16_t*)(ws + WS_WIN), DIN, NIN / 32, 1024, 0, r, 1}; r -= IT_WIN;
        if (r < IT_SQ) return TrItem{A.in[I_WCO], (bf16_t*)(ws + WS_BT2), 1024, 32, 2048, 0, r, 0}; r -= IT_SQ;
        if (r < IT_SQ) return TrItem{A.in[I_WMO], (bf16_t*)(ws + WS_BT2), 1024, 32, 2048, 1024, r, 0}; r -= IT_SQ;
        if (r < IT_SQ) return TrItem{A.in[I_WOUT], (bf16_t*)(ws + WS_WO), 1024, 32, 1024, 0, r, 0}; r -= IT_SQ;
        if (r < IT_W1) return TrItem{A.in[I_WFF1], (bf16_t*)(ws + WS_W1), 4096, 128, 1024, 0, r, 0}; r -= IT_W1;
        return TrItem{A.in[I_WFF2], (bf16_t*)(ws + WS_W2), 1024, 32, F1P, 0, r, 0};
    };
    if (gw < NITEMS) {
        f32x4 va[8], vb[8];
        TrItem cur = mk(gw); tr_load(cur, lane, va);
        for (int it = gw; it < NITEMS; it += 2 * NGW) {
            const bool h1 = it + NGW < NITEMS, h2 = it + 2 * NGW < NITEMS;
            TrItem nx = cur; if (h1) { nx = mk(it + NGW); tr_load(nx, lane, vb); }
            tr_finish(cur, lane, va, scr);
            if (!h1) break;
            if (h2) { cur = mk(it + 2 * NGW); tr_load(cur, lane, va); }
            tr_finish(nx, lane, vb, scr);
        }
    }
    for (int i = blockIdx.x * 512 + tid; i < NIN; i += gridDim.x * 512) { const int s = inproj_colmap(i); ((float*)(ws + WS_BIASP))[i] = s >= 0 ? A.in[I_BIN][s] : 0.f; }
}

__device__ __forceinline__ float wave_allsum(float x) { return lane63(wave_scan_add(x)); }
__device__ __forceinline__ void modulate_rows4(const float* xrow, const float* w, const float* sh, const float* sc, bf16_t* orow, int lane) {
    f32x4 v[4][4]; float r[4];
#pragma unroll
    for (int q = 0; q < 4; ++q)
#pragma unroll
        for (int j = 0; j < 4; ++j) v[q][j] = __builtin_nontemporal_load((const f32x4*)(xrow + (size_t)q * DM) + lane + 64 * j);
#pragma unroll
    for (int q = 0; q < 4; ++q) { float s = 0.f;
#pragma unroll
        for (int j = 0; j < 4; ++j) s += (v[q][j].x * v[q][j].x + v[q][j].y * v[q][j].y) + (v[q][j].z * v[q][j].z + v[q][j].w * v[q][j].w);
        r[q] = rsqrtf(wave_allsum(s) * (1.f / DM) + EPS); }
#pragma unroll
    for (int j = 0; j < 4; ++j) { const f32x4 ww = ((const f32x4*)w)[lane + 64 * j], hh = ((const f32x4*)sh)[lane + 64 * j], cc = ((const f32x4*)sc)[lane + 64 * j];
        const f32x4 wc = ww * (cc + 1.f);
#pragma unroll
        for (int q = 0; q < 4; ++q) { const f32x4 y = (v[q][j] * r[q]) * wc + hh;
            u32x2 p; p.x = cvt_pk_bf16(y[0], y[1]); p.y = cvt_pk_bf16(y[2], y[3]); ((u32x2*)(orow + (size_t)q * DM))[lane + 64 * j] = p; } }
}

constexpr int L_QS = 0, L_KS = 18432, L_KTS = 36864, L_VTS = 54272, L_SS = 93440, L_CS = 128256, L_GW = 148992;
static_assert(L_GW + 8 * 512 <= LDS_BYTES, "mlstm LDS map");
#define BAR_LDS() asm volatile("s_waitcnt lgkmcnt(0)\n\ts_barrier" ::: "memory")

__device__ __forceinline__ void mlstm_seq(LAS unsigned char* lds, const bf16_t* Kb, const bf16_t* VTb, const bf16_t* Qb, const float* Gb, bf16_t* HD0, bf16_t* HD1, int seq, int tid, int lane, int w) {
    const int dir = seq >> 7, b = (seq >> 3) & 15, head = seq & 7;
    const int g = lane >> 4, l15 = lane & 15;
    bf16_t* HD = dir ? HD1 : HD0;
    for (int i = tid; i < 16 * 136; i += 512) { const int r = i / 136, cidx = i % 136; *(LAS bf16_t*)(lds + L_VTS + (128 + r) * 272 + cidx * 2) = (r == 0) ? (bf16_t)0x3F80 : (bf16_t)0; }
    const int tb = (w < 4) ? 2 * w : 15 - 2 * w;
    f32x4 st[4], nst;
#pragma unroll
    for (int i = 0; i < 4; ++i) st[i] = (f32x4){0.f, 0.f, 0.f, 0.f};
    nst = (f32x4){0.f, 0.f, 0.f, 0.f};
    float mstate = 0.f;
    u32x4 pq[2], pk[2], pv[4]; float gi0, gi1, gf0, gf1;
    unsigned offq[2], offv[4], offg0, offg1;
#pragma unroll
    for (int i = 0; i < 2; ++i) { const int p = tid + 512 * i, row = p >> 3, pc = p & 7; offq[i] = (unsigned)((dir ? 127 - row : row) * 512 + head * 64 + pc * 8); }
#pragma unroll
    for (int i = 0; i < 4; ++i) { const int p = tid + 512 * i, v = p >> 4, pc = p & 15; offv[i] = (unsigned)((head * 128 + v) * MALL + pc * 8); }
    offg0 = (unsigned)((dir * 8 + head) * MALL + (dir ? 127 - lane : lane)); offg1 = (unsigned)((dir * 8 + head) * MALL + (dir ? 63 - lane : lane + 64));
#define PF_ADDR(cc) const int cc_ = (cc); const bool isctx_ = cc_ < 2; const int T_ = isctx_ ? CTXL : SEQ, c2_ = isctx_ ? cc_ : cc_ - 2; \
        const int base_ = isctx_ ? MTOK + b * CTXL : b * SEQ; const int tok0_ = base_ + (dir ? T_ - 128 * (c2_ + 1) : 128 * c2_);
#define PF_GK(cc) do { PF_ADDR(cc) const bf16_t* kb_ = Kb + (size_t)tok0_ * 512; const float* gb_ = Gb + tok0_; \
        gi0 = gb_[offg0]; gf0 = gb_[offg0 + 16 * MALL]; gi1 = gb_[offg1]; gf1 = gb_[offg1 + 16 * MALL]; \
        _Pragma("unroll") for (int i = 0; i < 2; ++i) pk[i] = *(const u32x4*)(kb_ + offq[i]); } while (0)
#define PF_Q(cc) do { PF_ADDR(cc) const bf16_t* qb_ = Qb + (size_t)tok0_ * 512; \
        if (!isctx_) { _Pragma("unroll") for (int i = 0; i < 2; ++i) pq[i] = *(const u32x4*)(qb_ + offq[i]); } } while (0)
#define PF_V(cc, i0) do { PF_ADDR(cc) const bf16_t* vb_ = VTb + tok0_; \
        _Pragma("unroll") for (int i = (i0); i < (i0) + 2; ++i) pv[i] = *(const u32x4*)(vb_ + offv[i]); } while (0)
#define PREFETCH(cc) do { PF_GK(cc); PF_Q(cc); PF_V(cc, 0); PF_V(cc, 2); } while (0)
    PREFETCH(0);
    for (int cc = 0; cc < 18; ++cc) {
        const bool isctx = cc < 2; const int T_ = isctx ? CTXL : SEQ, c_ = isctx ? cc : cc - 2;
        const int tok0 = (isctx ? MTOK + b * CTXL : b * SEQ) + (dir ? T_ - 128 * (c_ + 1) : 128 * c_);
        const float b0 = wave_scan_add(gf0), b1 = wave_scan_add(gf1) + lane63(b0);
        const float a0 = gi0 - b0, a1 = gi1 - b1;
        const float Mc = fmaxf(mstate, lane63(wave_scan_max(fmaxf(a0, a1))));
        const float e0 = __expf(a0 - Mc), e1 = __expf(a1 - Mc), th0 = __expf(-b0 - Mc), th1 = __expf(-b1 - Mc);
        const float decay = __expf(mstate - Mc);
        mstate = lane63(b1) + Mc;
#pragma unroll
        for (int db = 0; db < 4; ++db) { st[db] = st[db] * decay; u32x2 p; p.x = cvt_pk_bf16(st[db][0], st[db][1]); p.y = cvt_pk_bf16(st[db][2], st[db][3]);
            *(LAS u32x2*)(lds + L_CS + (16 * w + l15) * 144 + (16 * db + 4 * g) * 2) = p; }
        if (w < 4) { nst = nst * decay; u32x2 p; p.x = cvt_pk_bf16(nst[0], nst[1]); p.y = cvt_pk_bf16(nst[2], nst[3]);
            *(LAS u32x2*)(lds + L_CS + (128 + l15) * 144 + (16 * w + 4 * g) * 2) = p; }
        if (!isctx) {
#pragma unroll
            for (int i = 0; i < 2; ++i) { const int p = tid + 512 * i, row = p >> 3, pc = p & 7; *(LAS u32x4*)(lds + L_QS + row * 144 + pc * 16) = pq[i]; }
        }
        {
#pragma unroll
            for (int i = 0; i < 2; ++i) { const int p = tid + 512 * i, row = p >> 3, pc = p & 7, kidx = dir ? 127 - row : row;
                const float es = __shfl(i ? e1 : e0, 8 * w + (lane >> 3));
                const int kcol = (((kidx >> 3) ^ pc) << 3) | (kidx & 7);
                const unsigned ww[4] = {pk[i].x, pk[i].y, pk[i].z, pk[i].w}; unsigned sc4[4];
#pragma unroll
                for (int q2 = 0; q2 < 4; ++q2) { const unsigned pkd = cvt_pk_bf16(bf_lo(ww[q2]) * es, bf_hi(ww[q2]) * es); sc4[q2] = pkd;
                    *(LAS bf16_t*)(lds + L_KTS + (pc * 8 + 2 * q2) * 272 + kcol * 2) = (bf16_t)(pkd & 0xffffu);
                    *(LAS bf16_t*)(lds + L_KTS + (pc * 8 + 2 * q2 + 1) * 272 + kcol * 2) = (bf16_t)(pkd >> 16); }
                *(LAS u32x4*)(lds + L_KS + row * 144 + pc * 16) = (u32x4){sc4[0], sc4[1], sc4[2], sc4[3]}; }
#pragma unroll
            for (int i = 0; i < 4; ++i) { const int p = tid + 512 * i, v = p >> 4, pc = p & 15;
                const int rho = (v & ~31) | (((v >> 2) & 1) << 4) | (((v >> 3) & 3) << 2) | (v & 3);
                *(LAS u32x4*)(lds + L_VTS + rho * 272 + pc * 16) = pv[i]; }
        }
        BAR_LDS();
        if (cc + 1 < 18) { if (isctx) PREFETCH(cc + 1); else PF_GK(cc + 1); }
        if (!isctx) {
            const int trow = 16 * tb + l15;
            const int klo = dir ? ((7 - tb) >> 1) : 0, khi = dir ? 3 : (tb >> 1);
            bf16x8 qf[2];
#pragma unroll
            for (int kk = 0; kk < 2; ++kk) qf[kk] = *(const LAS bf16x8*)(lds + L_QS + trow * 144 + (kk * 32 + g * 8) * 2);
#define SB() __builtin_amdgcn_sched_barrier(0)
            f32x4 sa[8];
#pragma unroll
            for (int sp = 0; sp < 4; ++sp) {
                if (2 * sp <= tb) {
                    bf16x8 kf[2][2];
#pragma unroll
                    for (int j = 0; j < 2; ++j)
#pragma unroll
                        for (int kk = 0; kk < 2; ++kk) kf[j][kk] = *(const LAS bf16x8*)(lds + L_KS + (16 * (2 * sp + j) + l15) * 144 + (kk * 32 + g * 8) * 2);
                    SB();
#pragma unroll
                    for (int j = 0; j < 2; ++j) sa[2 * sp + j] = __builtin_amdgcn_mfma_f32_16x16x32_bf16(kf[j][0], qf[0], (f32x4){0.f, 0.f, 0.f, 0.f}, 0, 0, 0);
#pragma unroll
                    for (int j = 0; j < 2; ++j) sa[2 * sp + j] = __builtin_amdgcn_mfma_f32_16x16x32_bf16(kf[j][1], qf[1], sa[2 * sp + j], 0, 0, 0);
                    SB();
                } else { sa[2 * sp] = (f32x4){0.f, 0.f, 0.f, 0.f}; sa[2 * sp + 1] = (f32x4){0.f, 0.f, 0.f, 0.f}; }
            }
#pragma unroll
            for (int sb = 0; sb < 8; ++sb) { const int s0 = 16 * sb + 4 * g; f32x4 v = sa[sb];
#pragma unroll
                for (int r = 0; r < 4; ++r) v[r] = (s0 + r <= trow) ? v[r] : 0.f;
                u32x2 p;
                if (dir) { p.x = cvt_pk_bf16(v[3], v[2]); p.y = cvt_pk_bf16(v[1], v[0]); *(LAS u32x2*)(lds + L_SS + trow * 272 + (124 - s0) * 2) = p; }
                else { p.x = cvt_pk_bf16(v[0], v[1]); p.y = cvt_pk_bf16(v[2], v[3]); *(LAS u32x2*)(lds + L_SS + trow * 272 + s0 * 2) = p; } }
            if (cc + 1 < 18) PF_Q(cc + 1);
            f32x4 num[9];
            {
                bf16x8 c0[9];
#pragma unroll
                for (int vb = 0; vb < 9; ++vb) c0[vb] = *(const LAS bf16x8*)(lds + L_CS + (16 * vb + l15) * 144 + (g * 8) * 2);
                SB();
#pragma unroll
                for (int vb = 0; vb < 9; ++vb) num[vb] = __builtin_amdgcn_mfma_f32_16x16x32_bf16(c0[vb], qf[0], (f32x4){0.f, 0.f, 0.f, 0.f}, 0, 0, 0);
                SB();
#pragma unroll
                for (int vb = 0; vb < 9; ++vb) c0[vb] = *(const LAS bf16x8*)(lds + L_CS + (16 * vb + l15) * 144 + (32 + g * 8) * 2);
                SB();
#pragma unroll
                for (int vb = 0; vb < 9; ++vb) num[vb] = __builtin_amdgcn_mfma_f32_16x16x32_bf16(c0[vb], qf[1], num[vb], 0, 0, 0);
                SB();
            }
            if (cc + 1 < 18) PF_V(cc + 1, 0);
#pragma unroll
            for (int kk = 0; kk < 4; ++kk) {
                if (kk >= klo && kk <= khi) {
                    bf16x8 vf[9];
                    const bf16x8 sf = *(const LAS bf16x8*)(lds + L_SS + trow * 272 + (kk * 32 + g * 8) * 2);
#pragma unroll
                    for (int vb = 0; vb < 9; ++vb) vf[vb] = *(const LAS bf16x8*)(lds + L_VTS + (16 * vb + l15) * 272 + (kk * 32 + g * 8) * 2);
                    SB();
#pragma unroll
                    for (int vb = 0; vb < 9; ++vb) num[vb] = __builtin_amdgcn_mfma_f32_16x16x32_bf16(vf[vb], sf, num[vb], 0, 0, 0);
                    SB();
                }
            }
            if (cc + 1 < 18) PF_V(cc + 1, 2);
            const float den = __shfl(num[8][0], l15);
            const float thr = __shfl((tb < 4) ? th0 : th1, (16 * tb + l15) & 63);
            const float inv = 1.f / fmaxf(fabsf(den), thr);
            const int tok = tok0 + (dir ? 127 - trow : trow);
            bf16_t* hp = HD + (size_t)tok * 1024 + head * 128 + 8 * g;
#pragma unroll
            for (int vp = 0; vp < 4; ++vp) { u32x4 p; p.x = cvt_pk_bf16(num[2 * vp][0] * inv, num[2 * vp][1] * inv); p.y = cvt_pk_bf16(num[2 * vp][2] * inv, num[2 * vp][3] * inv);
                p.z = cvt_pk_bf16(num[2 * vp + 1][0] * inv, num[2 * vp + 1][1] * inv); p.w = cvt_pk_bf16(num[2 * vp + 1][2] * inv, num[2 * vp + 1][3] * inv); *(u32x4*)(hp + 32 * vp) = p; }
        }
        {
            bf16x8 vf[4], of[4];
#pragma unroll
            for (int kk = 0; kk < 4; ++kk) { vf[kk] = *(const LAS bf16x8*)(lds + L_VTS + (16 * w + l15) * 272 + (kk * 32 + g * 8) * 2);
                of[kk] = *(const LAS bf16x8*)(lds + L_VTS + (128 + l15) * 272 + (kk * 32 + g * 8) * 2); }
#pragma unroll
            for (int db = 0; db < 4; ++db) {
                bf16x8 kf[4];
#pragma unroll
                for (int kk = 0; kk < 4; ++kk) kf[kk] = *(const LAS bf16x8*)(lds + L_KTS + (16 * db + l15) * 272 + (((4 * kk + g) ^ ((2 * db + (l15 >> 3)) & 7)) << 4));
                SB();
#pragma unroll
                for (int kk = 0; kk < 4; ++kk) st[db] = __builtin_amdgcn_mfma_f32_16x16x32_bf16(kf[kk], vf[kk], st[db], 0, 0, 0);
                if (w == db) {
#pragma unroll
                    for (int kk = 0; kk < 4; ++kk) nst = __builtin_amdgcn_mfma_f32_16x16x32_bf16(kf[kk], of[kk], nst, 0, 0, 0);
                }
                SB();
            }
        }
#undef SB
        BAR_LDS();
    }
#undef PREFETCH
#undef PF_GK
#undef PF_Q
#undef PF_V
#undef PF_ADDR
}

__device__ __forceinline__ void combine_rows4(const bf16_t* h0, const bf16_t* h1, bf16_t* ab, const float* nw, int lane) {
    u32x4 a[4][2], b[4][2], o[4][2];
#pragma unroll
    for (int q = 0; q < 4; ++q)
#pragma unroll
        for (int i = 0; i < 2; ++i) { const int p = lane + 64 * i;
            a[q][i] = __builtin_nontemporal_load((const u32x4*)(h0 + (size_t)q * 1024 + 8 * p)); b[q][i] = __builtin_nontemporal_load((const u32x4*)(h1 + (size_t)q * 1024 + 8 * p)); o[q][i] = __builtin_nontemporal_load((const u32x4*)(ab + (size_t)q * 2048 + 8 * p)); }
#pragma unroll
    for (int i = 0; i < 2; ++i) { const int p = lane + 64 * i;
        const f32x4 n0 = *(const f32x4*)(nw + 8 * p), n1 = *(const f32x4*)(nw + 8 * p + 4);
#pragma unroll
        for (int q = 0; q < 4; ++q) { const u32x4 aa = a[q][i], bb = b[q][i], oo = o[q][i];
            float s[8] = {bf_lo(aa.x) + bf_lo(bb.x), bf_hi(aa.x) + bf_hi(bb.x), bf_lo(aa.y) + bf_lo(bb.y), bf_hi(aa.y) + bf_hi(bb.y), bf_lo(aa.z) + bf_lo(bb.z), bf_hi(aa.z) + bf_hi(bb.z), bf_lo(aa.w) + bf_lo(bb.w), bf_hi(aa.w) + bf_hi(bb.w)};
            float ss = 0.f;
#pragma unroll
            for (int j = 0; j < 8; ++j) ss += s[j] * s[j];
            ss += dppf<0x121>(0.f, ss); ss += dppf<0x122>(0.f, ss); ss += dppf<0x124>(0.f, ss); ss += dppf<0x128>(0.f, ss);
            const float r = rsqrtf(ss * (1.f / 128.f) + EPS);
            const float og[8] = {bf_lo(oo.x), bf_hi(oo.x), bf_lo(oo.y), bf_hi(oo.y), bf_lo(oo.z), bf_hi(oo.z), bf_lo(oo.w), bf_hi(oo.w)};
            u32x4 qv;
            qv.x = cvt_pk_bf16(s[0] * r * n0[0] * og[0], s[1] * r * n0[1] * og[1]); qv.y = cvt_pk_bf16(s[2] * r * n0[2] * og[2], s[3] * r * n0[3] * og[3]);
            qv.z = cvt_pk_bf16(s[4] * r * n1[0] * og[4], s[5] * r * n1[1] * og[5]); qv.w = cvt_pk_bf16(s[6] * r * n1[2] * og[6], s[7] * r * n1[3] * og[7]);
            *(u32x4*)(ab + (size_t)q * 2048 + 8 * p) = qv; } }
}

#define XB_TMO      128
#define XB_XCNT(j)  (256  + 64 * (j))
#define XB_XSUB(j)  (1280 + 64 * (j))
#define XB_XGEN(j)  (2304 + 64 * (j))
#define XB_TOP      3328
#define XB_TOPGEN   3392
#define XCD_BAR_WORDS 3456
#define XB_SPIN_CAP (1u << 18)
__device__ __forceinline__ unsigned xb_ld(unsigned* p)              { return __hip_atomic_load(p, __ATOMIC_RELAXED, __HIP_MEMORY_SCOPE_AGENT); }
__device__ __forceinline__ unsigned xb_add(unsigned* p, unsigned v) { return __hip_atomic_fetch_add(p, v, __ATOMIC_RELAXED, __HIP_MEMORY_SCOPE_AGENT); }
__device__ __forceinline__ unsigned xb_xcc_id() { return (unsigned)__builtin_amdgcn_s_getreg((3 << 11) | 20) & 0xFu; }
#define XB_SPIN(cond, bar) do { unsigned _sp = 0; while (cond) { __builtin_amdgcn_s_sleep(1); \
    if ((++_sp & 255u) == 0u) { if (xb_ld(&(bar)[XB_TMO])) break; if (_sp > XB_SPIN_CAP) { atomicAdd(&(bar)[XB_TMO], 1u); break; } } } } while (0)
struct XcdBarrier { unsigned* bar; unsigned x; volatile LAS unsigned* st; };
__device__ __forceinline__ XcdBarrier xcd_barrier_post(unsigned* bar, volatile LAS unsigned* st) {
    XcdBarrier b; b.bar = bar; b.x = xb_xcc_id(); b.st = st;
    if (threadIdx.x == 0) (void)xb_add(&bar[XB_XCNT(b.x)], 1u);
    return b;
}
__device__ __forceinline__ void xcd_barrier_complete(unsigned* bar, unsigned x, unsigned& nloc, unsigned& nx) {
    const unsigned G = gridDim.x * gridDim.y * gridDim.z;
    unsigned sum, cnt, mine, sp = 0u;
    for (;;) {
        sum = 0u; cnt = 0u; mine = 0u;
#pragma unroll
        for (unsigned j = 0; j < 16; ++j) { const unsigned c = xb_ld(&bar[XB_XCNT(j)]); sum += c; cnt += (c > 0u) ? 1u : 0u; mine = (j == x) ? c : mine; }
        if (sum == G) break;
        __builtin_amdgcn_s_sleep(1);
        if ((++sp & 255u) == 0u) { if (xb_ld(&bar[XB_TMO])) break; if (sp > XB_SPIN_CAP) { atomicAdd(&bar[XB_TMO], 1u); break; } }
    }
    nloc = mine > 0u ? mine : 1u; nx = cnt > 0u ? cnt : 1u;
}
__device__ __forceinline__ void xcd_barrier(const XcdBarrier& b) {
    asm volatile("s_waitcnt vmcnt(0)" ::: "memory");
    __syncthreads();
    if (threadIdx.x == 0) {
        unsigned* bar = b.bar;
        __builtin_amdgcn_s_waitcnt(0);
        unsigned nloc = b.st[0], nx = b.st[1];
        if (nloc == 0u) { xcd_barrier_complete(bar, b.x, nloc, nx); b.st[0] = nloc; b.st[1] = nx; }
        const unsigned old = xb_add(&bar[XB_XSUB(b.x)], 1u);
        const unsigned gen = old / nloc;
        if (old + 1u == (gen + 1u) * nloc) {
            __builtin_amdgcn_fence(__ATOMIC_RELEASE, "agent");
            asm volatile("s_waitcnt vmcnt(0)" ::: "memory");
            const unsigned og = xb_add(&bar[XB_TOP], 1u);
            const unsigned tg = og / nx;
            if (og + 1u == (tg + 1u) * nx) xb_add(&bar[XB_TOPGEN], 1u);
            else XB_SPIN(xb_ld(&bar[XB_TOPGEN]) == tg, bar);
            __builtin_amdgcn_fence(__ATOMIC_ACQUIRE, "agent");
            xb_add(&bar[XB_XGEN(b.x)], 1u);
            asm volatile("s_waitcnt vmcnt(0)" ::: "memory");
        } else {
            XB_SPIN(xb_ld(&bar[XB_XGEN(b.x)]) == gen, bar);
            __builtin_amdgcn_fence(__ATOMIC_ACQUIRE, "agent");
            asm volatile("s_waitcnt vmcnt(0)" ::: "memory");
        }
    }
    __syncthreads();
}

constexpr int N_PHASES = 11;
__global__ void __launch_bounds__(512, 2) mk_fwd(Args A) {
    extern __shared__ __attribute__((aligned(16))) unsigned char lds_raw[];
    LAS unsigned char* lds = (LAS unsigned char*)lds_raw;
    cg::grid_group grid = cg::this_grid();
    const int tid = threadIdx.x, lane = tid & 63, wave = __builtin_amdgcn_readfirstlane(tid >> 6);
    const int G = gridDim.x, gw = blockIdx.x * 8 + wave, NGW = G * 8;
    unsigned char* ws = A.ws;
    const float* mod = (const float*)(ws + WS_MOD);
    bf16_t* H = (bf16_t*)(ws + WS_H);
    const int lo = A.ph_lo, hi = A.ph_hi;
#ifndef PHMASK
#define PHMASK 0x7ff
#endif
#ifndef REPMASK
#define REPMASK 0
#endif
#ifndef XSYNC
#define XSYNC 0
#endif
#ifndef TS_LO
#define TS_LO -2
#define TS_HI -2
#endif
#define REP(k) for (int rep_ = 0; rep_ < 1 + ((REPMASK >> (k)) & 1); ++rep_)
#define IN(k) (((PHMASK >> (k)) & 1) && lo <= (k) && (k) < hi)
    unsigned* barw = (unsigned*)(ws + WS_BAR);
    volatile LAS unsigned* bst = (volatile LAS unsigned*)(lds + LDS_BYTES - 16);
    if (tid < 4) bst[tid] = 0u;
    __syncthreads();
    if (hi < 0) grid.sync();
    XcdBarrier xbar = xcd_barrier_post(barw, bst);
    unsigned long long ts_a = 0, ts_b = 0;
    if (TS_LO == -1) ts_a = __builtin_amdgcn_s_memrealtime();
#define SEAM(k) do { if (IN(k) && IN((k) + 1)) xcd_barrier(xbar); if (TS_LO == (k)) ts_a = __builtin_amdgcn_s_memrealtime(); if (TS_HI == (k)) ts_b = __builtin_amdgcn_s_memrealtime(); } while (0)

    if (IN(0)) {
        unsigned* modcnt = (unsigned*)(ws + WS_MODCNT);
        p0_mod(A, lds, tid, lane, wave, modcnt);
        if (TS_LO == 20) ts_a = __builtin_amdgcn_s_memrealtime(); if (TS_HI == 20) ts_b = __builtin_amdgcn_s_memrealtime();
        __syncthreads();
        p0_weights(A, lds, tid, lane, wave);
        if (TS_LO == 21) ts_a = __builtin_amdgcn_s_memrealtime(); if (TS_HI == 21) ts_b = __builtin_amdgcn_s_memrealtime();
        if (tid == 0) { unsigned sp = 0; while (__hip_atomic_load(modcnt, __ATOMIC_RELAXED, __HIP_MEMORY_SCOPE_AGENT) < 6144u / 32u) { __builtin_amdgcn_s_sleep(2); if (++sp > (1u << 22)) break; }
            __builtin_amdgcn_fence(__ATOMIC_ACQUIRE, "agent"); asm volatile("s_waitcnt vmcnt(0)" ::: "memory"); }
        __syncthreads();
        for (int row = 4 * gw; row < MALL; row += 4 * NGW) {
            const bool isx = row < MTOK; const int bb = isx ? (row >> 11) : 16;
            const float* xr = isx ? A.in[I_X] + (size_t)row * DM : A.in[I_CTX] + (size_t)(row - MTOK) * DM;
            modulate_rows4(xr, A.in[I_N1W], mod + bb * 6144, mod + bb * 6144 + 1024, H + (size_t)row * DM, lane);
        }
    }
    if (TS_LO == 0) ts_a = __builtin_amdgcn_s_memrealtime(); if (TS_HI == 0) ts_b = __builtin_amdgcn_s_memrealtime();
    SEAM(1);
    if (IN(2)) REP(2) {
        pg8::Gemm g{H, (const bf16_t*)(ws + WS_WIN), 1024, 1024, 1024, 0}; pg8::InProjOrder S{G, (int)blockIdx.x};
        EpiInProj E{(bf16_t*)(ws + WS_K), (bf16_t*)(ws + WS_VT), (bf16_t*)(ws + WS_Q), (float*)(ws + WS_G), (bf16_t*)(ws + WS_AB), (bf16_t*)A.out, (const float*)(ws + WS_BIASP), A.in[I_CONVW]};
        pg8::gemm_phase<EpiInProj, pg8::InProjOrder>(lds, g, S, E);
    }
    SEAM(2);
    if (IN(3)) REP(3) {
        for (int seq = blockIdx.x; seq < 256; seq += G)
            mlstm_seq(lds, (const bf16_t*)(ws + WS_K), (const bf16_t*)(ws + WS_VT), (const bf16_t*)(ws + WS_Q), (const float*)(ws + WS_G), (bf16_t*)(ws + WS_H), (bf16_t*)(ws + WS_HD1), seq, tid, lane, wave);
    }
    SEAM(3);
    if (IN(4)) {
        for (int row = 4 * gw; row < MTOK; row += 4 * NGW)
            combine_rows4((const bf16_t*)(ws + WS_H) + (size_t)row * 1024, (const bf16_t*)(ws + WS_HD1) + (size_t)row * 1024, (bf16_t*)(ws + WS_AB) + (size_t)row * 2048 + 1024, A.in[I_MNW], lane);
    }
    SEAM(4);
    if (IN(5)) REP(5) {
        pg8::Gemm g{(const bf16_t*)(ws + WS_AB), (const bf16_t*)(ws + WS_BT2), 1024, 2048, 2048, 0}; pg8::SplitKOrder S; S.base.init(MTOK, 1024, G, (int)blockIdx.x);
        EpiG2 E{(const bf16_t*)A.out, (bf16_t*)(ws + WS_H)};
        pg8::gemm_phase<EpiG2, pg8::SplitKOrder>(lds, g, S, E);
    }
    SEAM(5);
    if (IN(6)) REP(6) {
        pg8::Gemm g{(const bf16_t*)(ws + WS_H), (const bf16_t*)(ws + WS_WO), 1024, 1024, 1024, 0}; pg8::StaticOrder S; S.init(MTOK, 1024, G, (int)blockIdx.x);
        EpiResNorm<0> E{A.in[I_X], A.out, mod + 2048, 0, H, A.in[I_N2W], mod, (bf16_t*)(ws + WS_HD1), (float*)(ws + WS_XBUF), (unsigned*)(ws + WS_CNT), lds + 131072};
        pg8::gemm_phase<EpiResNorm<0>, pg8::StaticOrder>(lds, g, S, E);
    }
    SEAM(6);
    if (IN(8)) REP(8) {
        pg8::Gemm g{H, (const bf16_t*)(ws + WS_W1), 1024, 1024, 1024, 0}; pg8::StaticOrder S; S.init(MTOK, DFF, G, (int)blockIdx.x);
        EpiRelu2 E{(bf16_t*)(ws + WS_F1), DFF};
        pg8::gemm_phase<EpiRelu2, pg8::StaticOrder>(lds, g, S, E);
    }
    SEAM(8);
    if (IN(9)) {
        pg8::Gemm g{(const bf16_t*)(ws + WS_F1), (const bf16_t*)(ws + WS_W2), DFF, DFF, F1P, 1}; pg8::StaticOrder S; S.init(MTOK, 1024, G, (int)blockIdx.x);
        EpiResNorm<1> E{A.out, A.out, mod + 5120, 1, nullptr, A.in[I_FNW], mod, (bf16_t*)(ws + WS_HD1), (float*)(ws + WS_XBUF) + (size_t)MTOK * 4, (unsigned*)(ws + WS_CNT) + 128 * 64, lds + 131072};
        pg8::gemm_phase<EpiResNorm<1>, pg8::StaticOrder>(lds, g, S, E);
    }
    if (TS_LO > -2) {
        xcd_barrier(xbar); if (TS_HI == 9) ts_b = __builtin_amdgcn_s_memrealtime();
        if (blockIdx.x == 0) { const int n = (int)((ts_b - ts_a) / 100ull); for (int i = tid; i < n; i += 512) A.out[(size_t)i * 4096 + 3] += 0.25f; }
    }
#undef IN
#undef SEAM
}

#ifndef MK_N_LAUNCHES
#define MK_N_LAUNCHES 1
#endif
extern "C" void kernel_launch(void* const* d_in, const int* in_sizes, int n_in, void* d_out, int out_size, void* d_ws, size_t ws_size, hipStream_t stream) {
    static int grid = 0;
    if (grid == 0) {
        if (n_in != 18 || out_size != MTOK * DM || ws_size < WS_END) { fprintf(stderr, "kernel_launch: unexpected shapes (n_in %d out %d ws %zu)\n", n_in, out_size, ws_size); grid = -1; return; }
        int dev = 0, cus = 0, per_cu = 0;
        hipGetDevice(&dev); hipDeviceGetAttribute(&cus, hipDeviceAttributeMultiprocessorCount, dev);
        hipFuncSetAttribute((const void*)mk_fwd, hipFuncAttributeMaxDynamicSharedMemorySize, LDS_BYTES);
        if (hipOccupancyMaxActiveBlocksPerMultiprocessor(&per_cu, (const void*)mk_fwd, 512, LDS_BYTES) != hipSuccess || per_cu < 1) { fprintf(stderr, "kernel_launch: occupancy query says %d\n", per_cu); per_cu = 1; }
        (void)hipGetLastError();
        grid = cus * per_cu;
        if (grid > 256) grid = 256;
    }
    if (grid < 0) return;
    Args a{};
    for (int i = 0; i < 18; ++i) a.in[i] = (const float*)d_in[i];
    a.out = (float*)d_out; a.ws = (unsigned char*)d_ws;
    (void)hipMemsetAsync((unsigned char*)d_ws + WS_BAR, 0, 256 * 1024, stream);
#if MK_N_LAUNCHES == 1
    a.ph_lo = 0; a.ph_hi = N_PHASES;
    void* args[] = {&a};
    hipError_t e = hipLaunchCooperativeKernel((const void*)mk_fwd, dim3(grid), dim3(512), args, LDS_BYTES, stream);
    if (e != hipSuccess) fprintf(stderr, "cooperative launch failed: %s (grid %d)\n", hipGetErrorString(e), grid);
#else
    for (int p = 0; p < N_PHASES; ++p) { a.ph_lo = p; a.ph_hi = p + 1; hipLaunchKernelGGL(mk_fwd, dim3(grid), dim3(512), LDS_BYTES, stream, a); }
#endif
}
```
